# Optimizing an MI355X kernel written in HIP

```python
import jax, jax.numpy as jnp
from jax import lax
import numpy as np

D_MODEL = 2048
BATCH = 4
SEQ = 8192
DEPTH = 1

D_MIX = D_MODEL
D_GMLP = D_MIX // 2
D_LRU = D_MIX - D_GMLP
CHUNK = 128
GMLP_HEAD_DIM = 128
N_GMLP_HEADS = D_GMLP // GMLP_HEAD_DIM
LRU_BLOCK = 128
N_LRU_BLOCKS = D_LRU // LRU_BLOCK
CONV_WIDTH = 4
LRU_C = 8.0
D_PLE = 256
EPS = 1e-6
D_IN_PROJ = 3 * D_GMLP + 2 * D_LRU

kernel_name = "hymba_gmlp_rglru_sandwich_ple"


def rmsnorm(x, g):
    xf = x.astype(jnp.float32)
    y = xf * lax.rsqrt(jnp.mean(xf * xf, axis=-1, keepdims=True) + EPS)
    return (y * g.astype(jnp.float32)).astype(x.dtype)


def layernorm(x, g, b):
    xf = x.astype(jnp.float32)
    mu = jnp.mean(xf, axis=-1, keepdims=True)
    xc = xf - mu
    y = xc * lax.rsqrt(jnp.mean(xc * xc, axis=-1, keepdims=True) + EPS)
    return (y * g.astype(jnp.float32) + b.astype(jnp.float32)).astype(x.dtype)


def gmlp_branch(u, v, ln_g, ln_b, w_s, b_s):
    bsz, s, _ = v.shape
    u = jax.nn.gelu(u)
    v = layernorm(jax.nn.gelu(v), ln_g, ln_b)
    vc = v.reshape(bsz, s // CHUNK, CHUNK, N_GMLP_HEADS, GMLP_HEAD_DIM)
    causal = jnp.tril(jnp.ones((CHUNK, CHUNK), dtype=bool))
    w = jnp.where(causal[None], w_s, jnp.zeros_like(w_s))
    mixed = jnp.einsum('hts,bcshd->bcthd', w, vc) + jnp.transpose(b_s)[None, None, :, :, None]
    return u * mixed.reshape(bsz, s, D_GMLP)


def _lin_rec_combine(left, right):
    a_l, b_l = left
    a_r, b_r = right
    return a_l * a_r, a_r * b_l + b_r


def rglru_branch(xb, conv_w, conv_b, w_a, b_a, w_x, b_x, lam):
    bsz, s, c = xb.shape
    xc = lax.conv_general_dilated(
        xb, conv_w, window_strides=(1,), padding=[(CONV_WIDTH - 1, 0)],
        dimension_numbers=('NWC', 'WIO', 'NWC'), feature_group_count=c) + conv_b
    xh = xc.reshape(bsz, s, N_LRU_BLOCKS, LRU_BLOCK)
    r = jax.nn.sigmoid(jnp.einsum('bshi,hij->bshj', xh, w_a) + b_a).reshape(bsz, s, c)
    i = jax.nn.sigmoid(jnp.einsum('bshi,hij->bshj', xh, w_x) + b_x).reshape(bsz, s, c)
    log_a = -LRU_C * r.astype(jnp.float32) * jax.nn.softplus(-lam.astype(jnp.float32))
    a = jnp.exp(log_a)
    mult = jnp.sqrt(-jnp.expm1(2.0 * log_a))
    is_first = (jnp.arange(s) == 0)[None, :, None]
    mult = jnp.where(is_first, jnp.ones_like(mult), mult)
    bt = mult * (i * xc).astype(jnp.float32)
    _, h = lax.associative_scan(_lin_rec_combine, (a, bt), axis=1)
    return h.astype(xb.dtype)


def setup_inputs(seed: int = 0) -> dict:
    key = jax.random.key(seed)
    ks = jax.random.split(key, 24)
    f32 = jnp.float32
    n = lambda k, shape, scale: jax.random.normal(k, shape, f32) * scale
    gain = lambda k, shape: 1.0 + 0.01 * jax.random.normal(k, shape, f32)
    x = jax.random.normal(ks[0], (BATCH, SEQ, D_MODEL), f32)
    p = jax.random.normal(ks[1], (DEPTH, BATCH, SEQ, D_PLE), f32)
    pre_g = gain(ks[2], (DEPTH, D_MODEL))
    w_in = n(ks[3], (DEPTH, D_MODEL, D_IN_PROJ), D_MODEL ** -0.5)
    gmlp_ln_g = gain(ks[4], (DEPTH, D_GMLP))
    gmlp_ln_b = n(ks[5], (DEPTH, D_GMLP), 0.01)
    gmlp_ws = n(ks[6], (DEPTH, N_GMLP_HEADS, CHUNK, CHUNK), CHUNK ** -0.5)
    gmlp_bs = gain(ks[7], (DEPTH, N_GMLP_HEADS, CHUNK))
    conv_w = n(ks[8], (DEPTH, CONV_WIDTH, 1, D_LRU), CONV_WIDTH ** -0.5)
    conv_b = n(ks[9], (DEPTH, D_LRU), 0.01)
    w_a = n(ks[10], (DEPTH, N_LRU_BLOCKS, LRU_BLOCK, LRU_BLOCK), LRU_BLOCK ** -0.5)
    b_a = n(ks[11], (DEPTH, N_LRU_BLOCKS, LRU_BLOCK), 0.01)
    w_x = n(ks[12], (DEPTH, N_LRU_BLOCKS, LRU_BLOCK, LRU_BLOCK), LRU_BLOCK ** -0.5)
    b_x = n(ks[13], (DEPTH, N_LRU_BLOCKS, LRU_BLOCK), 0.01)
    a0 = jax.random.uniform(ks[14], (DEPTH, D_LRU), f32, 0.9, 0.999)
    s0 = a0 ** (1.0 / LRU_C)
    lam = jnp.log(s0) - jnp.log1p(-s0)
    gmlp_out_g = gain(ks[15], (DEPTH, D_GMLP))
    lru_out_g = gain(ks[16], (DEPTH, D_LRU))
    w_out = n(ks[17], (DEPTH, D_MIX, D_MODEL), D_MIX ** -0.5)
    post_g = gain(ks[18], (DEPTH, D_MODEL))
    w_pe = n(ks[19], (DEPTH, D_PLE, D_MODEL), D_PLE ** -0.5)
    w_pg = n(ks[20], (DEPTH, D_MODEL, D_MODEL), D_MODEL ** -0.5)
    return {"x": x, "p": p, "pre_g": pre_g, "w_in": w_in, "gmlp_ln_g": gmlp_ln_g,
            "gmlp_ln_b": gmlp_ln_b, "gmlp_ws": gmlp_ws, "gmlp_bs": gmlp_bs,
            "conv_w": conv_w, "conv_b": conv_b, "w_a": w_a, "b_a": b_a, "w_x": w_x,
            "b_x": b_x, "lam": lam, "gmlp_out_g": gmlp_out_g, "lru_out_g": lru_out_g,
            "w_out": w_out, "post_g": post_g, "w_pe": w_pe, "w_pg": w_pg}


def reference(x, p, pre_g, w_in, gmlp_ln_g, gmlp_ln_b, gmlp_ws, gmlp_bs, conv_w, conv_b,
              w_a, b_a, w_x, b_x, lam, gmlp_out_g, lru_out_g, w_out, post_g, w_pe, w_pg):
    h = x
    splits = [D_GMLP, 2 * D_GMLP, 3 * D_GMLP, 3 * D_GMLP + D_LRU]
    for l in range(DEPTH):
        hn = rmsnorm(h, pre_g[l])
        z = hn @ w_in[l]
        u, v, gate_a, xb, gate_b = jnp.split(z, splits, axis=-1)
        ya = gmlp_branch(u, v, gmlp_ln_g[l], gmlp_ln_b[l], gmlp_ws[l], gmlp_bs[l]) * jax.nn.silu(gate_a)
        yb = rglru_branch(xb, conv_w[l], conv_b[l], w_a[l], b_a[l], w_x[l], b_x[l], lam[l]) * jax.nn.silu(gate_b)
        y = jnp.concatenate([rmsnorm(ya, gmlp_out_g[l]), rmsnorm(yb, lru_out_g[l])], axis=-1)
        h = h + rmsnorm(y @ w_out[l], post_g[l])
        h = h + (p[l] @ w_pe[l]) * jax.nn.sigmoid(h @ w_pg[l])
    return h
```

```cpp
#define MK_N_LAUNCHES 8
#include <hip/hip_runtime.h>
#include <hip/hip_cooperative_groups.h>
#include <cstdio>
#include <cstdint>
namespace cg = cooperative_groups;
namespace pg8 {
#define PG8_LAS __attribute__((address_space(3)))
typedef unsigned short bf16_t;
typedef short bf16x8 __attribute__((ext_vector_type(8)));
typedef float f32x4 __attribute__((ext_vector_type(4)));
typedef unsigned u32x4 __attribute__((ext_vector_type(4)));
constexpr int BM = 256, BK = 64, HALF = 128, HTB = HALF * BK * 2  , STAGE_BYTES = 8 * HTB, NXCD = 8, WGM = 8;

__host__ __device__ __forceinline__ int lds_byte(int r, int c) { const int st = (r >> 4) * 2 + (c >> 5), rr = r & 15, cc = c & 31, ob = rr * 64 + cc * 2; return st * 1024 + (ob ^ (((ob >> 9) & 1) << 5)); }
__host__ __device__ __forceinline__ void stage_rc(int b, int& R, int& C) { const int st = b / 1024, sb = b % 1024, swz = sb ^ (((sb >> 9) & 1) << 5); R = (st >> 1) * 16 + swz / 64; C = (st & 1) * 32 + (swz % 64) / 2; }
__host__ __device__ __forceinline__ int perm32(int rho) { const int n = rho >> 4, i = rho & 15; return 8 * (i >> 2) + 4 * n + (i & 3); }

struct Unit { int pm, pn; };
struct Gemm { const bf16_t* A; const bf16_t* Bt; int M, N, K; };

struct StaticOrder {
    int nM, nN, nwg, G, c;
    __host__ __device__ void init(int M, int N, int G_, int c_) { nM = M / BM; nN = N / BM; nwg = nM * nN; G = G_; c = c_; }
    __host__ __device__ bool next(int i, Unit& u) const {
        const long L = (long)i * G + c; if (L >= nwg) return false;
        int wgid = (int)L; { const int q = nwg / NXCD, r = nwg % NXCD, xcd = wgid % NXCD, off = wgid / NXCD; wgid = (xcd < r ? xcd * (q + 1) : r * (q + 1) + (xcd - r) * q) + off; }
        const int nig = WGM * nN, gid = wgid / nig, fm = gid * WGM, gsz = (nM - fm) < WGM ? (nM - fm) : WGM;
        u.pm = fm + ((wgid % nig) % gsz); u.pn = (wgid % nig) / gsz; return true;
    }
    __device__ __forceinline__ void a_ready(const Unit&) const {}
    __device__ __forceinline__ void done(const Unit&) const {}
};

__device__ __forceinline__ unsigned cvt_pk_bf16(float lo, float hi) { unsigned r; asm volatile("v_cvt_pk_bf16_f32 %0, %1, %2" : "=v"(r) : "v"(lo), "v"(hi)); return r; }
typedef float f32x2 __attribute__((ext_vector_type(2)));
typedef unsigned u32x2 __attribute__((ext_vector_type(2)));
__device__ __forceinline__ float fast_sigmoid(float x) { return __builtin_amdgcn_rcpf(1.0f + __expf(-x)); }

struct EpiPlain {
    static constexpr bool PERM = true, AFTER_DRAIN = false;
    bf16_t* O; int ldc;
    __device__ __forceinline__ void operator()(const f32x4 (&acc)[2][2][4][2], const Unit& u, int wr, int wc, int fr, int fq) const {
        const int row0 = u.pm * BM + wr * 64 + fr, col0 = u.pn * BM + wc * 32 + 8 * fq;
#pragma unroll
        for (int ai = 0; ai < 2; ++ai)
#pragma unroll
            for (int m = 0; m < 4; ++m) { bf16_t* rowp = O + (size_t)(row0 + ai * HALF + m * 16) * ldc + col0;
#pragma unroll
                for (int bj = 0; bj < 2; ++bj) { const f32x4 v0 = acc[ai][bj][m][0], v1 = acc[ai][bj][m][1];
                    u32x4 w; w.x = cvt_pk_bf16(v0[0], v0[1]); w.y = cvt_pk_bf16(v0[2], v0[3]); w.z = cvt_pk_bf16(v1[0], v1[1]); w.w = cvt_pk_bf16(v1[2], v1[3]);
                    *(u32x4*)(rowp + bj * HALF) = w; } }
    }
};

struct EpiZ {
    static constexpr bool PERM = true, AFTER_DRAIN = false;
    bf16_t* Z; int ldc; f32x2* vst;
    __device__ __forceinline__ void operator()(const f32x4 (&acc)[2][2][4][2], const Unit& u, int wr, int wc, int fr, int fq) const {
        const int row0 = u.pm * BM + wr * 64 + fr, col0 = u.pn * BM + wc * 32 + 8 * fq;
        const int grp = u.pn >> 2;
#pragma unroll
        for (int ai = 0; ai < 2; ++ai)
#pragma unroll
            for (int m = 0; m < 4; ++m) { const int row = row0 + ai * HALF + m * 16; bf16_t* rowp = Z + (size_t)row * ldc + col0;
                float s = 0.f, q = 0.f;
#pragma unroll
                for (int bj = 0; bj < 2; ++bj) { f32x4 v[2] = {acc[ai][bj][m][0], acc[ai][bj][m][1]};
                    if (grp != 3) {
#pragma unroll
                        for (int n = 0; n < 2; ++n)
#pragma unroll
                            for (int j = 0; j < 4; ++j) { const float x = v[n][j]; const float a = (grp < 2) ? 1.5957691216f * (x + 0.044715f * x * x * x) : x; v[n][j] = x * fast_sigmoid(a); }
                    }
                    if (grp == 1) {
#pragma unroll
                        for (int n = 0; n < 2; ++n)
#pragma unroll
                            for (int j = 0; j < 4; ++j) { s += v[n][j]; q += v[n][j] * v[n][j]; }
                    }
                    u32x4 w; w.x = cvt_pk_bf16(v[0][0], v[0][1]); w.y = cvt_pk_bf16(v[0][2], v[0][3]); w.z = cvt_pk_bf16(v[1][0], v[1][1]); w.w = cvt_pk_bf16(v[1][2], v[1][3]);
                    *(u32x4*)(rowp + bj * HALF) = w; }
                if (grp == 1) { s += __shfl_xor(s, 16); s += __shfl_xor(s, 32); q += __shfl_xor(q, 16); q += __shfl_xor(q, 32);
                    if (fq == 0) vst[(size_t)row * 16 + (u.pn - 4) * 4 + wc] = (f32x2){s, q}; }
            }
    }
};

struct EpiO {
    static constexpr bool PERM = true, AFTER_DRAIN = false;
    bf16_t* O; int ldc; float* sso;
    __device__ __forceinline__ void operator()(const f32x4 (&acc)[2][2][4][2], const Unit& u, int wr, int wc, int fr, int fq) const {
        const int row0 = u.pm * BM + wr * 64 + fr, col0 = u.pn * BM + wc * 32 + 8 * fq;
#pragma unroll
        for (int ai = 0; ai < 2; ++ai)
#pragma unroll
            for (int m = 0; m < 4; ++m) { const int row = row0 + ai * HALF + m * 16; bf16_t* rowp = O + (size_t)row * ldc + col0;
                float q = 0.f;
#pragma unroll
                for (int bj = 0; bj < 2; ++bj) { const f32x4 v0 = acc[ai][bj][m][0], v1 = acc[ai][bj][m][1];
#pragma unroll
                    for (int j = 0; j < 4; ++j) { q += v0[j] * v0[j]; q += v1[j] * v1[j]; }
                    u32x4 w; w.x = cvt_pk_bf16(v0[0], v0[1]); w.y = cvt_pk_bf16(v0[2], v0[3]); w.z = cvt_pk_bf16(v1[0], v1[1]); w.w = cvt_pk_bf16(v1[2], v1[3]);
                    *(u32x4*)(rowp + bj * HALF) = w; }
                q += __shfl_xor(q, 16); q += __shfl_xor(q, 32);
                if (fq == 0) sso[(size_t)row * 32 + u.pn * 4 + wc] = q;
            }
    }
};

struct EpiOut {
    static constexpr bool PERM = false, AFTER_DRAIN = false;
    float* out; const bf16_t* pe; int ldc;
    __device__ __forceinline__ void operator()(const f32x4 (&acc)[2][2][4][2], const Unit& u, int wr, int wc, int fr, int fq) const {
        const int row0 = u.pm * BM + wr * 64 + fr, col0 = u.pn * BM + wc * 32 + 4 * fq;
#pragma unroll
        for (int ai = 0; ai < 2; ++ai)
#pragma unroll
            for (int m = 0; m < 4; ++m) { const size_t off = (size_t)(row0 + ai * HALF + m * 16) * ldc + col0;
#pragma unroll
                for (int bj = 0; bj < 2; ++bj)
#pragma unroll
                    for (int n = 0; n < 2; ++n) { const size_t o2 = off + bj * HALF + n * 16;
                        const f32x4 h1 = *(const f32x4*)(out + o2); const u32x2 pw = *(const u32x2*)(pe + o2); const f32x4 a = acc[ai][bj][m][n];
                        f32x4 r;
                        r[0] = h1[0] + __uint_as_float(pw.x << 16) * fast_sigmoid(a[0]);
                        r[1] = h1[1] + __uint_as_float(pw.x & 0xffff0000u) * fast_sigmoid(a[1]);
                        r[2] = h1[2] + __uint_as_float(pw.y << 16) * fast_sigmoid(a[2]);
                        r[3] = h1[3] + __uint_as_float(pw.y & 0xffff0000u) * fast_sigmoid(a[3]);
                        *(f32x4*)(out + o2) = r; }
                asm volatile("" ::: "memory"); }
    }
};

template <class Epi, class Sched, bool ALIGN_EPI = false, bool SP2 = false>
__device__ __forceinline__ void gemm_phase(PG8_LAS unsigned char* lds, const Gemm g, const Sched& S, const Epi& E) {
    const int tid = threadIdx.x, wid = __builtin_amdgcn_readfirstlane(tid >> 6), lane = tid & 63, wr = wid >> 2, wc = wid & 3, fr = lane & 15, fq = lane >> 4;
    const int K = g.K, nt = K / BK;
    unsigned voffA[2], voffB[2];
#pragma unroll
    for (int i = 0; i < 2; ++i) { int R, C; stage_rc(tid * 16 + i * 8192, R, C); const int Rb = Epi::PERM ? ((R & ~31) + perm32(R & 31)) : R;
        voffA[i] = (unsigned)(R * K + C) * 2u; voffB[i] = (unsigned)(Rb * K + C) * 2u; }
    const size_t kstep = (size_t)(BK * 2);
    const size_t hstep = (size_t)HALF * K * 2;
    const size_t tstep = 2 * hstep;
    const unsigned ldsw = (unsigned)wid * 1024u;
    const int aoff = lds_byte(wr * 64 + fr, fq * 8), boff = lds_byte(wc * 32 + fr, fq * 8);
#define PG8_SA(b, h) (((b) * 2 + (h)) * HTB)
#define PG8_SB(b, h) ((4 + (b) * 2 + (h)) * HTB)
#define PG8_STAGE(bufoff, gbase, voff) do { _Pragma("unroll") for (int _i = 0; _i < 2; ++_i) \
        __builtin_amdgcn_global_load_lds((const unsigned*)((const char*)(gbase) + (voff)[_i]), (PG8_LAS unsigned*)(lds + (bufoff) + ldsw + _i * 8192), 16, 0, 0); } while (0)
#define PG8_LDA(dst, b, h) do { _Pragma("unroll") for (int m = 0; m < 4; ++m) _Pragma("unroll") for (int k = 0; k < 2; ++k) dst[m][k] = *(const PG8_LAS bf16x8*)(lds + PG8_SA(b, h) + aoff + m * 2048 + k * 1024); } while (0)
#define PG8_LDB(dst, b, h) do { _Pragma("unroll") for (int n = 0; n < 2; ++n) _Pragma("unroll") for (int k = 0; k < 2; ++k) dst[n][k] = *(const PG8_LAS bf16x8*)(lds + PG8_SB(b, h) + boff + n * 2048 + k * 1024); } while (0)
#define PG8_MMA(ai, bj, At, Bt) do { __builtin_amdgcn_s_setprio(1); _Pragma("unroll") for (int m = 0; m < 4; ++m) _Pragma("unroll") for (int n = 0; n < 2; ++n) _Pragma("unroll") for (int k = 0; k < 2; ++k) \
        acc[ai][bj][m][n] = __builtin_amdgcn_mfma_f32_16x16x32_bf16(Bt[n][k], At[m][k], acc[ai][bj][m][n], 0, 0, 0); __builtin_amdgcn_s_setprio(0); } while (0)
#define PG8_WAIT_V(n) asm volatile("s_waitcnt vmcnt(" #n ")" ::: "memory")
#define PG8_WAIT_L(n) asm volatile("s_waitcnt lgkmcnt(" #n ")" ::: "memory")
#define PG8_BAR __builtin_amdgcn_s_barrier()
#define PG8_SCHED __builtin_amdgcn_sched_barrier(0)
    Unit cur, nxt; int ui = 0;
    if (!S.next(0, cur)) return;
    f32x4 acc[2][2][4][2];
#pragma unroll
    for (int a = 0; a < 2; ++a)
#pragma unroll
        for (int b = 0; b < 2; ++b)
#pragma unroll
            for (int m = 0; m < 4; ++m)
#pragma unroll
                for (int n = 0; n < 2; ++n) acc[a][b][m][n] = (f32x4){0.f, 0.f, 0.f, 0.f};
    bf16x8 At[4][2], B0[2][2], B1[2][2];
    const char* cA = (const char*)g.A + (size_t)cur.pm * tstep; const char* cB = (const char*)g.Bt + (size_t)cur.pn * tstep;
    S.a_ready(cur);
    if constexpr (SP2) {
        PG8_STAGE(PG8_SB(0, 0), cB, voffB); PG8_STAGE(PG8_SB(0, 1), cB + hstep, voffB); PG8_STAGE(PG8_SA(0, 0), cA, voffA); PG8_STAGE(PG8_SA(0, 1), cA + hstep, voffA);
        if (wr == 1) PG8_BAR;
        PG8_WAIT_V(2); PG8_BAR;
        PG8_STAGE(PG8_SB(1, 0), cB + kstep, voffB); PG8_STAGE(PG8_SA(1, 0), cA + kstep, voffA); PG8_STAGE(PG8_SB(1, 1), cB + hstep + kstep, voffB);
        PG8_WAIT_V(6); PG8_BAR;
    } else {
        PG8_STAGE(PG8_SB(0, 0), cB, voffB); PG8_STAGE(PG8_SA(0, 0), cA, voffA); PG8_STAGE(PG8_SB(0, 1), cB + hstep, voffB); PG8_STAGE(PG8_SA(0, 1), cA + hstep, voffA);
        if (wr == 1) PG8_BAR;
        PG8_WAIT_V(4); PG8_BAR;
        PG8_STAGE(PG8_SB(1, 0), cB + kstep, voffB); PG8_STAGE(PG8_SA(1, 0), cA + kstep, voffA); PG8_STAGE(PG8_SB(1, 1), cB + hstep + kstep, voffB);
        PG8_WAIT_V(6); PG8_BAR;
    }
    for (;;) {
        const bool has_next = S.next(ui + 1, nxt);
        const char* nA = has_next ? (const char*)g.A + (size_t)nxt.pm * tstep : cA; const char* nB = has_next ? (const char*)g.Bt + (size_t)nxt.pn * tstep : cB;
        for (int t = 0; t < nt; t += 2) {
            const bool last = (t == nt - 2);
            const char* a1 = cA + (size_t)(t + 1) * kstep;
            const char* a2 = last ? nA : cA + (size_t)(t + 2) * kstep; const char* b2 = last ? nB : cB + (size_t)(t + 2) * kstep;
            const char* a3 = a2 + kstep; const char* b3 = b2 + kstep;
            if (last && has_next) S.a_ready(nxt);
            if constexpr (SP2) {
            PG8_LDB(B0, 0, 0); PG8_LDB(B1, 0, 1); PG8_SCHED; PG8_LDA(At, 0, 0); PG8_STAGE(PG8_SA(1, 1), a1 + hstep, voffA);
            PG8_WAIT_V(8); PG8_WAIT_L(0); PG8_BAR; PG8_MMA(0, 0, At, B0); PG8_MMA(0, 1, At, B1); PG8_BAR; PG8_SCHED;
            PG8_LDA(At, 0, 1); PG8_STAGE(PG8_SB(0, 0), b2, voffB); PG8_STAGE(PG8_SB(0, 1), b2 + hstep, voffB); PG8_STAGE(PG8_SA(0, 0), a2, voffA);
            PG8_WAIT_V(8); PG8_WAIT_L(0); PG8_BAR; PG8_MMA(1, 0, At, B0); PG8_MMA(1, 1, At, B1); PG8_BAR; PG8_SCHED;
            PG8_LDB(B0, 1, 0); PG8_LDB(B1, 1, 1); PG8_SCHED; PG8_LDA(At, 1, 0); PG8_STAGE(PG8_SA(0, 1), a2 + hstep, voffA);
            PG8_WAIT_V(8); PG8_WAIT_L(0); PG8_BAR; PG8_MMA(0, 0, At, B0); PG8_MMA(0, 1, At, B1); PG8_BAR; PG8_SCHED;
            PG8_LDA(At, 1, 1); PG8_STAGE(PG8_SB(1, 0), b3, voffB); PG8_STAGE(PG8_SB(1, 1), b3 + hstep, voffB); PG8_STAGE(PG8_SA(1, 0), a3, voffA);
            PG8_WAIT_V(8); PG8_WAIT_L(0); PG8_BAR; PG8_MMA(1, 0, At, B0); PG8_MMA(1, 1, At, B1); PG8_BAR; PG8_SCHED;
            } else {
            PG8_LDB(B0, 0, 0); PG8_SCHED; PG8_LDA(At, 0, 0); PG8_STAGE(PG8_SA(1, 1), a1 + hstep, voffA);
            PG8_WAIT_L(8); PG8_BAR; PG8_WAIT_L(0); PG8_MMA(0, 0, At, B0); PG8_BAR; PG8_SCHED;
            PG8_LDB(B1, 0, 1); PG8_STAGE(PG8_SB(0, 0), b2, voffB);
            PG8_BAR; PG8_WAIT_L(0); PG8_MMA(0, 1, At, B1); PG8_BAR;
            PG8_LDA(At, 0, 1); PG8_STAGE(PG8_SA(0, 0), a2, voffA);
            PG8_BAR; PG8_WAIT_L(0); PG8_MMA(1, 0, At, B0); PG8_BAR; PG8_SCHED;
            PG8_STAGE(PG8_SB(0, 1), b2 + hstep, voffB);
            PG8_WAIT_V(6); PG8_BAR; PG8_MMA(1, 1, At, B1); PG8_BAR;
            PG8_LDB(B0, 1, 0); PG8_SCHED; PG8_LDA(At, 1, 0); PG8_STAGE(PG8_SA(0, 1), a2 + hstep, voffA);
            PG8_WAIT_L(8); PG8_BAR; PG8_WAIT_L(0); PG8_MMA(0, 0, At, B0); PG8_BAR; PG8_SCHED;
            PG8_LDB(B1, 1, 1); PG8_STAGE(PG8_SB(1, 0), b3, voffB);
            PG8_BAR; PG8_WAIT_L(0); PG8_MMA(0, 1, At, B1); PG8_BAR;
            PG8_LDA(At, 1, 1); PG8_STAGE(PG8_SA(1, 0), a3, voffA);
            PG8_BAR; PG8_WAIT_L(0); PG8_MMA(1, 0, At, B0); PG8_BAR; PG8_SCHED;
            PG8_STAGE(PG8_SB(1, 1), b3 + hstep, voffB);
            PG8_WAIT_V(6); PG8_BAR; PG8_MMA(1, 1, At, B1); PG8_BAR;
            }
        }
        if constexpr (ALIGN_EPI) { if (wr == 0) PG8_BAR; }
        if constexpr (!Epi::AFTER_DRAIN) { E(acc, cur, wr, wc, fr, fq); S.done(cur); }
        if (!has_next) break;
#pragma unroll
        for (int a = 0; a < 2; ++a)
#pragma unroll
            for (int b = 0; b < 2; ++b)
#pragma unroll
                for (int m = 0; m < 4; ++m)
#pragma unroll
                    for (int n = 0; n < 2; ++n) acc[a][b][m][n] = (f32x4){0.f, 0.f, 0.f, 0.f};
        cur = nxt; cA = nA; cB = nB; ++ui;
        if constexpr (ALIGN_EPI) { if (wr == 1) PG8_BAR; }
    }
    PG8_WAIT_V(0);
    if constexpr (!ALIGN_EPI) { if (wr == 0) PG8_BAR; }
    PG8_BAR;
    if constexpr (Epi::AFTER_DRAIN) { E.fused(acc, cur, wr, wc, fr, fq, lds, wid, lane); S.done(cur); }
#undef PG8_SA
#undef PG8_SB
#undef PG8_STAGE
#undef PG8_LDA
#undef PG8_LDB
#undef PG8_MMA
#undef PG8_WAIT_V
#undef PG8_WAIT_L
#undef PG8_BAR
#undef PG8_SCHED
}
}

constexpr int BATCH = 4, SEQ = 8192, DM = 2048, M = BATCH * SEQ, DG = 1024, DL = 1024, NZ = 5120, DP = 256, CHK = 128, NH = 8;
constexpr float EPS = 1e-6f;
constexpr int NWAVES = 8, NTHR = NWAVES * 64;
#ifndef MK_N_LAUNCHES
#define MK_N_LAUNCHES 1
#endif
constexpr int N_PHASES = 8;

constexpr size_t MiB = 1u << 20;
constexpr size_t WS_WIN = 2 * MiB;
constexpr size_t WS_WOUT = 22 * MiB;
constexpr size_t WS_WPG = 30 * MiB;
constexpr size_t WS_WPE = 38 * MiB;
constexpr size_t WS_WA = 39 * MiB;
constexpr size_t WS_WX = WS_WA + 256 * 1024;
constexpr size_t WS_WSM = WS_WX + 256 * 1024;
constexpr size_t WS_VST = 40 * MiB;
constexpr size_t WS_SSA = 44 * MiB;
constexpr size_t WS_SSB = 45 * MiB;
constexpr size_t WS_SSO = 46 * MiB;
constexpr size_t WS_AGG = 50 * MiB;
constexpr size_t WS_A1 = 64 * MiB;
constexpr size_t WS_PBF = 192 * MiB;
constexpr size_t WS_PE = 208 * MiB;
constexpr size_t WS_Z = 336 * MiB;
constexpr size_t WS_Y = 656 * MiB;
constexpr size_t WS_O = 784 * MiB;
constexpr size_t WS_END = 912 * MiB;

constexpr int LDS_BYTES = 147456;
constexpr int IMG0 = 0, IMG1 = 32768, IMG2 = 65536, IMG3 = 98304, MISC = 131072;
constexpr int MISC_STAT = MISC, MISC_PART = MISC + 1024, MISC_CPART = MISC + 5120;

#define LAS __attribute__((address_space(3)))
typedef unsigned short bf16;
typedef unsigned char uchar;
typedef float f32x4 __attribute__((ext_vector_type(4)));
typedef float f32x2 __attribute__((ext_vector_type(2)));
typedef unsigned u32x4 __attribute__((ext_vector_type(4)));
typedef unsigned u32x2 __attribute__((ext_vector_type(2)));
typedef short bf16x8 __attribute__((ext_vector_type(8)));

__device__ __forceinline__ unsigned f2bf(float f) { unsigned u = __builtin_bit_cast(unsigned, f); return (u + 0x7fffu + ((u >> 16) & 1u)) >> 16; }
__device__ __forceinline__ unsigned pk2(float lo, float hi) { return f2bf(lo) | (f2bf(hi) << 16); }
__device__ __forceinline__ float bflo(unsigned w) { return __uint_as_float(w << 16); }
__device__ __forceinline__ float bfhi(unsigned w) { return __uint_as_float(w & 0xffff0000u); }
__device__ __forceinline__ float wave_sum(float v) {
#pragma unroll
    for (int o = 1; o < 64; o <<= 1) v += __shfl_xor(v, o);
    return v;
}
__device__ __forceinline__ float sigmoidf_(float x) { return __builtin_amdgcn_rcpf(1.0f + __expf(-x)); }

struct Frame {
    LAS uchar* lds;
    int tid, lane, wave, G, bid;
    const float* in[21]; float* out; uchar* ws;
};

__device__ __forceinline__ void p0_transpose_item(const float* W, int K, int N, bf16* WT, LAS float* scr, int item, int lane, const float* ks0, const float* ks1, int ksplit) {
    const int nblk = N / 32, kb = item / nblk, nb = item % nblk, k0 = 64 * kb, n0 = 32 * nb;
#pragma unroll 8
    for (int i = 0; i < 32; ++i) { const int kk = 2 * i + (lane >> 5); float v = W[(size_t)(k0 + kk) * N + n0 + (lane & 31)];
        if (ks0) { const int k = k0 + kk; v *= (k < ksplit) ? ks0[k] : ks1[k - ksplit]; }
        scr[kk * 33 + (lane & 31)] = v; }
    asm volatile("s_waitcnt lgkmcnt(0)" ::: "memory");
    const int c = lane & 7;
#pragma unroll
    for (int j = 0; j < 4; ++j) { const int n = (lane >> 3) + 8 * j; const LAS float* s = scr + (8 * c) * 33 + n;
        u32x4 o; o.x = pk2(s[0 * 33], s[1 * 33]); o.y = pk2(s[2 * 33], s[3 * 33]); o.z = pk2(s[4 * 33], s[5 * 33]); o.w = pk2(s[6 * 33], s[7 * 33]);
        *(u32x4*)(WT + (size_t)(n0 + n) * K + k0 + 8 * c) = o; }
    asm volatile("s_waitcnt lgkmcnt(0)" ::: "memory");
}

__device__ __forceinline__ void p0_prologue(Frame& F) {
    LAS float* scr = (LAS float*)(F.lds + F.wave * 16384);
    const int gw = F.bid * NWAVES + F.wave, NGW = F.G * NWAVES;
    const float* w_in = F.in[3]; const float* w_out = F.in[17]; const float* w_pe = F.in[19]; const float* w_pg = F.in[20];
    const float* w_a = F.in[10]; const float* w_x = F.in[12];
    bf16* WIN = (bf16*)(F.ws + WS_WIN); bf16* WOUT = (bf16*)(F.ws + WS_WOUT); bf16* WPG = (bf16*)(F.ws + WS_WPG); bf16* WPE = (bf16*)(F.ws + WS_WPE);
    bf16* WA = (bf16*)(F.ws + WS_WA); bf16* WX = (bf16*)(F.ws + WS_WX); bf16* WSM = (bf16*)(F.ws + WS_WSM);
    constexpr int I_IN = (DM / 64) * (NZ / 32), I_OUT = (DM / 64) * (DM / 32), I_PG = I_OUT, I_PE = (DP / 64) * (DM / 32), I_SM = 16 * 8;
    constexpr int NITEMS = I_IN + I_OUT + I_PG + I_PE + I_SM;
    for (int it = gw; it < NITEMS; it += NGW) {
        int r = it;
        if (r < I_IN) { p0_transpose_item(w_in, DM, NZ, WIN, scr, r, F.lane, nullptr, nullptr, 0); continue; } r -= I_IN;
        if (r < I_OUT) { p0_transpose_item(w_out, DM, DM, WOUT, scr, r, F.lane, F.in[15], F.in[16], DG); continue; } r -= I_OUT;
        if (r < I_PG) { p0_transpose_item(w_pg, DM, DM, WPG, scr, r, F.lane, nullptr, nullptr, 0); continue; } r -= I_PG;
        if (r < I_PE) { p0_transpose_item(w_pe, DP, DM, WPE, scr, r, F.lane, nullptr, nullptr, 0); continue; } r -= I_PE;
        { const int mat = r >> 3, sub = r & 7;
          const float* src = (mat < 8 ? w_a : w_x) + (size_t)(mat & 7) * 16384; bf16* dst = (mat < 8 ? WA : WX) + (size_t)(mat & 7) * 16384;
          p0_transpose_item(src, 128, 128, dst, scr, sub, F.lane, nullptr, nullptr, 0); }
    }
    { const float* ws_ = F.in[6]; const int gt = F.bid * NTHR + F.tid, NGT = F.G * NTHR;
      for (int i = gt; i < NH * CHK * CHK / 2; i += NGT) { const int e = 2 * i, s = e & 127, t = (e >> 7) & 127; const f32x2 v = *(const f32x2*)(ws_ + e);
          ((unsigned*)WSM)[i] = pk2(s <= t ? v.x : 0.f, (s + 1) <= t ? v.y : 0.f); } }
    { const float* x = F.in[0]; const float* pg = F.in[2]; bf16* A1 = (bf16*)(F.ws + WS_A1);
      for (int m = gw; m < M; m += NGW) {
          const f32x4* xr = (const f32x4*)(x + (size_t)m * DM) + F.lane; f32x4 v[8]; float ss = 0.f;
#pragma unroll
          for (int j = 0; j < 8; ++j) { v[j] = xr[64 * j]; ss += (v[j].x * v[j].x + v[j].y * v[j].y) + (v[j].z * v[j].z + v[j].w * v[j].w); }
          const float rstd = 1.0f / sqrtf(wave_sum(ss) * (1.0f / DM) + EPS);
          u32x2* o8 = (u32x2*)(A1 + (size_t)m * DM) + F.lane;
#pragma unroll
          for (int j = 0; j < 8; ++j) { const f32x4 g = ((const f32x4*)pg)[F.lane + 64 * j];
              u32x2 o; o.x = pk2(v[j].x * rstd * g.x, v[j].y * rstd * g.y); o.y = pk2(v[j].z * rstd * g.z, v[j].w * rstd * g.w); o8[64 * j] = o; }
      } }
    { const float* p = F.in[1]; bf16* PB = (bf16*)(F.ws + WS_PBF); const size_t gt = (size_t)F.bid * NTHR + F.tid, NGT = (size_t)F.G * NTHR;
      for (size_t i = gt; i < (size_t)M * DP / 8; i += NGT) { const f32x4 a = ((const f32x4*)p)[2 * i], b = ((const f32x4*)p)[2 * i + 1];
          u32x4 o; o.x = pk2(a.x, a.y); o.y = pk2(a.z, a.w); o.z = pk2(b.x, b.y); o.w = pk2(b.z, b.w); ((u32x4*)PB)[i] = o; } }
}

__device__ __forceinline__ int sw16(int row) { return (row ^ (row >> 3)) & 15; }
__device__ __forceinline__ int img_off(int row, int chunk) { return row * 256 + ((chunk ^ sw16(row)) << 4); }
__device__ __forceinline__ void load_img(LAS uchar* img, const bf16* src, int tid) {
#pragma unroll
    for (int i = 0; i < 4; ++i) { const int q = tid + NTHR * i, row = q >> 4, ch = q & 15; const u32x4 v = *(const u32x4*)(src + row * 128 + ch * 8); *(LAS u32x4*)(img + img_off(row, ch)) = v; }
}
#define DPP_F(oldv, srcv, ctrl) __builtin_bit_cast(float, __builtin_amdgcn_update_dpp(__builtin_bit_cast(int, (float)(oldv)), __builtin_bit_cast(int, (float)(srcv)), (ctrl), 0xf, 0xf, false))

__device__ __forceinline__ void gmlp_unit(Frame& F, int c, int h) {
    const int tid = F.tid, lane = F.lane, w = F.wave, fr = lane & 15, fq = lane >> 4;
    const int t0 = c * CHK, tg4 = tid >> 4, cg = tid & 15;
    const bf16* Z = (const bf16*)(F.ws + WS_Z); bf16* Y = (bf16*)(F.ws + WS_Y);
    const f32x2* vst = (const f32x2*)(F.ws + WS_VST); float* SSA = (float*)(F.ws + WS_SSA);
    LAS f32x2* stat = (LAS f32x2*)(F.lds + MISC_STAT); LAS float* part = (LAS float*)(F.lds + MISC_PART);
    u32x4 gv[4], uu[4], gg[4];
#pragma unroll
    for (int j = 0; j < 4; ++j) { const bf16* zr = Z + (size_t)(t0 + 4 * tg4 + j) * NZ + 128 * h + 8 * cg;
        uu[j] = *(const u32x4*)zr; gv[j] = *(const u32x4*)(zr + DG); gg[j] = *(const u32x4*)(zr + 2 * DG); }
    if (tid < 128) { const f32x2* vp = vst + (size_t)(t0 + tid) * 16; float s = 0.f, q = 0.f;
#pragma unroll
        for (int k = 0; k < 16; ++k) { const f32x2 v = vp[k]; s += v.x; q += v.y; }
        const float mean = s * (1.0f / DG); float var = q * (1.0f / DG) - mean * mean; var = var > 0.f ? var : 0.f;
        stat[tid] = (f32x2){mean, 1.0f / sqrtf(var + EPS)}; }
    __syncthreads();
    {
        const float* lg = F.in[4] + 128 * h + 8 * cg; const float* lb = F.in[5] + 128 * h + 8 * cg;
        const f32x4 g0 = *(const f32x4*)lg, g1 = *(const f32x4*)(lg + 4), b0 = *(const f32x4*)lb, b1 = *(const f32x4*)(lb + 4);
        const float gsc[8] = {g0.x, g0.y, g0.z, g0.w, g1.x, g1.y, g1.z, g1.w}, bsc[8] = {b0.x, b0.y, b0.z, b0.w, b1.x, b1.y, b1.z, b1.w};
        float nv[4][8];
#pragma unroll
        for (int j = 0; j < 4; ++j) { const f32x2 st = stat[4 * tg4 + j]; const unsigned wv[4] = {gv[j].x, gv[j].y, gv[j].z, gv[j].w};
#pragma unroll
            for (int k = 0; k < 4; ++k) { nv[j][2 * k] = (bflo(wv[k]) - st.x) * st.y * gsc[2 * k] + bsc[2 * k]; nv[j][2 * k + 1] = (bfhi(wv[k]) - st.x) * st.y * gsc[2 * k + 1] + bsc[2 * k + 1]; } }
#pragma unroll
        for (int cc = 0; cc < 8; ++cc) { const int d = 8 * cg + cc; u32x2 o; o.x = pk2(nv[0][cc], nv[1][cc]); o.y = pk2(nv[2][cc], nv[3][cc]);
            *(LAS u32x2*)(F.lds + IMG0 + d * 256 + (((tg4 >> 1) ^ sw16(d)) << 4) + (tg4 & 1) * 8) = o; }
#pragma unroll
        for (int j = 0; j < 4; ++j) { *(LAS u32x4*)(F.lds + IMG2 + img_off(4 * tg4 + j, cg)) = uu[j]; *(LAS u32x4*)(F.lds + IMG3 + img_off(4 * tg4 + j, cg)) = gg[j]; }
    }
    __syncthreads();
    f32x4 acc[8];
#pragma unroll
    for (int T = 0; T < 8; ++T) acc[T] = (f32x4){0.f, 0.f, 0.f, 0.f};
    bf16x8 af[4];
#pragma unroll
    for (int kk = 0; kk < 4; ++kk) af[kk] = *(const LAS bf16x8*)(F.lds + IMG0 + img_off(16 * w + fr, 4 * kk + fq));
#pragma unroll
    for (int T = 0; T < 8; ++T)
#pragma unroll
        for (int kk = 0; kk <= (T >> 1); ++kk) { const bf16x8 bfr = *(const LAS bf16x8*)(F.lds + IMG1 + img_off(16 * T + fr, 4 * kk + fq));
            acc[T] = __builtin_amdgcn_mfma_f32_16x16x32_bf16(af[kk], bfr, acc[T], 0, 0, 0); }
    const float* bs = F.in[7] + h * CHK;
#pragma unroll
    for (int T = 0; T < 8; ++T) { const int t = 16 * T + fr; const float bsv = bs[t];
        const int o = img_off(t, 2 * w + (fq >> 1)) + (fq & 1) * 8;
        const u32x2 uw = *(const LAS u32x2*)(F.lds + IMG2 + o), gw = *(const LAS u32x2*)(F.lds + IMG3 + o);
        const float y0 = bflo(uw.x) * (acc[T][0] + bsv) * bflo(gw.x), y1 = bfhi(uw.x) * (acc[T][1] + bsv) * bfhi(gw.x);
        const float y2 = bflo(uw.y) * (acc[T][2] + bsv) * bflo(gw.y), y3 = bfhi(uw.y) * (acc[T][3] + bsv) * bfhi(gw.y);
        float q = (y0 * y0 + y1 * y1) + (y2 * y2 + y3 * y3);
        u32x2 ow; ow.x = pk2(y0, y1); ow.y = pk2(y2, y3);
        *(u32x2*)(Y + (size_t)(t0 + t) * DM + 128 * h + 16 * w + 4 * fq) = ow;
        q += __shfl_xor(q, 16); q += __shfl_xor(q, 32);
        if (fq == 0) part[w * 128 + t] = q; }
    __syncthreads();
    if (tid < 128) { float s = 0.f;
#pragma unroll
        for (int k = 0; k < 8; ++k) s += part[k * 128 + tid];
        SSA[(size_t)(t0 + tid) * 8 + h] = s; }
}

template <bool APPLY>
__device__ __forceinline__ void lru_unit(Frame& F, int c, int h) {
    const int tid = F.tid, lane = F.lane, w = F.wave, fr = lane & 15, fq = lane >> 4;
    const int t0 = c * CHK, tseq0 = t0 & (SEQ - 1), tg4 = tid >> 4, cg = tid & 15;
    const bf16* Z = (const bf16*)(F.ws + WS_Z); bf16* Y = (bf16*)(F.ws + WS_Y);
    f32x2* AGG = (f32x2*)(F.ws + WS_AGG); float* SSB = (float*)(F.ws + WS_SSB);
    LAS float* part = (LAS float*)(F.lds + MISC_PART); LAS f32x2* cpart = (LAS f32x2*)(F.lds + MISC_CPART);
    u32x4 xb[7], gg[4];
#pragma unroll
    for (int k = 0; k < 7; ++k) { const int trel = 4 * tg4 - 3 + k;
        if (tseq0 + trel >= 0) xb[k] = *(const u32x4*)(Z + (size_t)(t0 + trel) * NZ + 3 * DG + 128 * h + 8 * cg); else xb[k] = (u32x4){0u, 0u, 0u, 0u}; }
    if (APPLY) {
#pragma unroll
        for (int j = 0; j < 4; ++j) gg[j] = *(const u32x4*)(Z + (size_t)(t0 + 4 * tg4 + j) * NZ + 4 * DG + 128 * h + 8 * cg);
        const int ch = tid & 127, pt = tid >> 7, cs = c & 63, cb0 = c - cs; const int lo = 16 * pt, hi = (16 * pt + 16 < cs) ? 16 * pt + 16 : cs;
        float A = 1.f, B = 0.f;
        for (int cc = lo; cc < hi; ++cc) { const f32x2 ab = AGG[(size_t)(cb0 + cc) * DL + 128 * h + ch]; B = ab.x * B + ab.y; A = ab.x * A; }
        cpart[pt * 128 + ch] = (f32x2){A, B};
    }
    {
        const float* cw = F.in[8] + 128 * h + 8 * cg; const float* cbp = F.in[9] + 128 * h + 8 * cg;
        float wk[4][8], cbv[8];
#pragma unroll
        for (int k = 0; k < 4; ++k) { const f32x4 a = *(const f32x4*)(cw + k * DL), b = *(const f32x4*)(cw + k * DL + 4);
            wk[k][0] = a.x; wk[k][1] = a.y; wk[k][2] = a.z; wk[k][3] = a.w; wk[k][4] = b.x; wk[k][5] = b.y; wk[k][6] = b.z; wk[k][7] = b.w; }
        { const f32x4 a = *(const f32x4*)cbp, b = *(const f32x4*)(cbp + 4); cbv[0] = a.x; cbv[1] = a.y; cbv[2] = a.z; cbv[3] = a.w; cbv[4] = b.x; cbv[5] = b.y; cbv[6] = b.z; cbv[7] = b.w; }
        float xc[4][8];
#pragma unroll
        for (int j = 0; j < 4; ++j)
#pragma unroll
            for (int e = 0; e < 8; ++e) xc[j][e] = cbv[e];
#pragma unroll
        for (int k = 0; k < 7; ++k) { const unsigned wv[4] = {xb[k].x, xb[k].y, xb[k].z, xb[k].w};
#pragma unroll
            for (int e2 = 0; e2 < 4; ++e2) { const float lo_ = bflo(wv[e2]), hi_ = bfhi(wv[e2]);
#pragma unroll
                for (int j = 0; j < 4; ++j) { const int kw = k - j; if (kw >= 0 && kw < 4) { xc[j][2 * e2] += wk[kw][2 * e2] * lo_; xc[j][2 * e2 + 1] += wk[kw][2 * e2 + 1] * hi_; } } } }
#pragma unroll
        for (int j = 0; j < 4; ++j) { u32x4 o; o.x = pk2(xc[j][0], xc[j][1]); o.y = pk2(xc[j][2], xc[j][3]); o.z = pk2(xc[j][4], xc[j][5]); o.w = pk2(xc[j][6], xc[j][7]);
            *(LAS u32x4*)(F.lds + IMG0 + img_off(4 * tg4 + j, cg)) = o;
            if (APPLY) *(LAS u32x4*)(F.lds + IMG3 + img_off(4 * tg4 + j, cg)) = gg[j]; }
    }
    __syncthreads();
    f32x4 accA[8], accX[8];
#pragma unroll
    for (int T = 0; T < 8; ++T) { accA[T] = (f32x4){0.f, 0.f, 0.f, 0.f}; accX[T] = (f32x4){0.f, 0.f, 0.f, 0.f}; }
    {
        bf16x8 afa[4], afx[4];
#pragma unroll
        for (int kk = 0; kk < 4; ++kk) { afa[kk] = *(const LAS bf16x8*)(F.lds + IMG1 + img_off(16 * w + fr, 4 * kk + fq)); afx[kk] = *(const LAS bf16x8*)(F.lds + IMG2 + img_off(16 * w + fr, 4 * kk + fq)); }
#pragma unroll
        for (int T = 0; T < 8; ++T)
#pragma unroll
            for (int kk = 0; kk < 4; ++kk) { const bf16x8 bfr = *(const LAS bf16x8*)(F.lds + IMG0 + img_off(16 * T + fr, 4 * kk + fq));
                accA[T] = __builtin_amdgcn_mfma_f32_16x16x32_bf16(afa[kk], bfr, accA[T], 0, 0, 0);
                accX[T] = __builtin_amdgcn_mfma_f32_16x16x32_bf16(afx[kk], bfr, accX[T], 0, 0, 0); }
    }
    const int chl = 16 * w + 4 * fq;
    float ba[4], bx[4], sp[4], H[4], Ap[4];
    { const f32x4 a = *(const f32x4*)(F.in[11] + 128 * h + chl), b = *(const f32x4*)(F.in[13] + 128 * h + chl), lm = *(const f32x4*)(F.in[14] + 128 * h + chl);
      ba[0] = a.x; ba[1] = a.y; ba[2] = a.z; ba[3] = a.w; bx[0] = b.x; bx[1] = b.y; bx[2] = b.z; bx[3] = b.w;
      const float lmv[4] = {lm.x, lm.y, lm.z, lm.w};
#pragma unroll
      for (int r = 0; r < 4; ++r) { const float xx = -lmv[r]; sp[r] = (xx > 0.f ? xx : 0.f) + log1pf(__expf(-fabsf(xx))); } }
#pragma unroll
    for (int r = 0; r < 4; ++r) { H[r] = 0.f; Ap[r] = 1.f; }
    if (APPLY) {
#pragma unroll
        for (int r = 0; r < 4; ++r) { float hh = 0.f;
#pragma unroll
            for (int p = 0; p < 4; ++p) { const f32x2 ab = cpart[p * 128 + chl + r]; hh = ab.x * hh + ab.y; }
            H[r] = hh; } }
#pragma unroll
    for (int T = 0; T < 8; ++T) { const int t = 16 * T + fr; const bool first = (tseq0 + t) == 0;
        const int o = img_off(t, 2 * w + (fq >> 1)) + (fq & 1) * 8;
        const u32x2 xw = *(const LAS u32x2*)(F.lds + IMG0 + o);
        const float xcv[4] = {bflo(xw.x), bfhi(xw.x), bflo(xw.y), bfhi(xw.y)};
        float gvv[4] = {0.f, 0.f, 0.f, 0.f};
        if (APPLY) { const u32x2 gw = *(const LAS u32x2*)(F.lds + IMG3 + o); gvv[0] = bflo(gw.x); gvv[1] = bfhi(gw.x); gvv[2] = bflo(gw.y); gvv[3] = bfhi(gw.y); }
        float yv[4];
#pragma unroll
        for (int r = 0; r < 4; ++r) {
            const float rg = sigmoidf_(accA[T][r] + ba[r]), ig = sigmoidf_(accX[T][r] + bx[r]);
            const float la = -8.0f * rg * sp[r]; const float a = __expf(la); const float x2 = 2.0f * la;
            const float m2 = (x2 > -0.25f) ? -x2 * (1.0f + x2 * 0.5f * (1.0f + x2 * (1.0f / 3.0f) * (1.0f + x2 * 0.25f * (1.0f + x2 * 0.2f * (1.0f + x2 * (1.0f / 6.0f)))))) : 1.0f - __expf(x2);
            const float mult = first ? 1.0f : sqrtf(m2);
            float A = a, B = mult * (ig * xcv[r]);
            { float Aq, Bq;
              Aq = DPP_F(1.0f, A, 0x111); Bq = DPP_F(0.0f, B, 0x111); B = A * Bq + B; A = A * Aq;
              Aq = DPP_F(1.0f, A, 0x112); Bq = DPP_F(0.0f, B, 0x112); B = A * Bq + B; A = A * Aq;
              Aq = DPP_F(1.0f, A, 0x114); Bq = DPP_F(0.0f, B, 0x114); B = A * Bq + B; A = A * Aq;
              Aq = DPP_F(1.0f, A, 0x118); Bq = DPP_F(0.0f, B, 0x118); B = A * Bq + B; A = A * Aq; }
            const float At = DPP_F(0.0f, A, 0x15F), Bt = DPP_F(0.0f, B, 0x15F);
            const float hv = A * H[r] + B;
            H[r] = At * H[r] + Bt; Ap[r] = Ap[r] * At;
            yv[r] = hv * gvv[r];
        }
        if (APPLY) {
            float q = (yv[0] * yv[0] + yv[1] * yv[1]) + (yv[2] * yv[2] + yv[3] * yv[3]);
            u32x2 ow; ow.x = pk2(yv[0], yv[1]); ow.y = pk2(yv[2], yv[3]);
            *(u32x2*)(Y + (size_t)(t0 + t) * DM + DG + 128 * h + chl) = ow;
            q += __shfl_xor(q, 16); q += __shfl_xor(q, 32);
            if (fq == 0) part[w * 128 + t] = q;
        }
    }
    if (!APPLY) { if (fr == 0) {
#pragma unroll
        for (int r = 0; r < 4; ++r) AGG[(size_t)c * DL + 128 * h + chl + r] = (f32x2){Ap[r], H[r]}; } }
    __syncthreads();
    if (APPLY) { if (tid < 128) { float s = 0.f;
#pragma unroll
        for (int k = 0; k < 8; ++k) s += part[k * 128 + tid];
        SSB[(size_t)(t0 + tid) * 8 + h] = s; } }
}

struct Args { const float* in[21]; float* out; unsigned char* ws; int ph_lo, ph_hi; };
__global__ void __launch_bounds__(NTHR, 2) mk_fwd(Args args) {
    extern __shared__ __attribute__((aligned(16))) unsigned char lds_raw[];
    Frame F;
    F.lds = (LAS uchar*)lds_raw; F.tid = threadIdx.x; F.lane = F.tid & 63; F.wave = __builtin_amdgcn_readfirstlane(F.tid >> 6); F.G = gridDim.x; F.bid = blockIdx.x;
#pragma unroll
    for (int i = 0; i < 21; ++i) F.in[i] = args.in[i];
    F.out = args.out; F.ws = args.ws;
    const int lo = args.ph_lo, hi = args.ph_hi;
#define IN(k) (lo <= (k) && (k) < hi)
#if MK_N_LAUNCHES == 1
#define SEAM(k) do { if (IN(k) && IN((k) + 1)) cg::this_grid().sync(); } while (0)
#else
#define SEAM(k) do { } while (0)
#endif
    uchar* ws = args.ws;
    bf16* A1 = (bf16*)(ws + WS_A1); bf16* Zb = (bf16*)(ws + WS_Z); bf16* Yb = (bf16*)(ws + WS_Y); bf16* Ob = (bf16*)(ws + WS_O); bf16* PEb = (bf16*)(ws + WS_PE);

    if (IN(0)) { p0_prologue(F); __syncthreads(); }
    SEAM(0);
    if (IN(1)) {
        { pg8::Gemm g{A1, (const bf16*)(ws + WS_WIN), M, NZ, DM}; pg8::StaticOrder S; S.init(M, NZ, F.G, F.bid);
          pg8::EpiZ E{Zb, NZ, (pg8::f32x2*)(ws + WS_VST)};
          pg8::gemm_phase<pg8::EpiZ, pg8::StaticOrder, true, true>(F.lds, g, S, E); }
        { pg8::Gemm g{(const bf16*)(ws + WS_PBF), (const bf16*)(ws + WS_WPE), M, DM, DP}; pg8::StaticOrder S; S.init(M, DM, F.G, F.bid);
          pg8::EpiPlain E{PEb, DM};
          pg8::gemm_phase<pg8::EpiPlain, pg8::StaticOrder, true, true>(F.lds, g, S, E); }
    }
    SEAM(1);
    if (IN(2)) {
        int cur = -1;
        for (int u = F.bid; u < 2048; u += F.G) { const int h = u & 7, c = u >> 3;
            if (h != cur) { __syncthreads(); load_img(F.lds + IMG1, (const bf16*)(ws + WS_WSM) + (size_t)h * 16384, F.tid); cur = h; }
            gmlp_unit(F, c, h); }
        cur = -1;
        for (int u = F.bid; u < 2048; u += F.G) { const int h = u & 7, c = u >> 3;
            if (h != cur) { __syncthreads(); load_img(F.lds + IMG1, (const bf16*)(ws + WS_WA) + (size_t)h * 16384, F.tid); load_img(F.lds + IMG2, (const bf16*)(ws + WS_WX) + (size_t)h * 16384, F.tid); cur = h; }
            lru_unit<false>(F, c, h); }
        __syncthreads();
    }
    SEAM(2);
    if (IN(3)) {
        int cur = -1;
        for (int u = F.bid; u < 2048; u += F.G) { const int h = u & 7, c = u >> 3;
            if (h != cur) { __syncthreads(); load_img(F.lds + IMG1, (const bf16*)(ws + WS_WA) + (size_t)h * 16384, F.tid); load_img(F.lds + IMG2, (const bf16*)(ws + WS_WX) + (size_t)h * 16384, F.tid); cur = h; }
            lru_unit<true>(F, c, h); }
        __syncthreads();
    }
    SEAM(3);
    if (IN(4)) {
        const float* SSA = (const float*)(ws + WS_SSA); const float* SSB = (const float*)(ws + WS_SSB);
        const int gw = F.bid * NWAVES + F.wave, NGW = F.G * NWAVES;
        for (int m = gw; m < M; m += NGW) {
            const f32x4 a0 = *(const f32x4*)(SSA + (size_t)m * 8), a1 = *(const f32x4*)(SSA + (size_t)m * 8 + 4), b0 = *(const f32x4*)(SSB + (size_t)m * 8), b1 = *(const f32x4*)(SSB + (size_t)m * 8 + 4);
            const float ra = 1.0f / sqrtf(((a0.x + a0.y) + (a0.z + a0.w) + (a1.x + a1.y) + (a1.z + a1.w)) * (1.0f / DG) + EPS);
            const float rb = 1.0f / sqrtf(((b0.x + b0.y) + (b0.z + b0.w) + (b1.x + b1.y) + (b1.z + b1.w)) * (1.0f / DL) + EPS);
            u32x4* yr = (u32x4*)(Yb + (size_t)m * DM) + F.lane;
#pragma unroll
            for (int j = 0; j < 4; ++j) { const float sc = j < 2 ? ra : rb; u32x4 v = yr[64 * j];
                v.x = pk2(bflo(v.x) * sc, bfhi(v.x) * sc); v.y = pk2(bflo(v.y) * sc, bfhi(v.y) * sc); v.z = pk2(bflo(v.z) * sc, bfhi(v.z) * sc); v.w = pk2(bflo(v.w) * sc, bfhi(v.w) * sc);
                yr[64 * j] = v; }
        }
    }
    SEAM(4);
    if (IN(5)) {
        pg8::Gemm g{Yb, (const bf16*)(ws + WS_WOUT), M, DM, DM}; pg8::StaticOrder S; S.init(M, DM, F.G, F.bid);
        pg8::EpiO E{Ob, DM, (float*)(ws + WS_SSO)};
        pg8::gemm_phase<pg8::EpiO, pg8::StaticOrder, true, true>(F.lds, g, S, E);
    }
    SEAM(5);
    if (IN(6)) {
        const float* SSO = (const float*)(ws + WS_SSO); const float* x = F.in[0]; const float* pg = F.in[18];
        const int gw = F.bid * NWAVES + F.wave, NGW = F.G * NWAVES;
        for (int m = gw; m < M; m += NGW) {
            float s = (F.lane < 32) ? SSO[(size_t)m * 32 + F.lane] : 0.f; s = wave_sum(s);
            const float rstd = 1.0f / sqrtf(s * (1.0f / DM) + EPS);
            const f32x4* xr = (const f32x4*)(x + (size_t)m * DM) + F.lane; const u32x2* orow = (const u32x2*)(Ob + (size_t)m * DM) + F.lane;
            f32x4* outr = (f32x4*)(F.out + (size_t)m * DM) + F.lane; u32x2* hr = (u32x2*)(A1 + (size_t)m * DM) + F.lane;
#pragma unroll
            for (int j = 0; j < 8; ++j) { const f32x4 xv = xr[64 * j]; const u32x2 ov = orow[64 * j]; const f32x4 g = ((const f32x4*)pg)[F.lane + 64 * j];
                f32x4 hv; hv.x = xv.x + bflo(ov.x) * rstd * g.x; hv.y = xv.y + bfhi(ov.x) * rstd * g.y; hv.z = xv.z + bflo(ov.y) * rstd * g.z; hv.w = xv.w + bfhi(ov.y) * rstd * g.w;
                outr[64 * j] = hv; u32x2 hb; hb.x = pk2(hv.x, hv.y); hb.y = pk2(hv.z, hv.w); hr[64 * j] = hb; }
        }
    }
    SEAM(6);
    if (IN(7)) {
        pg8::Gemm g{A1, (const bf16*)(ws + WS_WPG), M, DM, DM}; pg8::StaticOrder S; S.init(M, DM, F.G, F.bid);
        pg8::EpiOut E{F.out, PEb, DM};
        pg8::gemm_phase<pg8::EpiOut, pg8::StaticOrder, true, true>(F.lds, g, S, E);
    }
#undef IN
#undef SEAM
}

extern "C" void kernel_launch(void* const* d_in, const int* in_sizes, int n_in, void* d_out, int out_size, void* d_ws, size_t ws_size, hipStream_t stream) {
    static int grid = 0;
    if (grid == 0) {
        if (n_in != 21 || in_sizes[0] != M * DM || out_size != M * DM || ws_size < WS_END) { fprintf(stderr, "kernel_launch: unexpected problem (n_in %d, in0 %d, out %d, ws %zu); nothing launched\n", n_in, n_in > 0 ? in_sizes[0] : -1, out_size, ws_size); grid = -1; return; }
        int dev = 0, cus = 0, per_cu = 0;
        if (hipGetDevice(&dev) != hipSuccess || hipDeviceGetAttribute(&cus, hipDeviceAttributeMultiprocessorCount, dev) != hipSuccess) { fprintf(stderr, "kernel_launch: device query failed\n"); grid = -1; return; }
        if (hipFuncSetAttribute((const void*)mk_fwd, hipFuncAttributeMaxDynamicSharedMemorySize, LDS_BYTES) != hipSuccess) { fprintf(stderr, "kernel_launch: hipFuncSetAttribute failed\n"); grid = -1; return; }
        if (hipOccupancyMaxActiveBlocksPerMultiprocessor(&per_cu, (const void*)mk_fwd, NTHR, LDS_BYTES) != hipSuccess || per_cu < 1) { fprintf(stderr, "kernel_launch: occupancy query says %d blocks per CU\n", per_cu); per_cu = 1; }
        (void)hipGetLastError();
        grid = cus;
    }
    if (grid < 0) return;
    Args a{};
    for (int i = 0; i < 21; ++i) a.in[i] = (const float*)d_in[i];
    a.out = (float*)d_out; a.ws = (unsigned char*)d_ws;
#if MK_N_LAUNCHES == 1
    a.ph_lo = 0; a.ph_hi = N_PHASES;
    void* kargs[] = {&a};
    hipError_t e = hipLaunchCooperativeKernel((const void*)mk_fwd, dim3(grid), dim3(NTHR), kargs, LDS_BYTES, stream);
    if (e != hipSuccess) fprintf(stderr, "kernel_launch: cooperative launch failed: %s (grid %d)\n", hipGetErrorString(e), grid);
#else
    for (int li = 0; li < N_PHASES; ++li) { a.ph_lo = li; a.ph_hi = li + 1;
        hipLaunchKernelGGL(mk_fwd, dim3(grid), dim3(NTHR), LDS_BYTES, stream, a);
        const hipError_t le = hipPeekAtLastError(); if (le != hipSuccess) { fprintf(stderr, "kernel_launch: launch %d failed: %s\n", li, hipGetErrorName(le)); break; } }
#endif
}
```

```cpp
#define MK_N_LAUNCHES 1
#include <hip/hip_runtime.h>
#include <hip/hip_cooperative_groups.h>
#include <cstdio>
#include <cstdint>
namespace cg = cooperative_groups;
namespace pg8 {
#define PG8_LAS __attribute__((address_space(3)))
typedef unsigned short bf16_t;
typedef short bf16x8 __attribute__((ext_vector_type(8)));
typedef float f32x4 __attribute__((ext_vector_type(4)));
typedef unsigned u32x4 __attribute__((ext_vector_type(4)));
constexpr int BM = 256, BK = 64, HALF = 128, HTB = HALF * BK * 2  , STAGE_BYTES = 8 * HTB, NXCD = 8, WGM = 8;

__host__ __device__ __forceinline__ int lds_byte(int r, int c) { const int st = (r >> 4) * 2 + (c >> 5), rr = r & 15, cc = c & 31, ob = rr * 64 + cc * 2; return st * 1024 + (ob ^ (((ob >> 9) & 1) << 5)); }
__host__ __device__ __forceinline__ void stage_rc(int b, int& R, int& C) { const int st = b / 1024, sb = b % 1024, swz = sb ^ (((sb >> 9) & 1) << 5); R = (st >> 1) * 16 + swz / 64; C = (st & 1) * 32 + (swz % 64) / 2; }
__host__ __device__ __forceinline__ int perm32(int rho) { const int n = rho >> 4, i = rho & 15; return 8 * (i >> 2) + 4 * n + (i & 3); }

struct Unit { int pm, pn; };
struct Gemm { const bf16_t* A; const bf16_t* Bt; int M, N, K; };

struct StaticOrder {
    int nM, nN, nwg, G, c;
    __host__ __device__ void init(int M, int N, int G_, int c_) { nM = M / BM; nN = N / BM; nwg = nM * nN; G = G_; c = c_; }
    __host__ __device__ bool next(int i, Unit& u) const {
        const long L = (long)i * G + c; if (L >= nwg) return false;
        int wgid = (int)L; { const int q = nwg / NXCD, r = nwg % NXCD, xcd = wgid % NXCD, off = wgid / NXCD; wgid = (xcd < r ? xcd * (q + 1) : r * (q + 1) + (xcd - r) * q) + off; }
        const int nig = WGM * nN, gid = wgid / nig, fm = gid * WGM, gsz = (nM - fm) < WGM ? (nM - fm) : WGM;
        u.pm = fm + ((wgid % nig) % gsz); u.pn = (wgid % nig) / gsz; return true;
    }
    __device__ __forceinline__ void a_ready(const Unit&) const {}
    __device__ __forceinline__ void done(const Unit&) const {}
};

__device__ __forceinline__ unsigned cvt_pk_bf16(float lo, float hi) { unsigned r; asm volatile("v_cvt_pk_bf16_f32 %0, %1, %2" : "=v"(r) : "v"(lo), "v"(hi)); return r; }
typedef float f32x2 __attribute__((ext_vector_type(2)));
typedef unsigned u32x2 __attribute__((ext_vector_type(2)));
__device__ __forceinline__ float fast_sigmoid(float x) { return __builtin_amdgcn_rcpf(1.0f + __expf(-x)); }

struct EpiPlain {
    static constexpr bool PERM = true, AFTER_DRAIN = false;
    bf16_t* O; int ldc;
    __device__ __forceinline__ void operator()(const f32x4 (&acc)[2][2][4][2], const Unit& u, int wr, int wc, int fr, int fq) const {
        const int row0 = u.pm * BM + wr * 64 + fr, col0 = u.pn * BM + wc * 32 + 8 * fq;
#pragma unroll
        for (int ai = 0; ai < 2; ++ai)
#pragma unroll
            for (int m = 0; m < 4; ++m) { bf16_t* rowp = O + (size_t)(row0 + ai * HALF + m * 16) * ldc + col0;
#pragma unroll
                for (int bj = 0; bj < 2; ++bj) { const f32x4 v0 = acc[ai][bj][m][0], v1 = acc[ai][bj][m][1];
                    u32x4 w; w.x = cvt_pk_bf16(v0[0], v0[1]); w.y = cvt_pk_bf16(v0[2], v0[3]); w.z = cvt_pk_bf16(v1[0], v1[1]); w.w = cvt_pk_bf16(v1[2], v1[3]);
                    *(u32x4*)(rowp + bj * HALF) = w; } }
    }
};

struct EpiZ {
    static constexpr bool PERM = true, AFTER_DRAIN = false;
    bf16_t* Z; int ldc; f32x2* vst;
    __device__ __forceinline__ void operator()(const f32x4 (&acc)[2][2][4][2], const Unit& u, int wr, int wc, int fr, int fq) const {
        const int row0 = u.pm * BM + wr * 64 + fr, col0 = u.pn * BM + wc * 32 + 8 * fq;
        const int grp = u.pn >> 2;
#pragma unroll
        for (int ai = 0; ai < 2; ++ai)
#pragma unroll
            for (int m = 0; m < 4; ++m) { const int row = row0 + ai * HALF + m * 16; bf16_t* rowp = Z + (size_t)row * ldc + col0;
                float s = 0.f, q = 0.f;
#pragma unroll
                for (int bj = 0; bj < 2; ++bj) { f32x4 v[2] = {acc[ai][bj][m][0], acc[ai][bj][m][1]};
                    if (grp != 3) {
#pragma unroll
                        for (int n = 0; n < 2; ++n)
#pragma unroll
                            for (int j = 0; j < 4; ++j) { const float x = v[n][j]; const float a = (grp < 2) ? 1.5957691216f * (x + 0.044715f * x * x * x) : x; v[n][j] = x * fast_sigmoid(a); }
                    }
                    if (grp == 1) {
#pragma unroll
                        for (int n = 0; n < 2; ++n)
#pragma unroll
                            for (int j = 0; j < 4; ++j) { s += v[n][j]; q += v[n][j] * v[n][j]; }
                    }
                    u32x4 w; w.x = cvt_pk_bf16(v[0][0], v[0][1]); w.y = cvt_pk_bf16(v[0][2], v[0][3]); w.z = cvt_pk_bf16(v[1][0], v[1][1]); w.w = cvt_pk_bf16(v[1][2], v[1][3]);
                    *(u32x4*)(rowp + bj * HALF) = w; }
                if (grp == 1) { s += __shfl_xor(s, 16); s += __shfl_xor(s, 32); q += __shfl_xor(q, 16); q += __shfl_xor(q, 32);
                    if (fq == 0) vst[(size_t)row * 16 + (u.pn - 4) * 4 + wc] = (f32x2){s, q}; }
            }
    }
};

struct EpiO {
    static constexpr bool PERM = true, AFTER_DRAIN = false;
    bf16_t* O; int ldc; float* sso;
    __device__ __forceinline__ void operator()(const f32x4 (&acc)[2][2][4][2], const Unit& u, int wr, int wc, int fr, int fq) const {
        const int row0 = u.pm * BM + wr * 64 + fr, col0 = u.pn * BM + wc * 32 + 8 * fq;
#pragma unroll
        for (int ai = 0; ai < 2; ++ai)
#pragma unroll
            for (int m = 0; m < 4; ++m) { const int row = row0 + ai * HALF + m * 16; bf16_t* rowp = O + (size_t)row * ldc + col0;
                float q = 0.f;
#pragma unroll
                for (int bj = 0; bj < 2; ++bj) { const f32x4 v0 = acc[ai][bj][m][0], v1 = acc[ai][bj][m][1];
#pragma unroll
                    for (int j = 0; j < 4; ++j) { q += v0[j] * v0[j]; q += v1[j] * v1[j]; }
                    u32x4 w; w.x = cvt_pk_bf16(v0[0], v0[1]); w.y = cvt_pk_bf16(v0[2], v0[3]); w.z = cvt_pk_bf16(v1[0], v1[1]); w.w = cvt_pk_bf16(v1[2], v1[3]);
                    *(u32x4*)(rowp + bj * HALF) = w; }
                q += __shfl_xor(q, 16); q += __shfl_xor(q, 32);
                if (fq == 0) sso[(size_t)row * 32 + u.pn * 4 + wc] = q;
            }
    }
};

struct EpiOut {
    static constexpr bool PERM = false, AFTER_DRAIN = false;
    float* out; const bf16_t* pe; int ldc;
    __device__ __forceinline__ void operator()(const f32x4 (&acc)[2][2][4][2], const Unit& u, int wr, int wc, int fr, int fq) const {
        const int row0 = u.pm * BM + wr * 64 + fr, col0 = u.pn * BM + wc * 32 + 4 * fq;
#pragma unroll
        for (int ai = 0; ai < 2; ++ai)
#pragma unroll
            for (int m = 0; m < 4; ++m) { const size_t off = (size_t)(row0 + ai * HALF + m * 16) * ldc + col0;
#pragma unroll
                for (int bj = 0; bj < 2; ++bj)
#pragma unroll
                    for (int n = 0; n < 2; ++n) { const size_t o2 = off + bj * HALF + n * 16;
                        const f32x4 h1 = *(const f32x4*)(out + o2); const u32x2 pw = *(const u32x2*)(pe + o2); const f32x4 a = acc[ai][bj][m][n];
                        f32x4 r;
                        r[0] = h1[0] + __uint_as_float(pw.x << 16) * fast_sigmoid(a[0]);
                        r[1] = h1[1] + __uint_as_float(pw.x & 0xffff0000u) * fast_sigmoid(a[1]);
                        r[2] = h1[2] + __uint_as_float(pw.y << 16) * fast_sigmoid(a[2]);
                        r[3] = h1[3] + __uint_as_float(pw.y & 0xffff0000u) * fast_sigmoid(a[3]);
                        *(f32x4*)(out + o2) = r; }
                asm volatile("" ::: "memory"); }
    }
};

template <class Epi, class Sched, bool ALIGN_EPI = false, bool SP2 = false>
__device__ __forceinline__ void gemm_phase(PG8_LAS unsigned char* lds, const Gemm g, const Sched& S, const Epi& E, int tid_in) {
    int tid_ = tid_in; asm volatile("" : "+v"(tid_));
    const int tid = tid_, wid = __builtin_amdgcn_readfirstlane(tid >> 6), lane = tid & 63, wr = wid >> 2, wc = wid & 3, fr = lane & 15, fq = lane >> 4;
    const int K = g.K, nt = K / BK;
    unsigned voffA[2], voffB[2];
#pragma unroll
    for (int i = 0; i < 2; ++i) { int R, C; stage_rc(tid * 16 + i * 8192, R, C); const int Rb = Epi::PERM ? ((R & ~31) + perm32(R & 31)) : R;
        voffA[i] = (unsigned)(R * K + C) * 2u; voffB[i] = (unsigned)(Rb * K + C) * 2u; }
    const size_t kstep = (size_t)(BK * 2);
    const size_t hstep = (size_t)HALF * K * 2;
    const size_t tstep = 2 * hstep;
    const unsigned ldsw = (unsigned)wid * 1024u;
    const int aoff = lds_byte(wr * 64 + fr, fq * 8), boff = lds_byte(wc * 32 + fr, fq * 8);
#define PG8_SA(b, h) (((b) * 2 + (h)) * HTB)
#define PG8_SB(b, h) ((4 + (b) * 2 + (h)) * HTB)
#define PG8_STAGE(bufoff, gbase, voff) do { _Pragma("unroll") for (int _i = 0; _i < 2; ++_i) \
        __builtin_amdgcn_global_load_lds((const unsigned*)((const char*)(gbase) + (voff)[_i]), (PG8_LAS unsigned*)(lds + (bufoff) + ldsw + _i * 8192), 16, 0, 0); } while (0)
#define PG8_LDA(dst, b, h) do { _Pragma("unroll") for (int m = 0; m < 4; ++m) _Pragma("unroll") for (int k = 0; k < 2; ++k) dst[m][k] = *(const PG8_LAS bf16x8*)(lds + PG8_SA(b, h) + aoff + m * 2048 + k * 1024); } while (0)
#define PG8_LDB(dst, b, h) do { _Pragma("unroll") for (int n = 0; n < 2; ++n) _Pragma("unroll") for (int k = 0; k < 2; ++k) dst[n][k] = *(const PG8_LAS bf16x8*)(lds + PG8_SB(b, h) + boff + n * 2048 + k * 1024); } while (0)
#define PG8_MMA(ai, bj, At, Bt) do { __builtin_amdgcn_s_setprio(1); _Pragma("unroll") for (int m = 0; m < 4; ++m) _Pragma("unroll") for (int n = 0; n < 2; ++n) _Pragma("unroll") for (int k = 0; k < 2; ++k) \
        acc[ai][bj][m][n] = __builtin_amdgcn_mfma_f32_16x16x32_bf16(Bt[n][k], At[m][k], acc[ai][bj][m][n], 0, 0, 0); __builtin_amdgcn_s_setprio(0); } while (0)
#define PG8_WAIT_V(n) asm volatile("s_waitcnt vmcnt(" #n ")" ::: "memory")
#define PG8_WAIT_L(n) asm volatile("s_waitcnt lgkmcnt(" #n ")" ::: "memory")
#define PG8_BAR __builtin_amdgcn_s_barrier()
#define PG8_SCHED __builtin_amdgcn_sched_barrier(0)
    Unit cur, nxt; int ui = 0;
    if (!S.next(0, cur)) return;
    f32x4 acc[2][2][4][2];
#pragma unroll
    for (int a = 0; a < 2; ++a)
#pragma unroll
        for (int b = 0; b < 2; ++b)
#pragma unroll
            for (int m = 0; m < 4; ++m)
#pragma unroll
                for (int n = 0; n < 2; ++n) acc[a][b][m][n] = (f32x4){0.f, 0.f, 0.f, 0.f};
    bf16x8 At[4][2], B0[2][2], B1[2][2];
    const char* cA = (const char*)g.A + (size_t)cur.pm * tstep; const char* cB = (const char*)g.Bt + (size_t)cur.pn * tstep;
    S.a_ready(cur);
    if constexpr (SP2) {
        PG8_STAGE(PG8_SB(0, 0), cB, voffB); PG8_STAGE(PG8_SB(0, 1), cB + hstep, voffB); PG8_STAGE(PG8_SA(0, 0), cA, voffA); PG8_STAGE(PG8_SA(0, 1), cA + hstep, voffA);
        if (wr == 1) PG8_BAR;
        PG8_WAIT_V(2); PG8_BAR;
        PG8_STAGE(PG8_SB(1, 0), cB + kstep, voffB); PG8_STAGE(PG8_SA(1, 0), cA + kstep, voffA); PG8_STAGE(PG8_SB(1, 1), cB + hstep + kstep, voffB);
        PG8_WAIT_V(6); PG8_BAR;
    } else {
        PG8_STAGE(PG8_SB(0, 0), cB, voffB); PG8_STAGE(PG8_SA(0, 0), cA, voffA); PG8_STAGE(PG8_SB(0, 1), cB + hstep, voffB); PG8_STAGE(PG8_SA(0, 1), cA + hstep, voffA);
        if (wr == 1) PG8_BAR;
        PG8_WAIT_V(4); PG8_BAR;
        PG8_STAGE(PG8_SB(1, 0), cB + kstep, voffB); PG8_STAGE(PG8_SA(1, 0), cA + kstep, voffA); PG8_STAGE(PG8_SB(1, 1), cB + hstep + kstep, voffB);
        PG8_WAIT_V(6); PG8_BAR;
    }
    for (;;) {
        const bool has_next = S.next(ui + 1, nxt);
        const char* nA = has_next ? (const char*)g.A + (size_t)nxt.pm * tstep : cA; const char* nB = has_next ? (const char*)g.Bt + (size_t)nxt.pn * tstep : cB;
        for (int t = 0; t < nt; t += 2) {
            const bool last = (t == nt - 2);
            const char* a1 = cA + (size_t)(t + 1) * kstep;
            const char* a2 = last ? nA : cA + (size_t)(t + 2) * kstep; const char* b2 = last ? nB : cB + (size_t)(t + 2) * kstep;
            const char* a3 = a2 + kstep; const char* b3 = b2 + kstep;
            if (last && has_next) S.a_ready(nxt);
            if constexpr (SP2) {
            PG8_LDB(B0, 0, 0); PG8_LDB(B1, 0, 1); PG8_SCHED; PG8_LDA(At, 0, 0); PG8_STAGE(PG8_SA(1, 1), a1 + hstep, voffA);
            PG8_WAIT_V(8); PG8_WAIT_L(0); PG8_BAR; PG8_MMA(0, 0, At, B0); PG8_MMA(0, 1, At, B1); PG8_BAR; PG8_SCHED;
            PG8_LDA(At, 0, 1); PG8_STAGE(PG8_SB(0, 0), b2, voffB); PG8_STAGE(PG8_SB(0, 1), b2 + hstep, voffB); PG8_STAGE(PG8_SA(0, 0), a2, voffA);
            PG8_WAIT_V(8); PG8_WAIT_L(0); PG8_BAR; PG8_MMA(1, 0, At, B0); PG8_MMA(1, 1, At, B1); PG8_BAR; PG8_SCHED;
            PG8_LDB(B0, 1, 0); PG8_LDB(B1, 1, 1); PG8_SCHED; PG8_LDA(At, 1, 0); PG8_STAGE(PG8_SA(0, 1), a2 + hstep, voffA);
            PG8_WAIT_V(8); PG8_WAIT_L(0); PG8_BAR; PG8_MMA(0, 0, At, B0); PG8_MMA(0, 1, At, B1); PG8_BAR; PG8_SCHED;
            PG8_LDA(At, 1, 1); PG8_STAGE(PG8_SB(1, 0), b3, voffB); PG8_STAGE(PG8_SB(1, 1), b3 + hstep, voffB); PG8_STAGE(PG8_SA(1, 0), a3, voffA);
            PG8_WAIT_V(8); PG8_WAIT_L(0); PG8_BAR; PG8_MMA(1, 0, At, B0); PG8_MMA(1, 1, At, B1); PG8_BAR; PG8_SCHED;
            } else {
            PG8_LDB(B0, 0, 0); PG8_SCHED; PG8_LDA(At, 0, 0); PG8_STAGE(PG8_SA(1, 1), a1 + hstep, voffA);
            PG8_WAIT_L(8); PG8_BAR; PG8_WAIT_L(0); PG8_MMA(0, 0, At, B0); PG8_BAR; PG8_SCHED;
            PG8_LDB(B1, 0, 1); PG8_STAGE(PG8_SB(0, 0), b2, voffB);
            PG8_BAR; PG8_WAIT_L(0); PG8_MMA(0, 1, At, B1); PG8_BAR;
            PG8_LDA(At, 0, 1); PG8_STAGE(PG8_SA(0, 0), a2, voffA);
            PG8_BAR; PG8_WAIT_L(0); PG8_MMA(1, 0, At, B0); PG8_BAR; PG8_SCHED;
            PG8_STAGE(PG8_SB(0, 1), b2 + hstep, voffB);
            PG8_WAIT_V(6); PG8_BAR; PG8_MMA(1, 1, At, B1); PG8_BAR;
            PG8_LDB(B0, 1, 0); PG8_SCHED; PG8_LDA(At, 1, 0); PG8_STAGE(PG8_SA(0, 1), a2 + hstep, voffA);
            PG8_WAIT_L(8); PG8_BAR; PG8_WAIT_L(0); PG8_MMA(0, 0, At, B0); PG8_BAR; PG8_SCHED;
            PG8_LDB(B1, 1, 1); PG8_STAGE(PG8_SB(1, 0), b3, voffB);
            PG8_BAR; PG8_WAIT_L(0); PG8_MMA(0, 1, At, B1); PG8_BAR;
            PG8_LDA(At, 1, 1); PG8_STAGE(PG8_SA(1, 0), a3, voffA);
            PG8_BAR; PG8_WAIT_L(0); PG8_MMA(1, 0, At, B0); PG8_BAR; PG8_SCHED;
            PG8_STAGE(PG8_SB(1, 1), b3 + hstep, voffB);
            PG8_WAIT_V(6); PG8_BAR; PG8_MMA(1, 1, At, B1); PG8_BAR;
            }
        }
        if constexpr (ALIGN_EPI) { if (wr == 0) PG8_BAR; }
        if constexpr (!Epi::AFTER_DRAIN) { E(acc, cur, wr, wc, fr, fq); S.done(cur); }
        if (!has_next) break;
#pragma unroll
        for (int a = 0; a < 2; ++a)
#pragma unroll
            for (int b = 0; b < 2; ++b)
#pragma unroll
                for (int m = 0; m < 4; ++m)
#pragma unroll
                    for (int n = 0; n < 2; ++n) acc[a][b][m][n] = (f32x4){0.f, 0.f, 0.f, 0.f};
        cur = nxt; cA = nA; cB = nB; ++ui;
        if constexpr (ALIGN_EPI) { if (wr == 1) PG8_BAR; }
    }
    PG8_WAIT_V(0);
    if constexpr (!ALIGN_EPI) { if (wr == 0) PG8_BAR; }
    PG8_BAR;
    if constexpr (Epi::AFTER_DRAIN) { E.fused(acc, cur, wr, wc, fr, fq, lds, wid, lane); S.done(cur); }
#undef PG8_SA
#undef PG8_SB
#undef PG8_STAGE
#undef PG8_LDA
#undef PG8_LDB
#undef PG8_MMA
#undef PG8_WAIT_V
#undef PG8_WAIT_L
#undef PG8_BAR
#undef PG8_SCHED
}
}

constexpr int BATCH = 4, SEQ = 8192, DM = 2048, M = BATCH * SEQ, DG = 1024, DL = 1024, NZ = 5120, DP = 256, CHK = 128, NH = 8;
constexpr float EPS = 1e-6f;
constexpr int NWAVES = 8, NTHR = NWAVES * 64;
#ifndef MK_N_LAUNCHES
#define MK_N_LAUNCHES 1
#endif
constexpr int N_PHASES = 8;

constexpr size_t MiB = 1u << 20;
constexpr size_t WS_WIN = 2 * MiB;
constexpr size_t WS_WOUT = 22 * MiB;
constexpr size_t WS_WPG = 30 * MiB;
constexpr size_t WS_WPE = 38 * MiB;
constexpr size_t WS_WA = 39 * MiB;
constexpr size_t WS_WX = WS_WA + 256 * 1024;
constexpr size_t WS_WSM = WS_WX + 256 * 1024;
constexpr size_t WS_VST = 40 * MiB;
constexpr size_t WS_SSA = 44 * MiB;
constexpr size_t WS_SSB = 45 * MiB;
constexpr size_t WS_SSO = 46 * MiB;
constexpr size_t WS_AGG = 50 * MiB;
constexpr size_t WS_A1 = 64 * MiB;
constexpr size_t WS_PBF = 192 * MiB;
constexpr size_t WS_PE = 208 * MiB;
constexpr size_t WS_Z = 336 * MiB;
constexpr size_t WS_Y = 656 * MiB;
constexpr size_t WS_O = 784 * MiB;
constexpr size_t WS_END = 912 * MiB;

constexpr int LDS_BYTES = 147456;
constexpr int IMG0 = 0, IMG1 = 32768, IMG2 = 65536, IMG3 = 98304, MISC = 131072;
constexpr int MISC_STAT = MISC, MISC_PART = MISC + 1024, MISC_CPART = MISC + 5120;

#define LAS __attribute__((address_space(3)))
typedef unsigned short bf16;
typedef unsigned char uchar;
typedef float f32x4 __attribute__((ext_vector_type(4)));
typedef float f32x2 __attribute__((ext_vector_type(2)));
typedef unsigned u32x4 __attribute__((ext_vector_type(4)));
typedef unsigned u32x2 __attribute__((ext_vector_type(2)));
typedef short bf16x8 __attribute__((ext_vector_type(8)));

__device__ __forceinline__ unsigned f2bf(float f) { unsigned u = __builtin_bit_cast(unsigned, f); return (u + 0x7fffu + ((u >> 16) & 1u)) >> 16; }
__device__ __forceinline__ unsigned pk2(float lo, float hi) { return f2bf(lo) | (f2bf(hi) << 16); }
__device__ __forceinline__ float bflo(unsigned w) { return __uint_as_float(w << 16); }
__device__ __forceinline__ float bfhi(unsigned w) { return __uint_as_float(w & 0xffff0000u); }
__device__ __forceinline__ float wave_sum(float v) {
#pragma unroll
    for (int o = 1; o < 64; o <<= 1) v += __shfl_xor(v, o);
    return v;
}
__device__ __forceinline__ float sigmoidf_(float x) { return __builtin_amdgcn_rcpf(1.0f + __expf(-x)); }

struct Args { const float* in[21]; float* out; unsigned char* ws; int ph_lo, ph_hi; };
typedef const __attribute__((address_space(4))) Args* ArgP;
struct Frame {
    LAS uchar* lds;
    int tid, lane, wave, G, bid;
    int wv;
    ArgP ap;
};
#define PHASE_BEGIN(F) do { int w_ = (F).wv; unsigned z_ = 0u; ArgP a_ = (ArgP)__builtin_amdgcn_kernarg_segment_ptr(); asm volatile("" : "+s"(w_), "+s"(a_), "+s"(z_)); \
    const int l_ = (int)__builtin_amdgcn_mbcnt_hi(~0u, __builtin_amdgcn_mbcnt_lo(~0u, z_));     \
    (F).lane = l_; (F).wave = w_; (F).tid = w_ * 64 + l_; (F).ap = a_; } while (0)

__device__ __forceinline__ void p0_transpose_item(const float* W, int K, int N, bf16* WT, LAS float* scr, int item, int lane, const float* ks0, const float* ks1, int ksplit) {
    const int nblk = N / 32, kb = item / nblk, nb = item % nblk, k0 = 64 * kb, n0 = 32 * nb;
#pragma unroll 8
    for (int i = 0; i < 32; ++i) { const int kk = 2 * i + (lane >> 5); float v = W[(size_t)(k0 + kk) * N + n0 + (lane & 31)];
        if (ks0) { const int k = k0 + kk; v *= (k < ksplit) ? ks0[k] : ks1[k - ksplit]; }
        scr[kk * 33 + (lane & 31)] = v; }
    asm volatile("s_waitcnt lgkmcnt(0)" ::: "memory");
    const int c = lane & 7;
#pragma unroll
    for (int j = 0; j < 4; ++j) { const int n = (lane >> 3) + 8 * j; const LAS float* s = scr + (8 * c) * 33 + n;
        u32x4 o; o.x = pk2(s[0 * 33], s[1 * 33]); o.y = pk2(s[2 * 33], s[3 * 33]); o.z = pk2(s[4 * 33], s[5 * 33]); o.w = pk2(s[6 * 33], s[7 * 33]);
        *(u32x4*)(WT + (size_t)(n0 + n) * K + k0 + 8 * c) = o; }
    asm volatile("s_waitcnt lgkmcnt(0)" ::: "memory");
}

__device__ __forceinline__ void p0_prologue(Frame& F) {
    LAS float* scr = (LAS float*)(F.lds + F.wave * 16384);
    const int gw = F.bid * NWAVES + F.wave, NGW = F.G * NWAVES;
    const float* w_in = F.ap->in[3]; const float* w_out = F.ap->in[17]; const float* w_pe = F.ap->in[19]; const float* w_pg = F.ap->in[20];
    const float* w_a = F.ap->in[10]; const float* w_x = F.ap->in[12];
    bf16* WIN = (bf16*)(((uchar*)F.ap->ws) + WS_WIN); bf16* WOUT = (bf16*)(((uchar*)F.ap->ws) + WS_WOUT); bf16* WPG = (bf16*)(((uchar*)F.ap->ws) + WS_WPG); bf16* WPE = (bf16*)(((uchar*)F.ap->ws) + WS_WPE);
    bf16* WA = (bf16*)(((uchar*)F.ap->ws) + WS_WA); bf16* WX = (bf16*)(((uchar*)F.ap->ws) + WS_WX); bf16* WSM = (bf16*)(((uchar*)F.ap->ws) + WS_WSM);
    constexpr int I_IN = (DM / 64) * (NZ / 32), I_OUT = (DM / 64) * (DM / 32), I_PG = I_OUT, I_PE = (DP / 64) * (DM / 32), I_SM = 16 * 8;
    constexpr int NITEMS = I_IN + I_OUT + I_PG + I_PE + I_SM;
    for (int it = gw; it < NITEMS; it += NGW) {
        int r = it;
        if (r < I_IN) { p0_transpose_item(w_in, DM, NZ, WIN, scr, r, F.lane, nullptr, nullptr, 0); continue; } r -= I_IN;
        if (r < I_OUT) { p0_transpose_item(w_out, DM, DM, WOUT, scr, r, F.lane, F.ap->in[15], F.ap->in[16], DG); continue; } r -= I_OUT;
        if (r < I_PG) { p0_transpose_item(w_pg, DM, DM, WPG, scr, r, F.lane, nullptr, nullptr, 0); continue; } r -= I_PG;
        if (r < I_PE) { p0_transpose_item(w_pe, DP, DM, WPE, scr, r, F.lane, nullptr, nullptr, 0); continue; } r -= I_PE;
        { const int mat = r >> 3, sub = r & 7;
          const float* src = (mat < 8 ? w_a : w_x) + (size_t)(mat & 7) * 16384; bf16* dst = (mat < 8 ? WA : WX) + (size_t)(mat & 7) * 16384;
          p0_transpose_item(src, 128, 128, dst, scr, sub, F.lane, nullptr, nullptr, 0); }
    }
    { const float* ws_ = F.ap->in[6]; const int gt = F.bid * NTHR + F.tid, NGT = F.G * NTHR;
      for (int i = gt; i < NH * CHK * CHK / 2; i += NGT) { const int e = 2 * i, s = e & 127, t = (e >> 7) & 127; const f32x2 v = *(const f32x2*)(ws_ + e);
          ((unsigned*)WSM)[i] = pk2(s <= t ? v.x : 0.f, (s + 1) <= t ? v.y : 0.f); } }
    { const float* x = F.ap->in[0]; const float* pg = F.ap->in[2]; bf16* A1 = (bf16*)(((uchar*)F.ap->ws) + WS_A1);
      for (int m = gw; m < M; m += NGW) {
          const f32x4* xr = (const f32x4*)(x + (size_t)m * DM) + F.lane; f32x4 v[8]; float ss = 0.f;
#pragma unroll
          for (int j = 0; j < 8; ++j) { v[j] = xr[64 * j]; ss += (v[j].x * v[j].x + v[j].y * v[j].y) + (v[j].z * v[j].z + v[j].w * v[j].w); }
          const float rstd = 1.0f / sqrtf(wave_sum(ss) * (1.0f / DM) + EPS);
          u32x2* o8 = (u32x2*)(A1 + (size_t)m * DM) + F.lane;
#pragma unroll
          for (int j = 0; j < 8; ++j) { const f32x4 g = ((const f32x4*)pg)[F.lane + 64 * j];
              u32x2 o; o.x = pk2(v[j].x * rstd * g.x, v[j].y * rstd * g.y); o.y = pk2(v[j].z * rstd * g.z, v[j].w * rstd * g.w); o8[64 * j] = o; }
      } }
    { const float* p = F.ap->in[1]; bf16* PB = (bf16*)(((uchar*)F.ap->ws) + WS_PBF); const size_t gt = (size_t)F.bid * NTHR + F.tid, NGT = (size_t)F.G * NTHR;
      for (size_t i = gt; i < (size_t)M * DP / 8; i += NGT) { const f32x4 a = ((const f32x4*)p)[2 * i], b = ((const f32x4*)p)[2 * i + 1];
          u32x4 o; o.x = pk2(a.x, a.y); o.y = pk2(a.z, a.w); o.z = pk2(b.x, b.y); o.w = pk2(b.z, b.w); ((u32x4*)PB)[i] = o; } }
}

__device__ __forceinline__ int sw16(int row) { return (row ^ (row >> 3)) & 15; }
__device__ __forceinline__ int img_off(int row, int chunk) { return row * 256 + ((chunk ^ sw16(row)) << 4); }
__device__ __forceinline__ void load_img(LAS uchar* img, const bf16* src, int tid) {
#pragma unroll
    for (int i = 0; i < 4; ++i) { const int q = tid + NTHR * i, row = q >> 4, ch = q & 15; const u32x4 v = *(const u32x4*)(src + row * 128 + ch * 8); *(LAS u32x4*)(img + img_off(row, ch)) = v; }
}
#define DPP_F(oldv, srcv, ctrl) __builtin_bit_cast(float, __builtin_amdgcn_update_dpp(__builtin_bit_cast(int, (float)(oldv)), __builtin_bit_cast(int, (float)(srcv)), (ctrl), 0xf, 0xf, false))

__device__ __forceinline__ void gmlp_unit(Frame& F, int c, int h) {
    const int tid = F.tid, lane = F.lane, w = F.wave, fr = lane & 15, fq = lane >> 4;
    const int t0 = c * CHK, tg4 = tid >> 4, cg = tid & 15;
    const bf16* Z = (const bf16*)(((uchar*)F.ap->ws) + WS_Z); bf16* Y = (bf16*)(((uchar*)F.ap->ws) + WS_Y);
    const f32x2* vst = (const f32x2*)(((uchar*)F.ap->ws) + WS_VST); float* SSA = (float*)(((uchar*)F.ap->ws) + WS_SSA);
    LAS f32x2* stat = (LAS f32x2*)(F.lds + MISC_STAT); LAS float* part = (LAS float*)(F.lds + MISC_PART);
    u32x4 gv[4], uu[4], gg[4];
#pragma unroll
    for (int j = 0; j < 4; ++j) { const bf16* zr = Z + (size_t)(t0 + 4 * tg4 + j) * NZ + 128 * h + 8 * cg;
        uu[j] = *(const u32x4*)zr; gv[j] = *(const u32x4*)(zr + DG); gg[j] = *(const u32x4*)(zr + 2 * DG); }
    if (tid < 128) { const f32x2* vp = vst + (size_t)(t0 + tid) * 16; float s = 0.f, q = 0.f;
#pragma unroll
        for (int k = 0; k < 16; ++k) { const f32x2 v = vp[k]; s += v.x; q += v.y; }
        const float mean = s * (1.0f / DG); float var = q * (1.0f / DG) - mean * mean; var = var > 0.f ? var : 0.f;
        stat[tid] = (f32x2){mean, 1.0f / sqrtf(var + EPS)}; }
    __syncthreads();
    {
        const float* lg = F.ap->in[4] + 128 * h + 8 * cg; const float* lb = F.ap->in[5] + 128 * h + 8 * cg;
        const f32x4 g0 = *(const f32x4*)lg, g1 = *(const f32x4*)(lg + 4), b0 = *(const f32x4*)lb, b1 = *(const f32x4*)(lb + 4);
        const float gsc[8] = {g0.x, g0.y, g0.z, g0.w, g1.x, g1.y, g1.z, g1.w}, bsc[8] = {b0.x, b0.y, b0.z, b0.w, b1.x, b1.y, b1.z, b1.w};
        float nv[4][8];
#pragma unroll
        for (int j = 0; j < 4; ++j) { const f32x2 st = stat[4 * tg4 + j]; const unsigned wv[4] = {gv[j].x, gv[j].y, gv[j].z, gv[j].w};
#pragma unroll
            for (int k = 0; k < 4; ++k) { nv[j][2 * k] = (bflo(wv[k]) - st.x) * st.y * gsc[2 * k] + bsc[2 * k]; nv[j][2 * k + 1] = (bfhi(wv[k]) - st.x) * st.y * gsc[2 * k + 1] + bsc[2 * k + 1]; } }
#pragma unroll
        for (int cc = 0; cc < 8; ++cc) { const int d = 8 * cg + cc; u32x2 o; o.x = pk2(nv[0][cc], nv[1][cc]); o.y = pk2(nv[2][cc], nv[3][cc]);
            *(LAS u32x2*)(F.lds + IMG0 + d * 256 + (((tg4 >> 1) ^ sw16(d)) << 4) + (tg4 & 1) * 8) = o; }
#pragma unroll
        for (int j = 0; j < 4; ++j) { *(LAS u32x4*)(F.lds + IMG2 + img_off(4 * tg4 + j, cg)) = uu[j]; *(LAS u32x4*)(F.lds + IMG3 + img_off(4 * tg4 + j, cg)) = gg[j]; }
    }
    __syncthreads();
    f32x4 acc[8];
#pragma unroll
    for (int T = 0; T < 8; ++T) acc[T] = (f32x4){0.f, 0.f, 0.f, 0.f};
    bf16x8 af[4];
#pragma unroll
    for (int kk = 0; kk < 4; ++kk) af[kk] = *(const LAS bf16x8*)(F.lds + IMG0 + img_off(16 * w + fr, 4 * kk + fq));
#pragma unroll
    for (int T = 0; T < 8; ++T)
#pragma unroll
        for (int kk = 0; kk <= (T >> 1); ++kk) { const bf16x8 bfr = *(const LAS bf16x8*)(F.lds + IMG1 + img_off(16 * T + fr, 4 * kk + fq));
            acc[T] = __builtin_amdgcn_mfma_f32_16x16x32_bf16(af[kk], bfr, acc[T], 0, 0, 0); }
    const float* bs = F.ap->in[7] + h * CHK;
#pragma unroll
    for (int T = 0; T < 8; ++T) { const int t = 16 * T + fr; const float bsv = bs[t];
        const int o = img_off(t, 2 * w + (fq >> 1)) + (fq & 1) * 8;
        const u32x2 uw = *(const LAS u32x2*)(F.lds + IMG2 + o), gw = *(const LAS u32x2*)(F.lds + IMG3 + o);
        const float y0 = bflo(uw.x) * (acc[T][0] + bsv) * bflo(gw.x), y1 = bfhi(uw.x) * (acc[T][1] + bsv) * bfhi(gw.x);
        const float y2 = bflo(uw.y) * (acc[T][2] + bsv) * bflo(gw.y), y3 = bfhi(uw.y) * (acc[T][3] + bsv) * bfhi(gw.y);
        float q = (y0 * y0 + y1 * y1) + (y2 * y2 + y3 * y3);
        u32x2 ow; ow.x = pk2(y0, y1); ow.y = pk2(y2, y3);
        *(u32x2*)(Y + (size_t)(t0 + t) * DM + 128 * h + 16 * w + 4 * fq) = ow;
        q += __shfl_xor(q, 16); q += __shfl_xor(q, 32);
        if (fq == 0) part[w * 128 + t] = q; }
    __syncthreads();
    if (tid < 128) { float s = 0.f;
#pragma unroll
        for (int k = 0; k < 8; ++k) s += part[k * 128 + tid];
        SSA[(size_t)(t0 + tid) * 8 + h] = s; }
}

template <bool APPLY>
__device__ __forceinline__ void lru_unit(Frame& F, int c, int h) {
    const int tid = F.tid, lane = F.lane, w = F.wave, fr = lane & 15, fq = lane >> 4;
    const int t0 = c * CHK, tseq0 = t0 & (SEQ - 1), tg4 = tid >> 4, cg = tid & 15;
    const bf16* Z = (const bf16*)(((uchar*)F.ap->ws) + WS_Z); bf16* Y = (bf16*)(((uchar*)F.ap->ws) + WS_Y);
    f32x2* AGG = (f32x2*)(((uchar*)F.ap->ws) + WS_AGG); float* SSB = (float*)(((uchar*)F.ap->ws) + WS_SSB);
    LAS float* part = (LAS float*)(F.lds + MISC_PART); LAS f32x2* cpart = (LAS f32x2*)(F.lds + MISC_CPART);
    u32x4 xb[7], gg[4];
#pragma unroll
    for (int k = 0; k < 7; ++k) { const int trel = 4 * tg4 - 3 + k;
        if (tseq0 + trel >= 0) xb[k] = *(const u32x4*)(Z + (size_t)(t0 + trel) * NZ + 3 * DG + 128 * h + 8 * cg); else xb[k] = (u32x4){0u, 0u, 0u, 0u}; }
    if (APPLY) {
#pragma unroll
        for (int j = 0; j < 4; ++j) gg[j] = *(const u32x4*)(Z + (size_t)(t0 + 4 * tg4 + j) * NZ + 4 * DG + 128 * h + 8 * cg);
        const int ch = tid & 127, pt = tid >> 7, cs = c & 63, cb0 = c - cs; const int lo = 16 * pt, hi = (16 * pt + 16 < cs) ? 16 * pt + 16 : cs;
        float A = 1.f, B = 0.f;
        for (int cc = lo; cc < hi; ++cc) { const f32x2 ab = AGG[(size_t)(cb0 + cc) * DL + 128 * h + ch]; B = ab.x * B + ab.y; A = ab.x * A; }
        cpart[pt * 128 + ch] = (f32x2){A, B};
    }
    {
        const float* cw = F.ap->in[8] + 128 * h + 8 * cg; const float* cbp = F.ap->in[9] + 128 * h + 8 * cg;
        float wk[4][8], cbv[8];
#pragma unroll
        for (int k = 0; k < 4; ++k) { const f32x4 a = *(const f32x4*)(cw + k * DL), b = *(const f32x4*)(cw + k * DL + 4);
            wk[k][0] = a.x; wk[k][1] = a.y; wk[k][2] = a.z; wk[k][3] = a.w; wk[k][4] = b.x; wk[k][5] = b.y; wk[k][6] = b.z; wk[k][7] = b.w; }
        { const f32x4 a = *(const f32x4*)cbp, b = *(const f32x4*)(cbp + 4); cbv[0] = a.x; cbv[1] = a.y; cbv[2] = a.z; cbv[3] = a.w; cbv[4] = b.x; cbv[5] = b.y; cbv[6] = b.z; cbv[7] = b.w; }
        float xc[4][8];
#pragma unroll
        for (int j = 0; j < 4; ++j)
#pragma unroll
            for (int e = 0; e < 8; ++e) xc[j][e] = cbv[e];
#pragma unroll
        for (int k = 0; k < 7; ++k) { const unsigned wv[4] = {xb[k].x, xb[k].y, xb[k].z, xb[k].w};
#pragma unroll
            for (int e2 = 0; e2 < 4; ++e2) { const float lo_ = bflo(wv[e2]), hi_ = bfhi(wv[e2]);
#pragma unroll
                for (int j = 0; j < 4; ++j) { const int kw = k - j; if (kw >= 0 && kw < 4) { xc[j][2 * e2] += wk[kw][2 * e2] * lo_; xc[j][2 * e2 + 1] += wk[kw][2 * e2 + 1] * hi_; } } } }
#pragma unroll
        for (int j = 0; j < 4; ++j) { u32x4 o; o.x = pk2(xc[j][0], xc[j][1]); o.y = pk2(xc[j][2], xc[j][3]); o.z = pk2(xc[j][4], xc[j][5]); o.w = pk2(xc[j][6], xc[j][7]);
            *(LAS u32x4*)(F.lds + IMG0 + img_off(4 * tg4 + j, cg)) = o;
            if (APPLY) *(LAS u32x4*)(F.lds + IMG3 + img_off(4 * tg4 + j, cg)) = gg[j]; }
    }
    __syncthreads();
    f32x4 accA[8], accX[8];
#pragma unroll
    for (int T = 0; T < 8; ++T) { accA[T] = (f32x4){0.f, 0.f, 0.f, 0.f}; accX[T] = (f32x4){0.f, 0.f, 0.f, 0.f}; }
    {
        bf16x8 afa[4], afx[4];
#pragma unroll
        for (int kk = 0; kk < 4; ++kk) { afa[kk] = *(const LAS bf16x8*)(F.lds + IMG1 + img_off(16 * w + fr, 4 * kk + fq)); afx[kk] = *(const LAS bf16x8*)(F.lds + IMG2 + img_off(16 * w + fr, 4 * kk + fq)); }
#pragma unroll
        for (int T = 0; T < 8; ++T)
#pragma unroll
            for (int kk = 0; kk < 4; ++kk) { const bf16x8 bfr = *(const LAS bf16x8*)(F.lds + IMG0 + img_off(16 * T + fr, 4 * kk + fq));
                accA[T] = __builtin_amdgcn_mfma_f32_16x16x32_bf16(afa[kk], bfr, accA[T], 0, 0, 0);
                accX[T] = __builtin_amdgcn_mfma_f32_16x16x32_bf16(afx[kk], bfr, accX[T], 0, 0, 0); }
    }
    const int chl = 16 * w + 4 * fq;
    float ba[4], bx[4], sp[4], H[4], Ap[4];
    { const f32x4 a = *(const f32x4*)(F.ap->in[11] + 128 * h + chl), b = *(const f32x4*)(F.ap->in[13] + 128 * h + chl), lm = *(const f32x4*)(F.ap->in[14] + 128 * h + chl);
      ba[0] = a.x; ba[1] = a.y; ba[2] = a.z; ba[3] = a.w; bx[0] = b.x; bx[1] = b.y; bx[2] = b.z; bx[3] = b.w;
      const float lmv[4] = {lm.x, lm.y, lm.z, lm.w};
#pragma unroll
      for (int r = 0; r < 4; ++r) { const float xx = -lmv[r]; sp[r] = (xx > 0.f ? xx : 0.f) + log1pf(__expf(-fabsf(xx))); } }
#pragma unroll
    for (int r = 0; r < 4; ++r) { H[r] = 0.f; Ap[r] = 1.f; }
    if (APPLY) {
#pragma unroll
        for (int r = 0; r < 4; ++r) { float hh = 0.f;
#pragma unroll
            for (int p = 0; p < 4; ++p) { const f32x2 ab = cpart[p * 128 + chl + r]; hh = ab.x * hh + ab.y; }
            H[r] = hh; } }
#pragma unroll
    for (int T = 0; T < 8; ++T) { const int t = 16 * T + fr; const bool first = (tseq0 + t) == 0;
        const int o = img_off(t, 2 * w + (fq >> 1)) + (fq & 1) * 8;
        const u32x2 xw = *(const LAS u32x2*)(F.lds + IMG0 + o);
        const float xcv[4] = {bflo(xw.x), bfhi(xw.x), bflo(xw.y), bfhi(xw.y)};
        float gvv[4] = {0.f, 0.f, 0.f, 0.f};
        if (APPLY) { const u32x2 gw = *(const LAS u32x2*)(F.lds + IMG3 + o); gvv[0] = bflo(gw.x); gvv[1] = bfhi(gw.x); gvv[2] = bflo(gw.y); gvv[3] = bfhi(gw.y); }
        float yv[4];
#pragma unroll
        for (int r = 0; r < 4; ++r) {
            const float rg = sigmoidf_(accA[T][r] + ba[r]), ig = sigmoidf_(accX[T][r] + bx[r]);
            const float la = -8.0f * rg * sp[r]; const float a = __expf(la); const float x2 = 2.0f * la;
            const float m2 = (x2 > -0.25f) ? -x2 * (1.0f + x2 * 0.5f * (1.0f + x2 * (1.0f / 3.0f) * (1.0f + x2 * 0.25f * (1.0f + x2 * 0.2f * (1.0f + x2 * (1.0f / 6.0f)))))) : 1.0f - __expf(x2);
            const float mult = first ? 1.0f : sqrtf(m2);
            float A = a, B = mult * (ig * xcv[r]);
            { float Aq, Bq;
              Aq = DPP_F(1.0f, A, 0x111); Bq = DPP_F(0.0f, B, 0x111); B = A * Bq + B; A = A * Aq;
              Aq = DPP_F(1.0f, A, 0x112); Bq = DPP_F(0.0f, B, 0x112); B = A * Bq + B; A = A * Aq;
              Aq = DPP_F(1.0f, A, 0x114); Bq = DPP_F(0.0f, B, 0x114); B = A * Bq + B; A = A * Aq;
              Aq = DPP_F(1.0f, A, 0x118); Bq = DPP_F(0.0f, B, 0x118); B = A * Bq + B; A = A * Aq; }
            const float At = DPP_F(0.0f, A, 0x15F), Bt = DPP_F(0.0f, B, 0x15F);
            const float hv = A * H[r] + B;
            H[r] = At * H[r] + Bt; Ap[r] = Ap[r] * At;
            yv[r] = hv * gvv[r];
        }
        if (APPLY) {
            float q = (yv[0] * yv[0] + yv[1] * yv[1]) + (yv[2] * yv[2] + yv[3] * yv[3]);
            u32x2 ow; ow.x = pk2(yv[0], yv[1]); ow.y = pk2(yv[2], yv[3]);
            *(u32x2*)(Y + (size_t)(t0 + t) * DM + DG + 128 * h + chl) = ow;
            q += __shfl_xor(q, 16); q += __shfl_xor(q, 32);
            if (fq == 0) part[w * 128 + t] = q;
        }
    }
    if (!APPLY) { if (fr == 0) {
#pragma unroll
        for (int r = 0; r < 4; ++r) AGG[(size_t)c * DL + 128 * h + chl + r] = (f32x2){Ap[r], H[r]}; } }
    __syncthreads();
    if (APPLY) { if (tid < 128) { float s = 0.f;
#pragma unroll
        for (int k = 0; k < 8; ++k) s += part[k * 128 + tid];
        SSB[(size_t)(t0 + tid) * 8 + h] = s; } }
}

#define XB_TMO      128
#define XB_XCNT(j)  (256  + 64 * (j))
#define XB_XSUB(j)  (1280 + 64 * (j))
#define XB_XGEN(j)  (2304 + 64 * (j))
#define XB_TOP      3328
#define XB_TOPGEN   3392
#define XCD_BAR_WORDS 3456
#define XB_SPIN_CAP (1u << 18)
constexpr int LDS_BARST = MISC + 15 * 1024;
__device__ __forceinline__ unsigned xb_ld(unsigned* p)              { return __hip_atomic_load(p, __ATOMIC_RELAXED, __HIP_MEMORY_SCOPE_AGENT); }
__device__ __forceinline__ unsigned xb_add(unsigned* p, unsigned v) { return __hip_atomic_fetch_add(p, v, __ATOMIC_RELAXED, __HIP_MEMORY_SCOPE_AGENT); }
__device__ __forceinline__ unsigned xb_xcc_id() { return (unsigned)__builtin_amdgcn_s_getreg((3 << 11) | 20) & 0xFu; }
#define XB_SPIN(cond, bar) do { unsigned _sp = 0; while (cond) { __builtin_amdgcn_s_sleep(1); \
    if ((++_sp & 255u) == 0u) { if (xb_ld(&(bar)[XB_TMO])) break; if (_sp > XB_SPIN_CAP) { atomicAdd(&(bar)[XB_TMO], 1u); break; } } } } while (0)
__device__ __forceinline__ void xcd_barrier_complete(unsigned* bar, unsigned x, unsigned& nloc, unsigned& nx) {
    const unsigned G = gridDim.x;
    unsigned sum, cnt, mine, sp = 0u;
    for (;;) {
        sum = 0u; cnt = 0u; mine = 0u;
#pragma unroll
        for (unsigned j = 0; j < 16; ++j) { const unsigned c = xb_ld(&bar[XB_XCNT(j)]); sum += c; cnt += (c > 0u) ? 1u : 0u; mine = (j == x) ? c : mine; }
        if (sum == G) break;
        __builtin_amdgcn_s_sleep(1);
        if ((++sp & 255u) == 0u) { if (xb_ld(&bar[XB_TMO])) break; if (sp > XB_SPIN_CAP) { atomicAdd(&bar[XB_TMO], 1u); break; } }
    }
    nloc = mine > 0u ? mine : 1u; nx = cnt > 0u ? cnt : 1u;
}
__device__ __forceinline__ void xcd_barrier(unsigned* bar, volatile LAS unsigned* st, int tid) {
    asm volatile("s_waitcnt vmcnt(0)" ::: "memory");
    __syncthreads();
    if (tid == 0) {
        const unsigned x = xb_xcc_id();
        __builtin_amdgcn_s_waitcnt(0);
        unsigned nloc = st[0], nx = st[1];
        if (nloc == 0u) { xcd_barrier_complete(bar, x, nloc, nx); st[0] = nloc; st[1] = nx; }
        const unsigned old = xb_add(&bar[XB_XSUB(x)], 1u);
        const unsigned gen = old / nloc;
        if (old + 1u == (gen + 1u) * nloc) {
            __builtin_amdgcn_fence(__ATOMIC_RELEASE, "agent");
            asm volatile("s_waitcnt vmcnt(0)" ::: "memory");
            const unsigned og = xb_add(&bar[XB_TOP], 1u);
            const unsigned tg = og / nx;
            if (og + 1u == (tg + 1u) * nx) xb_add(&bar[XB_TOPGEN], 1u);
            else XB_SPIN(xb_ld(&bar[XB_TOPGEN]) == tg, bar);
            __builtin_amdgcn_fence(__ATOMIC_ACQUIRE, "agent");
            xb_add(&bar[XB_XGEN(x)], 1u);
            asm volatile("s_waitcnt vmcnt(0)" ::: "memory");
        } else {
            XB_SPIN(xb_ld(&bar[XB_XGEN(x)]) == gen, bar);
            __builtin_amdgcn_fence(__ATOMIC_ACQUIRE, "agent");
            asm volatile("s_waitcnt vmcnt(0)" ::: "memory");
        }
    }
    __syncthreads();
}

__global__ void __launch_bounds__(NTHR, 2) mk_fwd(Args args_unused) {
    extern __shared__ __attribute__((aligned(16))) unsigned char lds_raw[];
    Frame F;
    F.lds = (LAS uchar*)lds_raw; F.G = gridDim.x; F.bid = blockIdx.x; F.wv = __builtin_amdgcn_readfirstlane((int)threadIdx.x >> 6);
    PHASE_BEGIN(F);
    const int lo = F.ap->ph_lo, hi = F.ap->ph_hi;
#define IN(k) (lo <= (k) && (k) < hi)
#if MK_N_LAUNCHES == 1
#define SEAM(k) do { if (IN(k) && IN((k) + 1)) { PHASE_BEGIN(F); xcd_barrier((unsigned*)F.ap->ws, (volatile LAS unsigned*)(F.lds + LDS_BARST), F.tid); } } while (0)
#else
#define SEAM(k) do { } while (0)
#endif
#define WSB(off) ((bf16*)((uchar*)F.ap->ws + (off)))
#define WSF(off) ((float*)((uchar*)F.ap->ws + (off)))

    if (F.tid < 2) ((volatile LAS unsigned*)(F.lds + LDS_BARST))[F.tid] = 0u;
    if (IN(0)) {
#if MK_N_LAUNCHES == 1
        if (F.bid == 0) { unsigned* bw = (unsigned*)F.ap->ws; for (int i = F.tid; i < 4096; i += NTHR) __hip_atomic_store(bw + i, 0u, __ATOMIC_RELAXED, __HIP_MEMORY_SCOPE_AGENT); }
#endif
        p0_prologue(F); __syncthreads(); }
#if MK_N_LAUNCHES == 1
    cg::this_grid().sync();
    PHASE_BEGIN(F);
    if (F.tid == 0) (void)xb_add((unsigned*)F.ap->ws + XB_XCNT(xb_xcc_id()), 1u);
#endif
    if (IN(1)) {
        PHASE_BEGIN(F);
        { pg8::Gemm g{WSB(WS_A1), WSB(WS_WIN), M, NZ, DM}; pg8::StaticOrder S; S.init(M, NZ, F.G, F.bid);
          pg8::EpiZ E{WSB(WS_Z), NZ, (pg8::f32x2*)WSF(WS_VST)};
          pg8::gemm_phase<pg8::EpiZ, pg8::StaticOrder, true, true>(F.lds, g, S, E, F.tid); }
        PHASE_BEGIN(F);
        { pg8::Gemm g{WSB(WS_PBF), WSB(WS_WPE), M, DM, DP}; pg8::StaticOrder S; S.init(M, DM, F.G, F.bid);
          pg8::EpiPlain E{WSB(WS_PE), DM};
          pg8::gemm_phase<pg8::EpiPlain, pg8::StaticOrder, true, true>(F.lds, g, S, E, F.tid); }
    }
    SEAM(1);
    if (IN(2)) {
        PHASE_BEGIN(F);
        int cur = -1;
        for (int u = F.bid; u < 2048; u += F.G) { const int h = u & 7, c = u >> 3;
            if (h != cur) { __syncthreads(); load_img(F.lds + IMG1, WSB(WS_WSM) + (size_t)h * 16384, F.tid); cur = h; }
            gmlp_unit(F, c, h); }
        PHASE_BEGIN(F);
        cur = -1;
        for (int u = F.bid; u < 2048; u += F.G) { const int h = u & 7, c = u >> 3;
            if (h != cur) { __syncthreads(); load_img(F.lds + IMG1, WSB(WS_WA) + (size_t)h * 16384, F.tid); load_img(F.lds + IMG2, WSB(WS_WX) + (size_t)h * 16384, F.tid); cur = h; }
            lru_unit<false>(F, c, h); }
        __syncthreads();
    }
    SEAM(2);
    if (IN(3)) {
        PHASE_BEGIN(F);
        int cur = -1;
        for (int u = F.bid; u < 2048; u += F.G) { const int h = u & 7, c = u >> 3;
            if (h != cur) { __syncthreads(); load_img(F.lds + IMG1, WSB(WS_WA) + (size_t)h * 16384, F.tid); load_img(F.lds + IMG2, WSB(WS_WX) + (size_t)h * 16384, F.tid); cur = h; }
            lru_unit<true>(F, c, h); }
        __syncthreads();
    }
    SEAM(3);
    if (IN(4)) {
        PHASE_BEGIN(F);
        const float* SSA = WSF(WS_SSA); const float* SSB = WSF(WS_SSB); bf16* Yb = WSB(WS_Y);
        const int gw = F.bid * NWAVES + F.wave, NGW = F.G * NWAVES;
        for (int m = gw; m < M; m += NGW) {
            const f32x4 a0 = *(const f32x4*)(SSA + (size_t)m * 8), a1 = *(const f32x4*)(SSA + (size_t)m * 8 + 4), b0 = *(const f32x4*)(SSB + (size_t)m * 8), b1 = *(const f32x4*)(SSB + (size_t)m * 8 + 4);
            const float ra = 1.0f / sqrtf(((a0.x + a0.y) + (a0.z + a0.w) + (a1.x + a1.y) + (a1.z + a1.w)) * (1.0f / DG) + EPS);
            const float rb = 1.0f / sqrtf(((b0.x + b0.y) + (b0.z + b0.w) + (b1.x + b1.y) + (b1.z + b1.w)) * (1.0f / DL) + EPS);
            u32x4* yr = (u32x4*)(Yb + (size_t)m * DM) + F.lane;
#pragma unroll
            for (int j = 0; j < 4; ++j) { const float sc = j < 2 ? ra : rb; u32x4 v = yr[64 * j];
                v.x = pk2(bflo(v.x) * sc, bfhi(v.x) * sc); v.y = pk2(bflo(v.y) * sc, bfhi(v.y) * sc); v.z = pk2(bflo(v.z) * sc, bfhi(v.z) * sc); v.w = pk2(bflo(v.w) * sc, bfhi(v.w) * sc);
                yr[64 * j] = v; }
        }
    }
    SEAM(4);
    if (IN(5)) {
        PHASE_BEGIN(F);
        pg8::Gemm g{WSB(WS_Y), WSB(WS_WOUT), M, DM, DM}; pg8::StaticOrder S; S.init(M, DM, F.G, F.bid);
        pg8::EpiO E{WSB(WS_O), DM, WSF(WS_SSO)};
        pg8::gemm_phase<pg8::EpiO, pg8::StaticOrder, true, true>(F.lds, g, S, E, F.tid);
    }
    SEAM(5);
    if (IN(6)) {
        PHASE_BEGIN(F);
        const float* SSO = WSF(WS_SSO); const float* x = F.ap->in[0]; const float* pg = F.ap->in[18]; const bf16* Ob = WSB(WS_O); bf16* H1 = WSB(WS_A1); float* outp = (float*)F.ap->out;
        const int gw = F.bid * NWAVES + F.wave, NGW = F.G * NWAVES;
        for (int m = gw; m < M; m += NGW) {
            float s = (F.lane < 32) ? SSO[(size_t)m * 32 + F.lane] : 0.f; s = wave_sum(s);
            const float rstd = 1.0f / sqrtf(s * (1.0f / DM) + EPS);
            const f32x4* xr = (const f32x4*)(x + (size_t)m * DM) + F.lane; const u32x2* orow = (const u32x2*)(Ob + (size_t)m * DM) + F.lane;
            f32x4* outr = (f32x4*)(outp + (size_t)m * DM) + F.lane; u32x2* hr = (u32x2*)(H1 + (size_t)m * DM) + F.lane;
#pragma unroll
            for (int j = 0; j < 8; ++j) { const f32x4 xv = xr[64 * j]; const u32x2 ov = orow[64 * j]; const f32x4 g = ((const f32x4*)pg)[F.lane + 64 * j];
                f32x4 hv; hv.x = xv.x + bflo(ov.x) * rstd * g.x; hv.y = xv.y + bfhi(ov.x) * rstd * g.y; hv.z = xv.z + bflo(ov.y) * rstd * g.z; hv.w = xv.w + bfhi(ov.y) * rstd * g.w;
                outr[64 * j] = hv; u32x2 hb; hb.x = pk2(hv.x, hv.y); hb.y = pk2(hv.z, hv.w); hr[64 * j] = hb; }
        }
    }
    SEAM(6);
    if (IN(7)) {
        PHASE_BEGIN(F);
        pg8::Gemm g{WSB(WS_A1), WSB(WS_WPG), M, DM, DM}; pg8::StaticOrder S; S.init(M, DM, F.G, F.bid);
        pg8::EpiOut E{(float*)F.ap->out, WSB(WS_PE), DM};
        pg8::gemm_phase<pg8::EpiOut, pg8::StaticOrder, true, true>(F.lds, g, S, E, F.tid);
    }
#undef IN
#undef SEAM
}

extern "C" void kernel_launch(void* const* d_in, const int* in_sizes, int n_in, void* d_out, int out_size, void* d_ws, size_t ws_size, hipStream_t stream) {
    static int grid = 0;
    if (grid == 0) {
        if (n_in != 21 || in_sizes[0] != M * DM || out_size != M * DM || ws_size < WS_END) { fprintf(stderr, "kernel_launch: unexpected problem (n_in %d, in0 %d, out %d, ws %zu); nothing launched\n", n_in, n_in > 0 ? in_sizes[0] : -1, out_size, ws_size); grid = -1; return; }
        int dev = 0, cus = 0, per_cu = 0;
        if (hipGetDevice(&dev) != hipSuccess || hipDeviceGetAttribute(&cus, hipDeviceAttributeMultiprocessorCount, dev) != hipSuccess) { fprintf(stderr, "kernel_launch: device query failed\n"); grid = -1; return; }
        if (hipFuncSetAttribute((const void*)mk_fwd, hipFuncAttributeMaxDynamicSharedMemorySize, LDS_BYTES) != hipSuccess) { fprintf(stderr, "kernel_launch: hipFuncSetAttribute failed\n"); grid = -1; return; }
        if (hipOccupancyMaxActiveBlocksPerMultiprocessor(&per_cu, (const void*)mk_fwd, NTHR, LDS_BYTES) != hipSuccess || per_cu < 1) { fprintf(stderr, "kernel_launch: occupancy query says %d blocks per CU\n", per_cu); per_cu = 1; }
        (void)hipGetLastError();
        grid = cus;
    }
    if (grid < 0) return;
    Args a{};
    for (int i = 0; i < 21; ++i) a.in[i] = (const float*)d_in[i];
    a.out = (float*)d_out; a.ws = (unsigned char*)d_ws;
#if MK_N_LAUNCHES == 1
    a.ph_lo = 0; a.ph_hi = N_PHASES;
    void* kargs[] = {&a};
    hipError_t e = hipLaunchCooperativeKernel((const void*)mk_fwd, dim3(grid), dim3(NTHR), kargs, LDS_BYTES, stream);
    if (e != hipSuccess) fprintf(stderr, "kernel_launch: cooperative launch failed: %s (grid %d)\n", hipGetErrorString(e), grid);
#else
    for (int li = 0; li < N_PHASES; ++li) { a.ph_lo = li; a.ph_hi = li + 1;
        hipLaunchKernelGGL(mk_fwd, dim3(grid), dim3(NTHR), LDS_BYTES, stream, a);
        const hipError_t le = hipPeekAtLastError(); if (le != hipSuccess) { fprintf(stderr, "kernel_launch: launch %d failed: %s\n", li, hipGetErrorName(le)); break; } }
#endif
}
```

```cpp
#define MK_N_LAUNCHES 1
#define PROBE_DOUBLE 0
#include <hip/hip_runtime.h>
#include <hip/hip_cooperative_groups.h>
#include <cstdio>
#include <cstdint>
namespace cg = cooperative_groups;
namespace pg8 {
#define PG8_LAS __attribute__((address_space(3)))
typedef unsigned short bf16_t;
typedef short bf16x8 __attribute__((ext_vector_type(8)));
typedef float f32x4 __attribute__((ext_vector_type(4)));
typedef unsigned u32x4 __attribute__((ext_vector_type(4)));
constexpr int BM = 256, BK = 64, HALF = 128, HTB = HALF * BK * 2  , STAGE_BYTES = 8 * HTB, NXCD = 8, WGM = 8;

__host__ __device__ __forceinline__ int lds_byte(int r, int c) { const int st = (r >> 4) * 2 + (c >> 5), rr = r & 15, cc = c & 31, ob = rr * 64 + cc * 2; return st * 1024 + (ob ^ (((ob >> 9) & 1) << 5)); }
__host__ __device__ __forceinline__ void stage_rc(int b, int& R, int& C) { const int st = b / 1024, sb = b % 1024, swz = sb ^ (((sb >> 9) & 1) << 5); R = (st >> 1) * 16 + swz / 64; C = (st & 1) * 32 + (swz % 64) / 2; }
__host__ __device__ __forceinline__ int perm32(int rho) { const int n = rho >> 4, i = rho & 15; return 8 * (i >> 2) + 4 * n + (i & 3); }

struct Unit { int pm, pn; };
struct Gemm { const bf16_t* A; const bf16_t* Bt; int M, N, K; };

struct StaticOrder {
    int nM, nN, nwg, G, c;
    __host__ __device__ void init(int M, int N, int G_, int c_) { nM = M / BM; nN = N / BM; nwg = nM * nN; G = G_; c = c_; }
    __host__ __device__ bool next(int i, Unit& u) const {
        const long L = (long)i * G + c; if (L >= nwg) return false;
        int wgid = (int)L; { const int q = nwg / NXCD, r = nwg % NXCD, xcd = wgid % NXCD, off = wgid / NXCD; wgid = (xcd < r ? xcd * (q + 1) : r * (q + 1) + (xcd - r) * q) + off; }
        const int nig = WGM * nN, gid = wgid / nig, fm = gid * WGM, gsz = (nM - fm) < WGM ? (nM - fm) : WGM;
        u.pm = fm + ((wgid % nig) % gsz); u.pn = (wgid % nig) / gsz; return true;
    }
    __device__ __forceinline__ void a_ready(const Unit&) const {}
    __device__ __forceinline__ void done(const Unit&) const {}
};

__device__ __forceinline__ unsigned cvt_pk_bf16(float lo, float hi) { unsigned r; asm volatile("v_cvt_pk_bf16_f32 %0, %1, %2" : "=v"(r) : "v"(lo), "v"(hi)); return r; }
typedef float f32x2 __attribute__((ext_vector_type(2)));
typedef unsigned u32x2 __attribute__((ext_vector_type(2)));
__device__ __forceinline__ float fast_sigmoid(float x) { return __builtin_amdgcn_rcpf(1.0f + __expf(-x)); }

struct EpiPlain {
    static constexpr bool PERM = true, AFTER_DRAIN = false, MIDSCALE = false;
    bf16_t* O; int ldc;
    __device__ __forceinline__ void operator()(const f32x4 (&acc)[2][2][4][2], const Unit& u, int wr, int wc, int fr, int fq) const {
        const int row0 = u.pm * BM + wr * 64 + fr, col0 = u.pn * BM + wc * 32 + 8 * fq;
#pragma unroll
        for (int ai = 0; ai < 2; ++ai)
#pragma unroll
            for (int m = 0; m < 4; ++m) { bf16_t* rowp = O + (size_t)(row0 + ai * HALF + m * 16) * ldc + col0;
#pragma unroll
                for (int bj = 0; bj < 2; ++bj) { const f32x4 v0 = acc[ai][bj][m][0], v1 = acc[ai][bj][m][1];
                    u32x4 w; w.x = cvt_pk_bf16(v0[0], v0[1]); w.y = cvt_pk_bf16(v0[2], v0[3]); w.z = cvt_pk_bf16(v1[0], v1[1]); w.w = cvt_pk_bf16(v1[2], v1[3]);
                    *(u32x4*)(rowp + bj * HALF) = w; } }
    }
};

struct EpiZ {
    static constexpr bool PERM = true, AFTER_DRAIN = false, MIDSCALE = false;
    bf16_t* Z; int ldc; f32x2* vst;
    __device__ __forceinline__ void operator()(const f32x4 (&acc)[2][2][4][2], const Unit& u, int wr, int wc, int fr, int fq) const {
        const int row0 = u.pm * BM + wr * 64 + fr, col0 = u.pn * BM + wc * 32 + 8 * fq;
        const int grp = u.pn >> 2;
#pragma unroll
        for (int ai = 0; ai < 2; ++ai)
#pragma unroll
            for (int m = 0; m < 4; ++m) { const int row = row0 + ai * HALF + m * 16; bf16_t* rowp = Z + (size_t)row * ldc + col0;
                float s = 0.f, q = 0.f;
#pragma unroll
                for (int bj = 0; bj < 2; ++bj) { f32x4 v[2] = {acc[ai][bj][m][0], acc[ai][bj][m][1]};
                    if (grp != 3) {
#pragma unroll
                        for (int n = 0; n < 2; ++n)
#pragma unroll
                            for (int j = 0; j < 4; ++j) { const float x = v[n][j]; const float a = (grp < 2) ? 1.5957691216f * (x + 0.044715f * x * x * x) : x; v[n][j] = x * fast_sigmoid(a); }
                    }
                    if (grp == 1) {
#pragma unroll
                        for (int n = 0; n < 2; ++n)
#pragma unroll
                            for (int j = 0; j < 4; ++j) { s += v[n][j]; q += v[n][j] * v[n][j]; }
                    }
                    u32x4 w; w.x = cvt_pk_bf16(v[0][0], v[0][1]); w.y = cvt_pk_bf16(v[0][2], v[0][3]); w.z = cvt_pk_bf16(v[1][0], v[1][1]); w.w = cvt_pk_bf16(v[1][2], v[1][3]);
                    *(u32x4*)(rowp + bj * HALF) = w; }
                if (grp == 1) { s += __shfl_xor(s, 16); s += __shfl_xor(s, 32); q += __shfl_xor(q, 16); q += __shfl_xor(q, 32);
                    if (fq == 0) vst[(size_t)row * 16 + (u.pn - 4) * 4 + wc] = (f32x2){s, q}; }
            }
    }
};

struct EpiO {
    static constexpr bool PERM = true, AFTER_DRAIN = false, MIDSCALE = true;
    bf16_t* O; int ldc; float* sso; const PG8_LAS f32x2* rr; mutable int ui;
    __device__ __forceinline__ void midscale(f32x4 (&acc)[2][2][4][2], int wr, int fr) const {
#pragma unroll
        for (int ai = 0; ai < 2; ++ai)
#pragma unroll
            for (int m = 0; m < 4; ++m) { const float s = rr[ui * 256 + ai * HALF + wr * 64 + m * 16 + fr].x;
#pragma unroll
                for (int bj = 0; bj < 2; ++bj)
#pragma unroll
                    for (int n = 0; n < 2; ++n) acc[ai][bj][m][n] *= s; }
    }
    __device__ __forceinline__ void operator()(const f32x4 (&acc)[2][2][4][2], const Unit& u, int wr, int wc, int fr, int fq) const {
        const int row0 = u.pm * BM + wr * 64 + fr, col0 = u.pn * BM + wc * 32 + 8 * fq;
#pragma unroll
        for (int ai = 0; ai < 2; ++ai)
#pragma unroll
            for (int m = 0; m < 4; ++m) { const int row = row0 + ai * HALF + m * 16; bf16_t* rowp = O + (size_t)row * ldc + col0;
                const float s = rr[ui * 256 + ai * HALF + wr * 64 + m * 16 + fr].y;
                float q = 0.f;
#pragma unroll
                for (int bj = 0; bj < 2; ++bj) { const f32x4 v0 = acc[ai][bj][m][0] * s, v1 = acc[ai][bj][m][1] * s;
#pragma unroll
                    for (int j = 0; j < 4; ++j) { q += v0[j] * v0[j]; q += v1[j] * v1[j]; }
                    u32x4 w; w.x = cvt_pk_bf16(v0[0], v0[1]); w.y = cvt_pk_bf16(v0[2], v0[3]); w.z = cvt_pk_bf16(v1[0], v1[1]); w.w = cvt_pk_bf16(v1[2], v1[3]);
                    *(u32x4*)(rowp + bj * HALF) = w; }
                q += __shfl_xor(q, 16); q += __shfl_xor(q, 32);
                if (fq == 0) sso[(size_t)row * 32 + u.pn * 4 + wc] = q;
            }
        ++ui;
    }
};

struct EpiOut {
    static constexpr bool PERM = false, AFTER_DRAIN = false, MIDSCALE = false;
    float* out; const float* x; const bf16_t* o; const bf16_t* pe; const float* rstd; const float* pg; int ldc;
    __device__ __forceinline__ void operator()(const f32x4 (&acc)[2][2][4][2], const Unit& u, int wr, int wc, int fr, int fq) const {
        const int row0 = u.pm * BM + wr * 64 + fr, col0 = u.pn * BM + wc * 32 + 4 * fq;
#pragma unroll
        for (int ai = 0; ai < 2; ++ai)
#pragma unroll
            for (int m = 0; m < 4; ++m) { const int row = row0 + ai * HALF + m * 16; const size_t off = (size_t)row * ldc + col0; const float rs = rstd[row];
#pragma unroll
                for (int bj = 0; bj < 2; ++bj)
#pragma unroll
                    for (int n = 0; n < 2; ++n) { const size_t o2 = off + bj * HALF + n * 16;
                        const f32x4 xv = *(const f32x4*)(x + o2); const u32x2 ow = *(const u32x2*)(o + o2); const u32x2 pw = *(const u32x2*)(pe + o2);
                        const f32x4 gv = *(const f32x4*)(pg + col0 + bj * HALF + n * 16); const f32x4 a = acc[ai][bj][m][n];
                        f32x4 r;
                        r[0] = xv[0] + __uint_as_float(ow.x << 16) * rs * gv[0] + __uint_as_float(pw.x << 16) * fast_sigmoid(a[0]);
                        r[1] = xv[1] + __uint_as_float(ow.x & 0xffff0000u) * rs * gv[1] + __uint_as_float(pw.x & 0xffff0000u) * fast_sigmoid(a[1]);
                        r[2] = xv[2] + __uint_as_float(ow.y << 16) * rs * gv[2] + __uint_as_float(pw.y << 16) * fast_sigmoid(a[2]);
                        r[3] = xv[3] + __uint_as_float(ow.y & 0xffff0000u) * rs * gv[3] + __uint_as_float(pw.y & 0xffff0000u) * fast_sigmoid(a[3]);
                        *(f32x4*)(out + o2) = r; }
                asm volatile("" ::: "memory"); }
    }
};

template <class Epi, class Sched, bool ALIGN_EPI = false, bool SP2 = false>
__device__ __forceinline__ void gemm_phase(PG8_LAS unsigned char* lds, const Gemm g, const Sched& S, const Epi& E, int tid_in) {
    int tid_ = tid_in; asm volatile("" : "+v"(tid_));
    const int tid = tid_, wid = __builtin_amdgcn_readfirstlane(tid >> 6), lane = tid & 63, wr = wid >> 2, wc = wid & 3, fr = lane & 15, fq = lane >> 4;
    const int K = g.K, nt = K / BK;
    unsigned voffA[2], voffB[2];
#pragma unroll
    for (int i = 0; i < 2; ++i) { int R, C; stage_rc(tid * 16 + i * 8192, R, C); const int Rb = Epi::PERM ? ((R & ~31) + perm32(R & 31)) : R;
        voffA[i] = (unsigned)(R * K + C) * 2u; voffB[i] = (unsigned)(Rb * K + C) * 2u; }
    const size_t kstep = (size_t)(BK * 2);
    const size_t hstep = (size_t)HALF * K * 2;
    const size_t tstep = 2 * hstep;
    const unsigned ldsw = (unsigned)wid * 1024u;
    const int aoff = lds_byte(wr * 64 + fr, fq * 8), boff = lds_byte(wc * 32 + fr, fq * 8);
#define PG8_SA(b, h) (((b) * 2 + (h)) * HTB)
#define PG8_SB(b, h) ((4 + (b) * 2 + (h)) * HTB)
#define PG8_STAGE(bufoff, gbase, voff) do { _Pragma("unroll") for (int _i = 0; _i < 2; ++_i) \
        __builtin_amdgcn_global_load_lds((const unsigned*)((const char*)(gbase) + (voff)[_i]), (PG8_LAS unsigned*)(lds + (bufoff) + ldsw + _i * 8192), 16, 0, 0); } while (0)
#define PG8_LDA(dst, b, h) do { _Pragma("unroll") for (int m = 0; m < 4; ++m) _Pragma("unroll") for (int k = 0; k < 2; ++k) dst[m][k] = *(const PG8_LAS bf16x8*)(lds + PG8_SA(b, h) + aoff + m * 2048 + k * 1024); } while (0)
#define PG8_LDB(dst, b, h) do { _Pragma("unroll") for (int n = 0; n < 2; ++n) _Pragma("unroll") for (int k = 0; k < 2; ++k) dst[n][k] = *(const PG8_LAS bf16x8*)(lds + PG8_SB(b, h) + boff + n * 2048 + k * 1024); } while (0)
#define PG8_MMA(ai, bj, At, Bt) do { __builtin_amdgcn_s_setprio(1); _Pragma("unroll") for (int m = 0; m < 4; ++m) _Pragma("unroll") for (int n = 0; n < 2; ++n) _Pragma("unroll") for (int k = 0; k < 2; ++k) \
        acc[ai][bj][m][n] = __builtin_amdgcn_mfma_f32_16x16x32_bf16(Bt[n][k], At[m][k], acc[ai][bj][m][n], 0, 0, 0); __builtin_amdgcn_s_setprio(0); } while (0)
#define PG8_WAIT_V(n) asm volatile("s_waitcnt vmcnt(" #n ")" ::: "memory")
#define PG8_WAIT_L(n) asm volatile("s_waitcnt lgkmcnt(" #n ")" ::: "memory")
#define PG8_BAR __builtin_amdgcn_s_barrier()
#define PG8_SCHED __builtin_amdgcn_sched_barrier(0)
    Unit cur, nxt; int ui = 0;
    if (!S.next(0, cur)) return;
    f32x4 acc[2][2][4][2];
#pragma unroll
    for (int a = 0; a < 2; ++a)
#pragma unroll
        for (int b = 0; b < 2; ++b)
#pragma unroll
            for (int m = 0; m < 4; ++m)
#pragma unroll
                for (int n = 0; n < 2; ++n) acc[a][b][m][n] = (f32x4){0.f, 0.f, 0.f, 0.f};
    bf16x8 At[4][2], B0[2][2], B1[2][2];
    const char* cA = (const char*)g.A + (size_t)cur.pm * tstep; const char* cB = (const char*)g.Bt + (size_t)cur.pn * tstep;
    S.a_ready(cur);
    if constexpr (SP2) {
        PG8_STAGE(PG8_SB(0, 0), cB, voffB); PG8_STAGE(PG8_SB(0, 1), cB + hstep, voffB); PG8_STAGE(PG8_SA(0, 0), cA, voffA); PG8_STAGE(PG8_SA(0, 1), cA + hstep, voffA);
        if (wr == 1) PG8_BAR;
        PG8_WAIT_V(2); PG8_BAR;
        PG8_STAGE(PG8_SB(1, 0), cB + kstep, voffB); PG8_STAGE(PG8_SA(1, 0), cA + kstep, voffA); PG8_STAGE(PG8_SB(1, 1), cB + hstep + kstep, voffB);
        PG8_WAIT_V(6); PG8_BAR;
    } else {
        PG8_STAGE(PG8_SB(0, 0), cB, voffB); PG8_STAGE(PG8_SA(0, 0), cA, voffA); PG8_STAGE(PG8_SB(0, 1), cB + hstep, voffB); PG8_STAGE(PG8_SA(0, 1), cA + hstep, voffA);
        if (wr == 1) PG8_BAR;
        PG8_WAIT_V(4); PG8_BAR;
        PG8_STAGE(PG8_SB(1, 0), cB + kstep, voffB); PG8_STAGE(PG8_SA(1, 0), cA + kstep, voffA); PG8_STAGE(PG8_SB(1, 1), cB + hstep + kstep, voffB);
        PG8_WAIT_V(6); PG8_BAR;
    }
    for (;;) {
        const bool has_next = S.next(ui + 1, nxt);
        const char* nA = has_next ? (const char*)g.A + (size_t)nxt.pm * tstep : cA; const char* nB = has_next ? (const char*)g.Bt + (size_t)nxt.pn * tstep : cB;
        for (int t = 0; t < nt; t += 2) {
            const bool last = (t == nt - 2);
            const char* a1 = cA + (size_t)(t + 1) * kstep;
            const char* a2 = last ? nA : cA + (size_t)(t + 2) * kstep; const char* b2 = last ? nB : cB + (size_t)(t + 2) * kstep;
            const char* a3 = a2 + kstep; const char* b3 = b2 + kstep;
            if (last && has_next) S.a_ready(nxt);
            if constexpr (Epi::MIDSCALE) { if (t == nt / 2) E.midscale(acc, wr, fr); }
            if constexpr (SP2) {
            PG8_LDB(B0, 0, 0); PG8_LDB(B1, 0, 1); PG8_SCHED; PG8_LDA(At, 0, 0); PG8_STAGE(PG8_SA(1, 1), a1 + hstep, voffA);
            PG8_WAIT_V(8); PG8_WAIT_L(0); PG8_BAR; PG8_MMA(0, 0, At, B0); PG8_MMA(0, 1, At, B1); PG8_BAR; PG8_SCHED;
            PG8_LDA(At, 0, 1); PG8_STAGE(PG8_SB(0, 0), b2, voffB); PG8_STAGE(PG8_SB(0, 1), b2 + hstep, voffB); PG8_STAGE(PG8_SA(0, 0), a2, voffA);
            PG8_WAIT_V(8); PG8_WAIT_L(0); PG8_BAR; PG8_MMA(1, 0, At, B0); PG8_MMA(1, 1, At, B1); PG8_BAR; PG8_SCHED;
            PG8_LDB(B0, 1, 0); PG8_LDB(B1, 1, 1); PG8_SCHED; PG8_LDA(At, 1, 0); PG8_STAGE(PG8_SA(0, 1), a2 + hstep, voffA);
            PG8_WAIT_V(8); PG8_WAIT_L(0); PG8_BAR; PG8_MMA(0, 0, At, B0); PG8_MMA(0, 1, At, B1); PG8_BAR; PG8_SCHED;
            PG8_LDA(At, 1, 1); PG8_STAGE(PG8_SB(1, 0), b3, voffB); PG8_STAGE(PG8_SB(1, 1), b3 + hstep, voffB); PG8_STAGE(PG8_SA(1, 0), a3, voffA);
            PG8_WAIT_V(8); PG8_WAIT_L(0); PG8_BAR; PG8_MMA(1, 0, At, B0); PG8_MMA(1, 1, At, B1); PG8_BAR; PG8_SCHED;
            } else {
            PG8_LDB(B0, 0, 0); PG8_SCHED; PG8_LDA(At, 0, 0); PG8_STAGE(PG8_SA(1, 1), a1 + hstep, voffA);
            PG8_WAIT_L(8); PG8_BAR; PG8_WAIT_L(0); PG8_MMA(0, 0, At, B0); PG8_BAR; PG8_SCHED;
            PG8_LDB(B1, 0, 1); PG8_STAGE(PG8_SB(0, 0), b2, voffB);
            PG8_BAR; PG8_WAIT_L(0); PG8_MMA(0, 1, At, B1); PG8_BAR;
            PG8_LDA(At, 0, 1); PG8_STAGE(PG8_SA(0, 0), a2, voffA);
            PG8_BAR; PG8_WAIT_L(0); PG8_MMA(1, 0, At, B0); PG8_BAR; PG8_SCHED;
            PG8_STAGE(PG8_SB(0, 1), b2 + hstep, voffB);
            PG8_WAIT_V(6); PG8_BAR; PG8_MMA(1, 1, At, B1); PG8_BAR;
            PG8_LDB(B0, 1, 0); PG8_SCHED; PG8_LDA(At, 1, 0); PG8_STAGE(PG8_SA(0, 1), a2 + hstep, voffA);
            PG8_WAIT_L(8); PG8_BAR; PG8_WAIT_L(0); PG8_MMA(0, 0, At, B0); PG8_BAR; PG8_SCHED;
            PG8_LDB(B1, 1, 1); PG8_STAGE(PG8_SB(1, 0), b3, voffB);
            PG8_BAR; PG8_WAIT_L(0); PG8_MMA(0, 1, At, B1); PG8_BAR;
            PG8_LDA(At, 1, 1); PG8_STAGE(PG8_SA(1, 0), a3, voffA);
            PG8_BAR; PG8_WAIT_L(0); PG8_MMA(1, 0, At, B0); PG8_BAR; PG8_SCHED;
            PG8_STAGE(PG8_SB(1, 1), b3 + hstep, voffB);
            PG8_WAIT_V(6); PG8_BAR; PG8_MMA(1, 1, At, B1); PG8_BAR;
            }
        }
        if constexpr (ALIGN_EPI) { if (wr == 0) PG8_BAR; }
        if constexpr (!Epi::AFTER_DRAIN) { E(acc, cur, wr, wc, fr, fq); S.done(cur); }
        if (!has_next) break;
#pragma unroll
        for (int a = 0; a < 2; ++a)
#pragma unroll
            for (int b = 0; b < 2; ++b)
#pragma unroll
                for (int m = 0; m < 4; ++m)
#pragma unroll
                    for (int n = 0; n < 2; ++n) acc[a][b][m][n] = (f32x4){0.f, 0.f, 0.f, 0.f};
        cur = nxt; cA = nA; cB = nB; ++ui;
        if constexpr (ALIGN_EPI) { if (wr == 1) PG8_BAR; }
    }
    PG8_WAIT_V(0);
    if constexpr (!ALIGN_EPI) { if (wr == 0) PG8_BAR; }
    PG8_BAR;
    if constexpr (Epi::AFTER_DRAIN) { E.fused(acc, cur, wr, wc, fr, fq, lds, wid, lane); S.done(cur); }
#undef PG8_SA
#undef PG8_SB
#undef PG8_STAGE
#undef PG8_LDA
#undef PG8_LDB
#undef PG8_MMA
#undef PG8_WAIT_V
#undef PG8_WAIT_L
#undef PG8_BAR
#undef PG8_SCHED
}
}

constexpr int BATCH = 4, SEQ = 8192, DM = 2048, M = BATCH * SEQ, DG = 1024, DL = 1024, NZ = 5120, DP = 256, CHK = 128, NH = 8;
constexpr float EPS = 1e-6f;
constexpr int NWAVES = 8, NTHR = NWAVES * 64;
#ifndef MK_N_LAUNCHES
#define MK_N_LAUNCHES 1
#endif
constexpr int N_PHASES = 8;
#ifndef PROBE_DOUBLE
#define PROBE_DOUBLE 0
#endif
#define REPS(k) for (int rep_ = 0; rep_ < 1 + ((PROBE_DOUBLE >> (k)) & 1); ++rep_)

constexpr size_t MiB = 1u << 20;
constexpr size_t WS_WIN = 2 * MiB;
constexpr size_t WS_WOUT = 22 * MiB;
constexpr size_t WS_WPG = 30 * MiB;
constexpr size_t WS_WPE = 38 * MiB;
constexpr size_t WS_WA = 39 * MiB;
constexpr size_t WS_WX = WS_WA + 256 * 1024;
constexpr size_t WS_WSM = WS_WX + 256 * 1024;
constexpr size_t WS_VST = 40 * MiB;
constexpr size_t WS_SSA = 44 * MiB;
constexpr size_t WS_SSB = 45 * MiB;
constexpr size_t WS_SSO = 46 * MiB;
constexpr size_t WS_AGG = 50 * MiB;
constexpr size_t WS_RSTD = 52 * MiB;
constexpr size_t WS_A1 = 64 * MiB;
constexpr size_t WS_PBF = 192 * MiB;
constexpr size_t WS_PE = 208 * MiB;
constexpr size_t WS_Z = 336 * MiB;
constexpr size_t WS_Y = 656 * MiB;
constexpr size_t WS_O = 784 * MiB;
constexpr size_t WS_END = 912 * MiB;

constexpr int LDS_BYTES = 147456;
constexpr int IMG0 = 0, IMG1 = 32768, IMG2 = 65536, IMG3 = 98304, MISC = 131072;
constexpr int MISC_STAT = MISC, MISC_PART = MISC + 1024, MISC_CPART = MISC + 5120;

#define LAS __attribute__((address_space(3)))
typedef unsigned short bf16;
typedef unsigned char uchar;
typedef float f32x4 __attribute__((ext_vector_type(4)));
typedef float f32x2 __attribute__((ext_vector_type(2)));
typedef unsigned u32x4 __attribute__((ext_vector_type(4)));
typedef unsigned u32x2 __attribute__((ext_vector_type(2)));
typedef short bf16x8 __attribute__((ext_vector_type(8)));

__device__ __forceinline__ unsigned f2bf(float f) { unsigned u = __builtin_bit_cast(unsigned, f); return (u + 0x7fffu + ((u >> 16) & 1u)) >> 16; }
__device__ __forceinline__ unsigned pk2(float lo, float hi) { unsigned r; asm("v_cvt_pk_bf16_f32 %0, %1, %2" : "=v"(r) : "v"(lo), "v"(hi)); return r; }
__device__ __forceinline__ float bflo(unsigned w) { return __uint_as_float(w << 16); }
__device__ __forceinline__ float bfhi(unsigned w) { return __uint_as_float(w & 0xffff0000u); }
__device__ __forceinline__ float wave_sum(float v) {
#pragma unroll
    for (int o = 1; o < 64; o <<= 1) v += __shfl_xor(v, o);
    return v;
}
__device__ __forceinline__ float sigmoidf_(float x) { return __builtin_amdgcn_rcpf(1.0f + __expf(-x)); }

struct Args { const float* in[21]; float* out; unsigned char* ws; int ph_lo, ph_hi; };
typedef const __attribute__((address_space(4))) Args* ArgP;
struct Frame {
    LAS uchar* lds;
    int tid, lane, wave, G, bid;
    int wv;
    ArgP ap;
};
#define PHASE_BEGIN(F) do { int w_ = (F).wv; unsigned z_ = 0u; ArgP a_ = (ArgP)__builtin_amdgcn_kernarg_segment_ptr(); asm volatile("" : "+s"(w_), "+s"(a_), "+s"(z_)); \
    const int l_ = (int)__builtin_amdgcn_mbcnt_hi(~0u, __builtin_amdgcn_mbcnt_lo(~0u, z_));     \
    (F).lane = l_; (F).wave = w_; (F).tid = w_ * 64 + l_; (F).ap = a_; } while (0)

__device__ __forceinline__ void p0_transpose_item(const float* W, int K, int N, bf16* WT, LAS float* scr, int item, int lane, const float* ks0, const float* ks1, int ksplit) {
    const int nblk = N / 32, kb = item / nblk, nb = item % nblk, k0 = 64 * kb, n0 = 32 * nb;
#pragma unroll 8
    for (int i = 0; i < 32; ++i) { const int kk = 2 * i + (lane >> 5); float v = W[(size_t)(k0 + kk) * N + n0 + (lane & 31)];
        if (ks0) { const int k = k0 + kk; v *= (k < ksplit) ? ks0[k] : ks1[k - ksplit]; }
        scr[kk * 33 + (lane & 31)] = v; }
    asm volatile("s_waitcnt lgkmcnt(0)" ::: "memory");
    const int c = lane & 7;
#pragma unroll
    for (int j = 0; j < 4; ++j) { const int n = (lane >> 3) + 8 * j; const LAS float* s = scr + (8 * c) * 33 + n;
        u32x4 o; o.x = pk2(s[0 * 33], s[1 * 33]); o.y = pk2(s[2 * 33], s[3 * 33]); o.z = pk2(s[4 * 33], s[5 * 33]); o.w = pk2(s[6 * 33], s[7 * 33]);
        *(u32x4*)(WT + (size_t)(n0 + n) * K + k0 + 8 * c) = o; }
    asm volatile("s_waitcnt lgkmcnt(0)" ::: "memory");
}

__device__ __forceinline__ void p0_prologue(Frame& F) {
    LAS float* scr = (LAS float*)(F.lds + F.wave * 16384);
    const int gw = F.bid * NWAVES + F.wave, NGW = F.G * NWAVES;
    const float* w_in = F.ap->in[3]; const float* w_out = F.ap->in[17]; const float* w_pe = F.ap->in[19]; const float* w_pg = F.ap->in[20];
    const float* w_a = F.ap->in[10]; const float* w_x = F.ap->in[12];
    bf16* WIN = (bf16*)(((uchar*)F.ap->ws) + WS_WIN); bf16* WOUT = (bf16*)(((uchar*)F.ap->ws) + WS_WOUT); bf16* WPG = (bf16*)(((uchar*)F.ap->ws) + WS_WPG); bf16* WPE = (bf16*)(((uchar*)F.ap->ws) + WS_WPE);
    bf16* WA = (bf16*)(((uchar*)F.ap->ws) + WS_WA); bf16* WX = (bf16*)(((uchar*)F.ap->ws) + WS_WX); bf16* WSM = (bf16*)(((uchar*)F.ap->ws) + WS_WSM);
    constexpr int I_IN = (DM / 64) * (NZ / 32), I_OUT = (DM / 64) * (DM / 32), I_PG = I_OUT, I_PE = (DP / 64) * (DM / 32), I_SM = 16 * 8;
    constexpr int NITEMS = I_IN + I_OUT + I_PG + I_PE + I_SM;
    for (int it = gw; it < NITEMS; it += NGW) {
        int r = it;
        if (r < I_IN) { p0_transpose_item(w_in, DM, NZ, WIN, scr, r, F.lane, nullptr, nullptr, 0); continue; } r -= I_IN;
        if (r < I_OUT) { p0_transpose_item(w_out, DM, DM, WOUT, scr, r, F.lane, F.ap->in[15], F.ap->in[16], DG); continue; } r -= I_OUT;
        if (r < I_PG) { p0_transpose_item(w_pg, DM, DM, WPG, scr, r, F.lane, nullptr, nullptr, 0); continue; } r -= I_PG;
        if (r < I_PE) { p0_transpose_item(w_pe, DP, DM, WPE, scr, r, F.lane, nullptr, nullptr, 0); continue; } r -= I_PE;
        { const int mat = r >> 3, sub = r & 7;
          const float* src = (mat < 8 ? w_a : w_x) + (size_t)(mat & 7) * 16384; bf16* dst = (mat < 8 ? WA : WX) + (size_t)(mat & 7) * 16384;
          p0_transpose_item(src, 128, 128, dst, scr, sub, F.lane, nullptr, nullptr, 0); }
    }
    { const float* ws_ = F.ap->in[6]; const int gt = F.bid * NTHR + F.tid, NGT = F.G * NTHR;
      for (int i = gt; i < NH * CHK * CHK / 2; i += NGT) { const int e = 2 * i, s = e & 127, t = (e >> 7) & 127; const f32x2 v = *(const f32x2*)(ws_ + e);
          ((unsigned*)WSM)[i] = pk2(s <= t ? v.x : 0.f, (s + 1) <= t ? v.y : 0.f); } }
    { const float* x = F.ap->in[0]; const float* pg = F.ap->in[2]; bf16* A1 = (bf16*)(((uchar*)F.ap->ws) + WS_A1);
      for (int m = gw; m < M; m += NGW) {
          const f32x4* xr = (const f32x4*)(x + (size_t)m * DM) + F.lane; f32x4 v[8]; float ss = 0.f;
#pragma unroll
          for (int j = 0; j < 8; ++j) { v[j] = xr[64 * j]; ss += (v[j].x * v[j].x + v[j].y * v[j].y) + (v[j].z * v[j].z + v[j].w * v[j].w); }
          const float rstd = 1.0f / sqrtf(wave_sum(ss) * (1.0f / DM) + EPS);
          u32x2* o8 = (u32x2*)(A1 + (size_t)m * DM) + F.lane;
#pragma unroll
          for (int j = 0; j < 8; ++j) { const f32x4 g = ((const f32x4*)pg)[F.lane + 64 * j];
              u32x2 o; o.x = pk2(v[j].x * rstd * g.x, v[j].y * rstd * g.y); o.y = pk2(v[j].z * rstd * g.z, v[j].w * rstd * g.w); o8[64 * j] = o; }
      } }
    { const float* p = F.ap->in[1]; bf16* PB = (bf16*)(((uchar*)F.ap->ws) + WS_PBF); const size_t gt = (size_t)F.bid * NTHR + F.tid, NGT = (size_t)F.G * NTHR;
      for (size_t i = gt; i < (size_t)M * DP / 8; i += NGT) { const f32x4 a = ((const f32x4*)p)[2 * i], b = ((const f32x4*)p)[2 * i + 1];
          u32x4 o; o.x = pk2(a.x, a.y); o.y = pk2(a.z, a.w); o.z = pk2(b.x, b.y); o.w = pk2(b.z, b.w); ((u32x4*)PB)[i] = o; } }
}

__device__ __forceinline__ int sw16(int row) { return (row ^ (row >> 3)) & 15; }
__device__ __forceinline__ int img_off(int row, int chunk) { return row * 256 + ((chunk ^ sw16(row)) << 4); }
__device__ __forceinline__ void load_img(LAS uchar* img, const bf16* src, int tid) {
#pragma unroll
    for (int i = 0; i < 4; ++i) { const int q = tid + NTHR * i, row = q >> 4, ch = q & 15; const u32x4 v = *(const u32x4*)(src + row * 128 + ch * 8); *(LAS u32x4*)(img + img_off(row, ch)) = v; }
}
#define DPP_F(oldv, srcv, ctrl) __builtin_bit_cast(float, __builtin_amdgcn_update_dpp(__builtin_bit_cast(int, (float)(oldv)), __builtin_bit_cast(int, (float)(srcv)), (ctrl), 0xf, 0xf, false))

__device__ __forceinline__ void gmlp_unit(Frame& F, int c, int h) {
    const int tid = F.tid, lane = F.lane, w = F.wave, fr = lane & 15, fq = lane >> 4;
    const int t0 = c * CHK, tg4 = tid >> 4, cg = tid & 15;
    const bf16* Z = (const bf16*)(((uchar*)F.ap->ws) + WS_Z); bf16* Y = (bf16*)(((uchar*)F.ap->ws) + WS_Y);
    const f32x2* vst = (const f32x2*)(((uchar*)F.ap->ws) + WS_VST); float* SSA = (float*)(((uchar*)F.ap->ws) + WS_SSA);
    LAS f32x2* stat = (LAS f32x2*)(F.lds + MISC_STAT); LAS float* part = (LAS float*)(F.lds + MISC_PART);
    u32x4 gv[4], uu[4], gg[4];
#pragma unroll
    for (int j = 0; j < 4; ++j) { const bf16* zr = Z + (size_t)(t0 + 4 * tg4 + j) * NZ + 128 * h + 8 * cg;
        uu[j] = *(const u32x4*)zr; gv[j] = *(const u32x4*)(zr + DG); gg[j] = *(const u32x4*)(zr + 2 * DG); }
    if (tid < 128) { const f32x2* vp = vst + (size_t)(t0 + tid) * 16; float s = 0.f, q = 0.f;
#pragma unroll
        for (int k = 0; k < 16; ++k) { const f32x2 v = vp[k]; s += v.x; q += v.y; }
        const float mean = s * (1.0f / DG); float var = q * (1.0f / DG) - mean * mean; var = var > 0.f ? var : 0.f;
        stat[tid] = (f32x2){mean, 1.0f / sqrtf(var + EPS)}; }
    __syncthreads();
    {
        const float* lg = F.ap->in[4] + 128 * h + 8 * cg; const float* lb = F.ap->in[5] + 128 * h + 8 * cg;
        const f32x4 g0 = *(const f32x4*)lg, g1 = *(const f32x4*)(lg + 4), b0 = *(const f32x4*)lb, b1 = *(const f32x4*)(lb + 4);
        const float gsc[8] = {g0.x, g0.y, g0.z, g0.w, g1.x, g1.y, g1.z, g1.w}, bsc[8] = {b0.x, b0.y, b0.z, b0.w, b1.x, b1.y, b1.z, b1.w};
        float nv[4][8];
#pragma unroll
        for (int j = 0; j < 4; ++j) { const f32x2 st = stat[4 * tg4 + j]; const unsigned wv[4] = {gv[j].x, gv[j].y, gv[j].z, gv[j].w};
#pragma unroll
            for (int k = 0; k < 4; ++k) { nv[j][2 * k] = (bflo(wv[k]) - st.x) * st.y * gsc[2 * k] + bsc[2 * k]; nv[j][2 * k + 1] = (bfhi(wv[k]) - st.x) * st.y * gsc[2 * k + 1] + bsc[2 * k + 1]; } }
#pragma unroll
        for (int cc = 0; cc < 8; ++cc) { const int d = 8 * cg + cc; u32x2 o; o.x = pk2(nv[0][cc], nv[1][cc]); o.y = pk2(nv[2][cc], nv[3][cc]);
            *(LAS u32x2*)(F.lds + IMG0 + d * 256 + (((tg4 >> 1) ^ sw16(d)) << 4) + (tg4 & 1) * 8) = o; }
#pragma unroll
        for (int j = 0; j < 4; ++j) { *(LAS u32x4*)(F.lds + IMG2 + img_off(4 * tg4 + j, cg)) = uu[j]; *(LAS u32x4*)(F.lds + IMG3 + img_off(4 * tg4 + j, cg)) = gg[j]; }
    }
    __syncthreads();
    f32x4 acc[8];
#pragma unroll
    for (int T = 0; T < 8; ++T) acc[T] = (f32x4){0.f, 0.f, 0.f, 0.f};
    bf16x8 af[4];
#pragma unroll
    for (int kk = 0; kk < 4; ++kk) af[kk] = *(const LAS bf16x8*)(F.lds + IMG0 + img_off(16 * w + fr, 4 * kk + fq));
#pragma unroll
    for (int T = 0; T < 8; ++T)
#pragma unroll
        for (int kk = 0; kk <= (T >> 1); ++kk) { const bf16x8 bfr = *(const LAS bf16x8*)(F.lds + IMG1 + img_off(16 * T + fr, 4 * kk + fq));
            acc[T] = __builtin_amdgcn_mfma_f32_16x16x32_bf16(af[kk], bfr, acc[T], 0, 0, 0); }
    const float* bs = F.ap->in[7] + h * CHK;
#pragma unroll
    for (int T = 0; T < 8; ++T) { const int t = 16 * T + fr; const float bsv = bs[t];
        const int o = img_off(t, 2 * w + (fq >> 1)) + (fq & 1) * 8;
        const u32x2 uw = *(const LAS u32x2*)(F.lds + IMG2 + o), gw = *(const LAS u32x2*)(F.lds + IMG3 + o);
        const float y0 = bflo(uw.x) * (acc[T][0] + bsv) * bflo(gw.x), y1 = bfhi(uw.x) * (acc[T][1] + bsv) * bfhi(gw.x);
        const float y2 = bflo(uw.y) * (acc[T][2] + bsv) * bflo(gw.y), y3 = bfhi(uw.y) * (acc[T][3] + bsv) * bfhi(gw.y);
        float q = (y0 * y0 + y1 * y1) + (y2 * y2 + y3 * y3);
        u32x2 ow; ow.x = pk2(y0, y1); ow.y = pk2(y2, y3);
        *(u32x2*)(Y + (size_t)(t0 + t) * DM + 128 * h + 16 * w + 4 * fq) = ow;
        q += __shfl_xor(q, 16); q += __shfl_xor(q, 32);
        if (fq == 0) part[w * 128 + t] = q; }
    __syncthreads();
    if (tid < 128) { float s = 0.f;
#pragma unroll
        for (int k = 0; k < 8; ++k) s += part[k * 128 + tid];
        SSA[(size_t)(t0 + tid) * 8 + h] = s; }
}

template <bool APPLY>
__device__ __forceinline__ void lru_unit(Frame& F, int c, int h) {
    const int tid = F.tid, lane = F.lane, w = F.wave, fr = lane & 15, fq = lane >> 4;
    const int t0 = c * CHK, tseq0 = t0 & (SEQ - 1), tg4 = tid >> 4, cg = tid & 15;
    const bf16* Z = (const bf16*)(((uchar*)F.ap->ws) + WS_Z); bf16* Y = (bf16*)(((uchar*)F.ap->ws) + WS_Y);
    f32x2* AGG = (f32x2*)(((uchar*)F.ap->ws) + WS_AGG); float* SSB = (float*)(((uchar*)F.ap->ws) + WS_SSB);
    LAS float* part = (LAS float*)(F.lds + MISC_PART); LAS f32x2* cpart = (LAS f32x2*)(F.lds + MISC_CPART);
    u32x4 xb[7], gg[4];
#pragma unroll
    for (int k = 0; k < 7; ++k) { const int trel = 4 * tg4 - 3 + k;
        if (tseq0 + trel >= 0) xb[k] = *(const u32x4*)(Z + (size_t)(t0 + trel) * NZ + 3 * DG + 128 * h + 8 * cg); else xb[k] = (u32x4){0u, 0u, 0u, 0u}; }
    if (APPLY) {
#pragma unroll
        for (int j = 0; j < 4; ++j) gg[j] = *(const u32x4*)(Z + (size_t)(t0 + 4 * tg4 + j) * NZ + 4 * DG + 128 * h + 8 * cg);
        const int ch = tid & 127, pt = tid >> 7, cs = c & 63, cb0 = c - cs; const int lo = 16 * pt, hi = (16 * pt + 16 < cs) ? 16 * pt + 16 : cs;
        float A = 1.f, B = 0.f;
        for (int cc = lo; cc < hi; ++cc) { const f32x2 ab = AGG[(size_t)(cb0 + cc) * DL + 128 * h + ch]; B = ab.x * B + ab.y; A = ab.x * A; }
        cpart[pt * 128 + ch] = (f32x2){A, B};
    }
    {
        const float* cw = F.ap->in[8] + 128 * h + 8 * cg; const float* cbp = F.ap->in[9] + 128 * h + 8 * cg;
        float wk[4][8], cbv[8];
#pragma unroll
        for (int k = 0; k < 4; ++k) { const f32x4 a = *(const f32x4*)(cw + k * DL), b = *(const f32x4*)(cw + k * DL + 4);
            wk[k][0] = a.x; wk[k][1] = a.y; wk[k][2] = a.z; wk[k][3] = a.w; wk[k][4] = b.x; wk[k][5] = b.y; wk[k][6] = b.z; wk[k][7] = b.w; }
        { const f32x4 a = *(const f32x4*)cbp, b = *(const f32x4*)(cbp + 4); cbv[0] = a.x; cbv[1] = a.y; cbv[2] = a.z; cbv[3] = a.w; cbv[4] = b.x; cbv[5] = b.y; cbv[6] = b.z; cbv[7] = b.w; }
        float xc[4][8];
#pragma unroll
        for (int j = 0; j < 4; ++j)
#pragma unroll
            for (int e = 0; e < 8; ++e) xc[j][e] = cbv[e];
#pragma unroll
        for (int k = 0; k < 7; ++k) { const unsigned wv[4] = {xb[k].x, xb[k].y, xb[k].z, xb[k].w};
#pragma unroll
            for (int e2 = 0; e2 < 4; ++e2) { const float lo_ = bflo(wv[e2]), hi_ = bfhi(wv[e2]);
#pragma unroll
                for (int j = 0; j < 4; ++j) { const int kw = k - j; if (kw >= 0 && kw < 4) { xc[j][2 * e2] += wk[kw][2 * e2] * lo_; xc[j][2 * e2 + 1] += wk[kw][2 * e2 + 1] * hi_; } } } }
#pragma unroll
        for (int j = 0; j < 4; ++j) { u32x4 o; o.x = pk2(xc[j][0], xc[j][1]); o.y = pk2(xc[j][2], xc[j][3]); o.z = pk2(xc[j][4], xc[j][5]); o.w = pk2(xc[j][6], xc[j][7]);
            *(LAS u32x4*)(F.lds + IMG0 + img_off(4 * tg4 + j, cg)) = o;
            if (APPLY) *(LAS u32x4*)(F.lds + IMG3 + img_off(4 * tg4 + j, cg)) = gg[j]; }
    }
    __syncthreads();
    f32x4 accA[8], accX[8];
#pragma unroll
    for (int T = 0; T < 8; ++T) { accA[T] = (f32x4){0.f, 0.f, 0.f, 0.f}; accX[T] = (f32x4){0.f, 0.f, 0.f, 0.f}; }
    {
        bf16x8 afa[4], afx[4];
#pragma unroll
        for (int kk = 0; kk < 4; ++kk) { afa[kk] = *(const LAS bf16x8*)(F.lds + IMG1 + img_off(16 * w + fr, 4 * kk + fq)); afx[kk] = *(const LAS bf16x8*)(F.lds + IMG2 + img_off(16 * w + fr, 4 * kk + fq)); }
#pragma unroll
        for (int T = 0; T < 8; ++T)
#pragma unroll
            for (int kk = 0; kk < 4; ++kk) { const bf16x8 bfr = *(const LAS bf16x8*)(F.lds + IMG0 + img_off(16 * T + fr, 4 * kk + fq));
                accA[T] = __builtin_amdgcn_mfma_f32_16x16x32_bf16(afa[kk], bfr, accA[T], 0, 0, 0);
                accX[T] = __builtin_amdgcn_mfma_f32_16x16x32_bf16(afx[kk], bfr, accX[T], 0, 0, 0); }
    }
    const int chl = 16 * w + 4 * fq;
    float ba[4], bx[4], sp[4], H[4], Ap[4];
    { const f32x4 a = *(const f32x4*)(F.ap->in[11] + 128 * h + chl), b = *(const f32x4*)(F.ap->in[13] + 128 * h + chl), lm = *(const f32x4*)(F.ap->in[14] + 128 * h + chl);
      ba[0] = a.x; ba[1] = a.y; ba[2] = a.z; ba[3] = a.w; bx[0] = b.x; bx[1] = b.y; bx[2] = b.z; bx[3] = b.w;
      const float lmv[4] = {lm.x, lm.y, lm.z, lm.w};
#pragma unroll
      for (int r = 0; r < 4; ++r) { const float xx = -lmv[r]; const float spl = (xx > 0.f ? xx : 0.f) + log1pf(__expf(-fabsf(xx)));
          sp[r] = -8.0f * 1.44269504f * spl; ba[r] *= -1.44269504f; bx[r] *= -1.44269504f; } }
#pragma unroll
    for (int r = 0; r < 4; ++r) { H[r] = 0.f; Ap[r] = 1.f; }
    if (APPLY) {
#pragma unroll
        for (int r = 0; r < 4; ++r) { float hh = 0.f;
#pragma unroll
            for (int p = 0; p < 4; ++p) { const f32x2 ab = cpart[p * 128 + chl + r]; hh = ab.x * hh + ab.y; }
            H[r] = hh; } }
#pragma unroll
    for (int T = 0; T < 8; ++T) { const int t = 16 * T + fr; const bool first = (tseq0 + t) == 0;
        const int o = img_off(t, 2 * w + (fq >> 1)) + (fq & 1) * 8;
        const u32x2 xw = *(const LAS u32x2*)(F.lds + IMG0 + o);
        const float xcv[4] = {bflo(xw.x), bfhi(xw.x), bflo(xw.y), bfhi(xw.y)};
        float gvv[4] = {0.f, 0.f, 0.f, 0.f};
        if (APPLY) { const u32x2 gw = *(const LAS u32x2*)(F.lds + IMG3 + o); gvv[0] = bflo(gw.x); gvv[1] = bfhi(gw.x); gvv[2] = bflo(gw.y); gvv[3] = bfhi(gw.y); }
        float yv[4];
#pragma unroll
        for (int r = 0; r < 4; ++r) {
            const float rg = __builtin_amdgcn_rcpf(1.0f + __builtin_amdgcn_exp2f(__builtin_fmaf(accA[T][r], -1.44269504f, ba[r])));
            const float ig = __builtin_amdgcn_rcpf(1.0f + __builtin_amdgcn_exp2f(__builtin_fmaf(accX[T][r], -1.44269504f, bx[r])));
            const float a = __builtin_amdgcn_exp2f(sp[r] * rg);
            const float m2 = __builtin_fmaf(-a, a, 1.0f);
            const float mult = first ? 1.0f : __builtin_amdgcn_sqrtf(m2);
            float A = a, B = mult * (ig * xcv[r]);
            { float Aq, Bq;
              Aq = DPP_F(1.0f, A, 0x111); Bq = DPP_F(0.0f, B, 0x111); B = A * Bq + B; A = A * Aq;
              Aq = DPP_F(1.0f, A, 0x112); Bq = DPP_F(0.0f, B, 0x112); B = A * Bq + B; A = A * Aq;
              Aq = DPP_F(1.0f, A, 0x114); Bq = DPP_F(0.0f, B, 0x114); B = A * Bq + B; A = A * Aq;
              Aq = DPP_F(1.0f, A, 0x118); Bq = DPP_F(0.0f, B, 0x118); B = A * Bq + B; A = A * Aq; }
            const float At = DPP_F(0.0f, A, 0x15F), Bt = DPP_F(0.0f, B, 0x15F);
            const float hv = A * H[r] + B;
            H[r] = At * H[r] + Bt; Ap[r] = Ap[r] * At;
            yv[r] = hv * gvv[r];
        }
        if (APPLY) {
            float q = (yv[0] * yv[0] + yv[1] * yv[1]) + (yv[2] * yv[2] + yv[3] * yv[3]);
            u32x2 ow; ow.x = pk2(yv[0], yv[1]); ow.y = pk2(yv[2], yv[3]);
            *(u32x2*)(Y + (size_t)(t0 + t) * DM + DG + 128 * h + chl) = ow;
            q += __shfl_xor(q, 16); q += __shfl_xor(q, 32);
            if (fq == 0) part[w * 128 + t] = q;
        }
    }
    if (!APPLY) { if (fr == 0) {
#pragma unroll
        for (int r = 0; r < 4; ++r) AGG[(size_t)c * DL + 128 * h + chl + r] = (f32x2){Ap[r], H[r]}; } }
    __syncthreads();
    if (APPLY) { if (tid < 128) { float s = 0.f;
#pragma unroll
        for (int k = 0; k < 8; ++k) s += part[k * 128 + tid];
        SSB[(size_t)(t0 + tid) * 8 + h] = s; } }
}

#define XB_TMO      128
#define XB_XCNT(j)  (256  + 64 * (j))
#define XB_XSUB(j)  (1280 + 64 * (j))
#define XB_XGEN(j)  (2304 + 64 * (j))
#define XB_TOP      3328
#define XB_TOPGEN   3392
#define XCD_BAR_WORDS 3456
#define XB_SPIN_CAP (1u << 18)
constexpr int LDS_BARST = MISC + 15 * 1024;
__device__ __forceinline__ unsigned xb_ld(unsigned* p)              { return __hip_atomic_load(p, __ATOMIC_RELAXED, __HIP_MEMORY_SCOPE_AGENT); }
__device__ __forceinline__ unsigned xb_add(unsigned* p, unsigned v) { return __hip_atomic_fetch_add(p, v, __ATOMIC_RELAXED, __HIP_MEMORY_SCOPE_AGENT); }
__device__ __forceinline__ unsigned xb_xcc_id() { return (unsigned)__builtin_amdgcn_s_getreg((3 << 11) | 20) & 0xFu; }
#define XB_SPIN(cond, bar) do { unsigned _sp = 0; while (cond) { __builtin_amdgcn_s_sleep(1); \
    if ((++_sp & 255u) == 0u) { if (xb_ld(&(bar)[XB_TMO])) break; if (_sp > XB_SPIN_CAP) { atomicAdd(&(bar)[XB_TMO], 1u); break; } } } } while (0)
__device__ __forceinline__ void xcd_barrier_complete(unsigned* bar, unsigned x, unsigned& nloc, unsigned& nx) {
    const unsigned G = gridDim.x;
    unsigned sum, cnt, mine, sp = 0u;
    for (;;) {
        sum = 0u; cnt = 0u; mine = 0u;
#pragma unroll
        for (unsigned j = 0; j < 16; ++j) { const unsigned c = xb_ld(&bar[XB_XCNT(j)]); sum += c; cnt += (c > 0u) ? 1u : 0u; mine = (j == x) ? c : mine; }
        if (sum == G) break;
        __builtin_amdgcn_s_sleep(1);
        if ((++sp & 255u) == 0u) { if (xb_ld(&bar[XB_TMO])) break; if (sp > XB_SPIN_CAP) { atomicAdd(&bar[XB_TMO], 1u); break; } }
    }
    nloc = mine > 0u ? mine : 1u; nx = cnt > 0u ? cnt : 1u;
}
__device__ __forceinline__ void xcd_barrier(unsigned* bar, volatile LAS unsigned* st, int tid) {
    asm volatile("s_waitcnt vmcnt(0)" ::: "memory");
    __syncthreads();
    if (tid == 0) {
        const unsigned x = xb_xcc_id();
        __builtin_amdgcn_s_waitcnt(0);
        unsigned nloc = st[0], nx = st[1];
        if (nloc == 0u) { xcd_barrier_complete(bar, x, nloc, nx); st[0] = nloc; st[1] = nx; }
        const unsigned old = xb_add(&bar[XB_XSUB(x)], 1u);
        const unsigned gen = old / nloc;
        if (old + 1u == (gen + 1u) * nloc) {
            __builtin_amdgcn_fence(__ATOMIC_RELEASE, "agent");
            asm volatile("s_waitcnt vmcnt(0)" ::: "memory");
            const unsigned og = xb_add(&bar[XB_TOP], 1u);
            const unsigned tg = og / nx;
            if (og + 1u == (tg + 1u) * nx) xb_add(&bar[XB_TOPGEN], 1u);
            else XB_SPIN(xb_ld(&bar[XB_TOPGEN]) == tg, bar);
            __builtin_amdgcn_fence(__ATOMIC_ACQUIRE, "agent");
            xb_add(&bar[XB_XGEN(x)], 1u);
            asm volatile("s_waitcnt vmcnt(0)" ::: "memory");
        } else {
            XB_SPIN(xb_ld(&bar[XB_XGEN(x)]) == gen, bar);
            __builtin_amdgcn_fence(__ATOMIC_ACQUIRE, "agent");
            asm volatile("s_waitcnt vmcnt(0)" ::: "memory");
        }
    }
    __syncthreads();
}

__global__ void __launch_bounds__(NTHR, 2) mk_fwd(Args args_unused) {
    extern __shared__ __attribute__((aligned(16))) unsigned char lds_raw[];
    Frame F;
    F.lds = (LAS uchar*)lds_raw; F.G = gridDim.x; F.bid = blockIdx.x; F.wv = __builtin_amdgcn_readfirstlane((int)threadIdx.x >> 6);
    PHASE_BEGIN(F);
    const int lo = F.ap->ph_lo, hi = F.ap->ph_hi;
#define IN(k) (lo <= (k) && (k) < hi)
#if MK_N_LAUNCHES == 1
#define SEAM(k) do { if (IN(k) && IN((k) + 1)) { PHASE_BEGIN(F); xcd_barrier((unsigned*)F.ap->ws, (volatile LAS unsigned*)(F.lds + LDS_BARST), F.tid); } } while (0)
#else
#define SEAM(k) do { } while (0)
#endif
#define WSB(off) ((bf16*)((uchar*)F.ap->ws + (off)))
#define WSF(off) ((float*)((uchar*)F.ap->ws + (off)))

    if (F.tid < 2) ((volatile LAS unsigned*)(F.lds + LDS_BARST))[F.tid] = 0u;
    if (IN(0)) {
#if MK_N_LAUNCHES == 1
        if (F.bid == 0) { unsigned* bw = (unsigned*)F.ap->ws; for (int i = F.tid; i < 4096; i += NTHR) __hip_atomic_store(bw + i, 0u, __ATOMIC_RELAXED, __HIP_MEMORY_SCOPE_AGENT); }
#endif
        REPS(0) { p0_prologue(F); __syncthreads(); } }
#if MK_N_LAUNCHES == 1
    cg::this_grid().sync();
    PHASE_BEGIN(F);
    if (F.tid == 0) (void)xb_add((unsigned*)F.ap->ws + XB_XCNT(xb_xcc_id()), 1u);
#endif
    if (IN(1)) REPS(1) {
        PHASE_BEGIN(F);
        { pg8::Gemm g{WSB(WS_A1), WSB(WS_WIN), M, NZ, DM}; pg8::StaticOrder S; S.init(M, NZ, F.G, F.bid);
          pg8::EpiZ E{WSB(WS_Z), NZ, (pg8::f32x2*)WSF(WS_VST)};
          pg8::gemm_phase<pg8::EpiZ, pg8::StaticOrder, true, true>(F.lds, g, S, E, F.tid); }
        PHASE_BEGIN(F);
        { pg8::Gemm g{WSB(WS_PBF), WSB(WS_WPE), M, DM, DP}; pg8::StaticOrder S; S.init(M, DM, F.G, F.bid);
          pg8::EpiPlain E{WSB(WS_PE), DM};
          pg8::gemm_phase<pg8::EpiPlain, pg8::StaticOrder, true, true>(F.lds, g, S, E, F.tid); }
    }
    SEAM(1);
    if (IN(2)) REPS(2) {
        PHASE_BEGIN(F);
        int cur = -1;
        for (int u = F.bid; u < 2048; u += F.G) { const int h = u & 7, c = u >> 3;
            if (h != cur) { __syncthreads(); load_img(F.lds + IMG1, WSB(WS_WSM) + (size_t)h * 16384, F.tid); cur = h; }
            gmlp_unit(F, c, h); }
        PHASE_BEGIN(F);
        cur = -1;
        for (int u = F.bid; u < 2048; u += F.G) { const int h = u & 7, c = u >> 3;
            if (h != cur) { __syncthreads(); load_img(F.lds + IMG1, WSB(WS_WA) + (size_t)h * 16384, F.tid); load_img(F.lds + IMG2, WSB(WS_WX) + (size_t)h * 16384, F.tid); cur = h; }
            lru_unit<false>(F, c, h); }
        __syncthreads();
    }
    SEAM(2);
    if (IN(3)) REPS(3) {
        PHASE_BEGIN(F);
        int cur = -1;
        for (int u = F.bid; u < 2048; u += F.G) { const int h = u & 7, c = u >> 3;
            if (h != cur) { __syncthreads(); load_img(F.lds + IMG1, WSB(WS_WA) + (size_t)h * 16384, F.tid); load_img(F.lds + IMG2, WSB(WS_WX) + (size_t)h * 16384, F.tid); cur = h; }
            lru_unit<true>(F, c, h); }
        __syncthreads();
    }
    SEAM(3);
    if (IN(5)) REPS(5) {
        PHASE_BEGIN(F);
        pg8::StaticOrder S; S.init(M, DM, F.G, F.bid);
        {
            const float* SSA = WSF(WS_SSA); const float* SSB = WSF(WS_SSB); LAS f32x2* rr = (LAS f32x2*)(F.lds + MISC);
            for (int i = 0; i < 4; ++i) { pg8::Unit u; if (!S.next(i, u)) break;
                if (F.tid < 256) { const size_t row = (size_t)u.pm * 256 + F.tid;
                    const f32x4 a0 = *(const f32x4*)(SSA + row * 8), a1 = *(const f32x4*)(SSA + row * 8 + 4), b0 = *(const f32x4*)(SSB + row * 8), b1 = *(const f32x4*)(SSB + row * 8 + 4);
                    const float ra = 1.0f / sqrtf(((a0.x + a0.y) + (a0.z + a0.w) + (a1.x + a1.y) + (a1.z + a1.w)) * (1.0f / DG) + EPS);
                    const float rb = 1.0f / sqrtf(((b0.x + b0.y) + (b0.z + b0.w) + (b1.x + b1.y) + (b1.z + b1.w)) * (1.0f / DL) + EPS);
                    rr[i * 256 + F.tid] = (f32x2){ra / rb, rb}; } }
            __syncthreads();
        }
        pg8::Gemm g{WSB(WS_Y), WSB(WS_WOUT), M, DM, DM};
        pg8::EpiO E{WSB(WS_O), DM, WSF(WS_SSO), (const LAS pg8::f32x2*)(F.lds + MISC), 0};
        pg8::gemm_phase<pg8::EpiO, pg8::StaticOrder, true, true>(F.lds, g, S, E, F.tid);
        __syncthreads();
    }
    SEAM(5);
    if (IN(6)) REPS(6) {
        PHASE_BEGIN(F);
        const float* SSO = WSF(WS_SSO); const float* x = F.ap->in[0]; const float* pg = F.ap->in[18]; const bf16* Ob = WSB(WS_O); bf16* H1 = WSB(WS_A1); float* RS = WSF(WS_RSTD);
        const int gw = F.bid * NWAVES + F.wave, NGW = F.G * NWAVES;
        for (int m = gw; m < M; m += NGW) {
            float s = (F.lane < 32) ? SSO[(size_t)m * 32 + F.lane] : 0.f; s = wave_sum(s);
            const float rstd = 1.0f / sqrtf(s * (1.0f / DM) + EPS);
            if (F.lane == 0) RS[m] = rstd;
            const f32x4* xr = (const f32x4*)(x + (size_t)m * DM) + F.lane; const u32x2* orow = (const u32x2*)(Ob + (size_t)m * DM) + F.lane;
            u32x2* hr = (u32x2*)(H1 + (size_t)m * DM) + F.lane;
#pragma unroll
            for (int j = 0; j < 8; ++j) { const f32x4 xv = xr[64 * j]; const u32x2 ov = orow[64 * j]; const f32x4 g = ((const f32x4*)pg)[F.lane + 64 * j];
                u32x2 hb; hb.x = pk2(xv.x + bflo(ov.x) * rstd * g.x, xv.y + bfhi(ov.x) * rstd * g.y); hb.y = pk2(xv.z + bflo(ov.y) * rstd * g.z, xv.w + bfhi(ov.y) * rstd * g.w); hr[64 * j] = hb; }
        }
    }
    SEAM(6);
    if (IN(7)) {
        PHASE_BEGIN(F);
        pg8::Gemm g{WSB(WS_A1), WSB(WS_WPG), M, DM, DM}; pg8::StaticOrder S; S.init(M, DM, F.G, F.bid);
        pg8::EpiOut E{(float*)F.ap->out, F.ap->in[0], WSB(WS_O), WSB(WS_PE), WSF(WS_RSTD), F.ap->in[18], DM};
        pg8::gemm_phase<pg8::EpiOut, pg8::StaticOrder, true, true>(F.lds, g, S, E, F.tid);
    }
#undef IN
#undef SEAM
}

extern "C" void kernel_launch(void* const* d_in, const int* in_sizes, int n_in, void* d_out, int out_size, void* d_ws, size_t ws_size, hipStream_t stream) {
    static int grid = 0;
    if (grid == 0) {
        if (n_in != 21 || in_sizes[0] != M * DM || out_size != M * DM || ws_size < WS_END) { fprintf(stderr, "kernel_launch: unexpected problem (n_in %d, in0 %d, out %d, ws %zu); nothing launched\n", n_in, n_in > 0 ? in_sizes[0] : -1, out_size, ws_size); grid = -1; return; }
        int dev = 0, cus = 0, per_cu = 0;
        if (hipGetDevice(&dev) != hipSuccess || hipDeviceGetAttribute(&cus, hipDeviceAttributeMultiprocessorCount, dev) != hipSuccess) { fprintf(stderr, "kernel_launch: device query failed\n"); grid = -1; return; }
        if (hipFuncSetAttribute((const void*)mk_fwd, hipFuncAttributeMaxDynamicSharedMemorySize, LDS_BYTES) != hipSuccess) { fprintf(stderr, "kernel_launch: hipFuncSetAttribute failed\n"); grid = -1; return; }
        if (hipOccupancyMaxActiveBlocksPerMultiprocessor(&per_cu, (const void*)mk_fwd, NTHR, LDS_BYTES) != hipSuccess || per_cu < 1) { fprintf(stderr, "kernel_launch: occupancy query says %d blocks per CU\n", per_cu); per_cu = 1; }
        (void)hipGetLastError();
        grid = cus;
    }
    if (grid < 0) return;
    Args a{};
    for (int i = 0; i < 21; ++i) a.in[i] = (const float*)d_in[i];
    a.out = (float*)d_out; a.ws = (unsigned char*)d_ws;
#if MK_N_LAUNCHES == 1
    a.ph_lo = 0; a.ph_hi = N_PHASES;
    void* kargs[] = {&a};
    hipError_t e = hipLaunchCooperativeKernel((const void*)mk_fwd, dim3(grid), dim3(NTHR), kargs, LDS_BYTES, stream);
    if (e != hipSuccess) fprintf(stderr, "kernel_launch: cooperative launch failed: %s (grid %d)\n", hipGetErrorString(e), grid);
#else
    for (int li = 0; li < N_PHASES; ++li) { a.ph_lo = li; a.ph_hi = li + 1;
        hipLaunchKernelGGL(mk_fwd, dim3(grid), dim3(NTHR), LDS_BYTES, stream, a);
        const hipError_t le = hipPeekAtLastError(); if (le != hipSuccess) { fprintf(stderr, "kernel_launch: launch %d failed: %s\n", li, hipGetErrorName(le)); break; } }
#endif
}
```

```cpp
#define MK_N_LAUNCHES 1
#define PROBE_DOUBLE 0
#include <hip/hip_runtime.h>
#include <hip/hip_cooperative_groups.h>
#include <cstdio>
#include <cstdint>
namespace cg = cooperative_groups;
namespace pg8 {
#define PG8_LAS __attribute__((address_space(3)))
typedef unsigned short bf16_t;
typedef short bf16x8 __attribute__((ext_vector_type(8)));
typedef float f32x4 __attribute__((ext_vector_type(4)));
typedef unsigned u32x4 __attribute__((ext_vector_type(4)));
constexpr int BM = 256, BK = 64, HALF = 128, HTB = HALF * BK * 2  , STAGE_BYTES = 8 * HTB, NXCD = 8, WGM = 8;

__host__ __device__ __forceinline__ int lds_byte(int r, int c) { const int st = (r >> 4) * 2 + (c >> 5), rr = r & 15, cc = c & 31, ob = rr * 64 + cc * 2; return st * 1024 + (ob ^ (((ob >> 9) & 1) << 5)); }
__host__ __device__ __forceinline__ void stage_rc(int b, int& R, int& C) { const int st = b / 1024, sb = b % 1024, swz = sb ^ (((sb >> 9) & 1) << 5); R = (st >> 1) * 16 + swz / 64; C = (st & 1) * 32 + (swz % 64) / 2; }
__host__ __device__ __forceinline__ int perm32(int rho) { const int n = rho >> 4, i = rho & 15; return 8 * (i >> 2) + 4 * n + (i & 3); }

struct Unit { int pm, pn; };
struct Gemm { const bf16_t* A; const bf16_t* Bt; int M, N, K; };

struct StaticOrder {
    int nM, nN, nwg, G, c;
    __host__ __device__ void init(int M, int N, int G_, int c_) { nM = M / BM; nN = N / BM; nwg = nM * nN; G = G_; c = c_; }
    __host__ __device__ bool next(int i, Unit& u) const {
        const long L = (long)i * G + c; if (L >= nwg) return false;
        int wgid = (int)L; { const int q = nwg / NXCD, r = nwg % NXCD, xcd = wgid % NXCD, off = wgid / NXCD; wgid = (xcd < r ? xcd * (q + 1) : r * (q + 1) + (xcd - r) * q) + off; }
        const int nig = WGM * nN, gid = wgid / nig, fm = gid * WGM, gsz = (nM - fm) < WGM ? (nM - fm) : WGM;
        u.pm = fm + ((wgid % nig) % gsz); u.pn = (wgid % nig) / gsz; return true;
    }
    __device__ __forceinline__ void a_ready(const Unit&) const {}
    __device__ __forceinline__ void done(const Unit&) const {}
};

__device__ __forceinline__ unsigned cvt_pk_bf16(float lo, float hi) { unsigned r; asm volatile("v_cvt_pk_bf16_f32 %0, %1, %2" : "=v"(r) : "v"(lo), "v"(hi)); return r; }
typedef float f32x2 __attribute__((ext_vector_type(2)));
typedef unsigned u32x2 __attribute__((ext_vector_type(2)));
__device__ __forceinline__ float fast_sigmoid(float x) { return __builtin_amdgcn_rcpf(1.0f + __expf(-x)); }

struct EpiPlain {
    static constexpr bool PERM = true, AFTER_DRAIN = false, MIDSCALE = false;
    bf16_t* O; int ldc;
    __device__ __forceinline__ void operator()(const f32x4 (&acc)[2][2][4][2], const Unit& u, int wr, int wc, int fr, int fq) const {
        const int row0 = u.pm * BM + wr * 64 + fr, col0 = u.pn * BM + wc * 32 + 8 * fq;
#pragma unroll
        for (int ai = 0; ai < 2; ++ai)
#pragma unroll
            for (int m = 0; m < 4; ++m) { bf16_t* rowp = O + (size_t)(row0 + ai * HALF + m * 16) * ldc + col0;
#pragma unroll
                for (int bj = 0; bj < 2; ++bj) { const f32x4 v0 = acc[ai][bj][m][0], v1 = acc[ai][bj][m][1];
                    u32x4 w; w.x = cvt_pk_bf16(v0[0], v0[1]); w.y = cvt_pk_bf16(v0[2], v0[3]); w.z = cvt_pk_bf16(v1[0], v1[1]); w.w = cvt_pk_bf16(v1[2], v1[3]);
                    *(u32x4*)(rowp + bj * HALF) = w; } }
    }
};

struct EpiZ {
    static constexpr bool PERM = true, AFTER_DRAIN = false, MIDSCALE = false;
    bf16_t* Z; int ldc; f32x2* vst;
    __device__ __forceinline__ void operator()(const f32x4 (&acc)[2][2][4][2], const Unit& u, int wr, int wc, int fr, int fq) const {
        const int row0 = u.pm * BM + wr * 64 + fr, col0 = u.pn * BM + wc * 32 + 8 * fq;
        const int grp = u.pn >> 2;
#pragma unroll
        for (int ai = 0; ai < 2; ++ai)
#pragma unroll
            for (int m = 0; m < 4; ++m) { const int row = row0 + ai * HALF + m * 16; bf16_t* rowp = Z + (size_t)row * ldc + col0;
                float s = 0.f, q = 0.f;
#pragma unroll
                for (int bj = 0; bj < 2; ++bj) { f32x4 v[2] = {acc[ai][bj][m][0], acc[ai][bj][m][1]};
                    if (grp != 3) {
#pragma unroll
                        for (int n = 0; n < 2; ++n)
#pragma unroll
                            for (int j = 0; j < 4; ++j) { const float x = v[n][j]; const float a = (grp < 2) ? 1.5957691216f * (x + 0.044715f * x * x * x) : x; v[n][j] = x * fast_sigmoid(a); }
                    }
                    if (grp == 1) {
#pragma unroll
                        for (int n = 0; n < 2; ++n)
#pragma unroll
                            for (int j = 0; j < 4; ++j) { s += v[n][j]; q += v[n][j] * v[n][j]; }
                    }
                    u32x4 w; w.x = cvt_pk_bf16(v[0][0], v[0][1]); w.y = cvt_pk_bf16(v[0][2], v[0][3]); w.z = cvt_pk_bf16(v[1][0], v[1][1]); w.w = cvt_pk_bf16(v[1][2], v[1][3]);
                    *(u32x4*)(rowp + bj * HALF) = w; }
                if (grp == 1) { s += __shfl_xor(s, 16); s += __shfl_xor(s, 32); q += __shfl_xor(q, 16); q += __shfl_xor(q, 32);
                    if (fq == 0) vst[(size_t)row * 16 + (u.pn - 4) * 4 + wc] = (f32x2){s, q}; }
            }
    }
};

struct EpiO {
    static constexpr bool PERM = true, AFTER_DRAIN = false, MIDSCALE = true;
    bf16_t* O; int ldc; float* sso; const PG8_LAS f32x2* rr; mutable int ui;
    __device__ __forceinline__ void midscale(f32x4 (&acc)[2][2][4][2], int wr, int fr) const {
#pragma unroll
        for (int ai = 0; ai < 2; ++ai)
#pragma unroll
            for (int m = 0; m < 4; ++m) { const float s = rr[ui * 256 + ai * HALF + wr * 64 + m * 16 + fr].x;
#pragma unroll
                for (int bj = 0; bj < 2; ++bj)
#pragma unroll
                    for (int n = 0; n < 2; ++n) acc[ai][bj][m][n] *= s; }
    }
    __device__ __forceinline__ void operator()(const f32x4 (&acc)[2][2][4][2], const Unit& u, int wr, int wc, int fr, int fq) const {
        const int row0 = u.pm * BM + wr * 64 + fr, col0 = u.pn * BM + wc * 32 + 8 * fq;
#pragma unroll
        for (int ai = 0; ai < 2; ++ai)
#pragma unroll
            for (int m = 0; m < 4; ++m) { const int row = row0 + ai * HALF + m * 16; bf16_t* rowp = O + (size_t)row * ldc + col0;
                const float s = rr[ui * 256 + ai * HALF + wr * 64 + m * 16 + fr].y;
                float q = 0.f;
#pragma unroll
                for (int bj = 0; bj < 2; ++bj) { const f32x4 v0 = acc[ai][bj][m][0] * s, v1 = acc[ai][bj][m][1] * s;
#pragma unroll
                    for (int j = 0; j < 4; ++j) { q += v0[j] * v0[j]; q += v1[j] * v1[j]; }
                    u32x4 w; w.x = cvt_pk_bf16(v0[0], v0[1]); w.y = cvt_pk_bf16(v0[2], v0[3]); w.z = cvt_pk_bf16(v1[0], v1[1]); w.w = cvt_pk_bf16(v1[2], v1[3]);
                    *(u32x4*)(rowp + bj * HALF) = w; }
                q += __shfl_xor(q, 16); q += __shfl_xor(q, 32);
                if (fq == 0) sso[(size_t)row * 32 + u.pn * 4 + wc] = q;
            }
        ++ui;
    }
};

struct EpiOut {
    static constexpr bool PERM = false, AFTER_DRAIN = false, MIDSCALE = false;
    float* out; const float* x; const bf16_t* o; const bf16_t* pe; const float* rstd; const float* pg; int ldc;
    __device__ __forceinline__ void operator()(const f32x4 (&acc)[2][2][4][2], const Unit& u, int wr, int wc, int fr, int fq) const {
        const int row0 = u.pm * BM + wr * 64 + fr, col0 = u.pn * BM + wc * 32 + 4 * fq;
#pragma unroll
        for (int ai = 0; ai < 2; ++ai)
#pragma unroll
            for (int m = 0; m < 4; ++m) { const int row = row0 + ai * HALF + m * 16; const size_t off = (size_t)row * ldc + col0; const float rs = rstd[row];
#pragma unroll
                for (int bj = 0; bj < 2; ++bj)
#pragma unroll
                    for (int n = 0; n < 2; ++n) { const size_t o2 = off + bj * HALF + n * 16;
                        const f32x4 xv = *(const f32x4*)(x + o2); const u32x2 ow = *(const u32x2*)(o + o2); const u32x2 pw = *(const u32x2*)(pe + o2);
                        const f32x4 gv = *(const f32x4*)(pg + col0 + bj * HALF + n * 16); const f32x4 a = acc[ai][bj][m][n];
                        f32x4 r;
                        r[0] = xv[0] + __uint_as_float(ow.x << 16) * rs * gv[0] + __uint_as_float(pw.x << 16) * fast_sigmoid(a[0]);
                        r[1] = xv[1] + __uint_as_float(ow.x & 0xffff0000u) * rs * gv[1] + __uint_as_float(pw.x & 0xffff0000u) * fast_sigmoid(a[1]);
                        r[2] = xv[2] + __uint_as_float(ow.y << 16) * rs * gv[2] + __uint_as_float(pw.y << 16) * fast_sigmoid(a[2]);
                        r[3] = xv[3] + __uint_as_float(ow.y & 0xffff0000u) * rs * gv[3] + __uint_as_float(pw.y & 0xffff0000u) * fast_sigmoid(a[3]);
                        *(f32x4*)(out + o2) = r; }
                asm volatile("" ::: "memory"); }
    }
};

template <class Epi, class Sched, bool ALIGN_EPI = false, bool SP2 = false>
__device__ __forceinline__ void gemm_phase(PG8_LAS unsigned char* lds, const Gemm g, const Sched& S, const Epi& E, int tid_in) {
    int tid_ = tid_in; asm volatile("" : "+v"(tid_));
    const int tid = tid_, wid = __builtin_amdgcn_readfirstlane(tid >> 6), lane = tid & 63, wr = wid >> 2, wc = wid & 3, fr = lane & 15, fq = lane >> 4;
    const int K = g.K, nt = K / BK;
    unsigned voffA[2], voffB[2];
#pragma unroll
    for (int i = 0; i < 2; ++i) { int R, C; stage_rc(tid * 16 + i * 8192, R, C); const int Rb = Epi::PERM ? ((R & ~31) + perm32(R & 31)) : R;
        voffA[i] = (unsigned)(R * K + C) * 2u; voffB[i] = (unsigned)(Rb * K + C) * 2u; }
    const size_t kstep = (size_t)(BK * 2);
    const size_t hstep = (size_t)HALF * K * 2;
    const size_t tstep = 2 * hstep;
    const unsigned ldsw = (unsigned)wid * 1024u;
    const int aoff = lds_byte(wr * 64 + fr, fq * 8), boff = lds_byte(wc * 32 + fr, fq * 8);
#define PG8_SA(b, h) (((b) * 2 + (h)) * HTB)
#define PG8_SB(b, h) ((4 + (b) * 2 + (h)) * HTB)
#define PG8_STAGE(bufoff, gbase, voff) do { _Pragma("unroll") for (int _i = 0; _i < 2; ++_i) \
        __builtin_amdgcn_global_load_lds((const unsigned*)((const char*)(gbase) + (voff)[_i]), (PG8_LAS unsigned*)(lds + (bufoff) + ldsw + _i * 8192), 16, 0, 0); } while (0)
#define PG8_LDA(dst, b, h) do { _Pragma("unroll") for (int m = 0; m < 4; ++m) _Pragma("unroll") for (int k = 0; k < 2; ++k) dst[m][k] = *(const PG8_LAS bf16x8*)(lds + PG8_SA(b, h) + aoff + m * 2048 + k * 1024); } while (0)
#define PG8_LDB(dst, b, h) do { _Pragma("unroll") for (int n = 0; n < 2; ++n) _Pragma("unroll") for (int k = 0; k < 2; ++k) dst[n][k] = *(const PG8_LAS bf16x8*)(lds + PG8_SB(b, h) + boff + n * 2048 + k * 1024); } while (0)
#define PG8_MMA(ai, bj, At, Bt) do { __builtin_amdgcn_s_setprio(1); _Pragma("unroll") for (int m = 0; m < 4; ++m) _Pragma("unroll") for (int n = 0; n < 2; ++n) _Pragma("unroll") for (int k = 0; k < 2; ++k) \
        acc[ai][bj][m][n] = __builtin_amdgcn_mfma_f32_16x16x32_bf16(Bt[n][k], At[m][k], acc[ai][bj][m][n], 0, 0, 0); __builtin_amdgcn_s_setprio(0); } while (0)
#define PG8_WAIT_V(n) asm volatile("s_waitcnt vmcnt(" #n ")" ::: "memory")
#define PG8_WAIT_L(n) asm volatile("s_waitcnt lgkmcnt(" #n ")" ::: "memory")
#define PG8_BAR __builtin_amdgcn_s_barrier()
#define PG8_SCHED __builtin_amdgcn_sched_barrier(0)
    Unit cur, nxt; int ui = 0;
    if (!S.next(0, cur)) return;
    f32x4 acc[2][2][4][2];
#pragma unroll
    for (int a = 0; a < 2; ++a)
#pragma unroll
        for (int b = 0; b < 2; ++b)
#pragma unroll
            for (int m = 0; m < 4; ++m)
#pragma unroll
                for (int n = 0; n < 2; ++n) acc[a][b][m][n] = (f32x4){0.f, 0.f, 0.f, 0.f};
    bf16x8 At[4][2], B0[2][2], B1[2][2];
    const char* cA = (const char*)g.A + (size_t)cur.pm * tstep; const char* cB = (const char*)g.Bt + (size_t)cur.pn * tstep;
    S.a_ready(cur);
    if constexpr (SP2) {
        PG8_STAGE(PG8_SB(0, 0), cB, voffB); PG8_STAGE(PG8_SB(0, 1), cB + hstep, voffB); PG8_STAGE(PG8_SA(0, 0), cA, voffA); PG8_STAGE(PG8_SA(0, 1), cA + hstep, voffA);
        if (wr == 1) PG8_BAR;
        PG8_WAIT_V(2); PG8_BAR;
        PG8_STAGE(PG8_SB(1, 0), cB + kstep, voffB); PG8_STAGE(PG8_SA(1, 0), cA + kstep, voffA); PG8_STAGE(PG8_SB(1, 1), cB + hstep + kstep, voffB);
        PG8_WAIT_V(6); PG8_BAR;
    } else {
        PG8_STAGE(PG8_SB(0, 0), cB, voffB); PG8_STAGE(PG8_SA(0, 0), cA, voffA); PG8_STAGE(PG8_SB(0, 1), cB + hstep, voffB); PG8_STAGE(PG8_SA(0, 1), cA + hstep, voffA);
        if (wr == 1) PG8_BAR;
        PG8_WAIT_V(4); PG8_BAR;
        PG8_STAGE(PG8_SB(1, 0), cB + kstep, voffB); PG8_STAGE(PG8_SA(1, 0), cA + kstep, voffA); PG8_STAGE(PG8_SB(1, 1), cB + hstep + kstep, voffB);
        PG8_WAIT_V(6); PG8_BAR;
    }
    for (;;) {
        const bool has_next = S.next(ui + 1, nxt);
        const char* nA = has_next ? (const char*)g.A + (size_t)nxt.pm * tstep : cA; const char* nB = has_next ? (const char*)g.Bt + (size_t)nxt.pn * tstep : cB;
        for (int t = 0; t < nt; t += 2) {
            const bool last = (t == nt - 2);
            const char* a1 = cA + (size_t)(t + 1) * kstep;
            const char* a2 = last ? nA : cA + (size_t)(t + 2) * kstep; const char* b2 = last ? nB : cB + (size_t)(t + 2) * kstep;
            const char* a3 = a2 + kstep; const char* b3 = b2 + kstep;
            if (last && has_next) S.a_ready(nxt);
            if constexpr (Epi::MIDSCALE) { if (t == nt / 2) E.midscale(acc, wr, fr); }
            if constexpr (SP2) {
            PG8_LDB(B0, 0, 0); PG8_LDB(B1, 0, 1); PG8_SCHED; PG8_LDA(At, 0, 0); PG8_STAGE(PG8_SA(1, 1), a1 + hstep, voffA);
            PG8_WAIT_V(8); PG8_WAIT_L(0); PG8_BAR; PG8_MMA(0, 0, At, B0); PG8_MMA(0, 1, At, B1); PG8_BAR; PG8_SCHED;
            PG8_LDA(At, 0, 1); PG8_STAGE(PG8_SB(0, 0), b2, voffB); PG8_STAGE(PG8_SB(0, 1), b2 + hstep, voffB); PG8_STAGE(PG8_SA(0, 0), a2, voffA);
            PG8_WAIT_V(8); PG8_WAIT_L(0); PG8_BAR; PG8_MMA(1, 0, At, B0); PG8_MMA(1, 1, At, B1); PG8_BAR; PG8_SCHED;
            PG8_LDB(B0, 1, 0); PG8_LDB(B1, 1, 1); PG8_SCHED; PG8_LDA(At, 1, 0); PG8_STAGE(PG8_SA(0, 1), a2 + hstep, voffA);
            PG8_WAIT_V(8); PG8_WAIT_L(0); PG8_BAR; PG8_MMA(0, 0, At, B0); PG8_MMA(0, 1, At, B1); PG8_BAR; PG8_SCHED;
            PG8_LDA(At, 1, 1); PG8_STAGE(PG8_SB(1, 0), b3, voffB); PG8_STAGE(PG8_SB(1, 1), b3 + hstep, voffB); PG8_STAGE(PG8_SA(1, 0), a3, voffA);
            PG8_WAIT_V(8); PG8_WAIT_L(0); PG8_BAR; PG8_MMA(1, 0, At, B0); PG8_MMA(1, 1, At, B1); PG8_BAR; PG8_SCHED;
            } else {
            PG8_LDB(B0, 0, 0); PG8_SCHED; PG8_LDA(At, 0, 0); PG8_STAGE(PG8_SA(1, 1), a1 + hstep, voffA);
            PG8_WAIT_L(8); PG8_BAR; PG8_WAIT_L(0); PG8_MMA(0, 0, At, B0); PG8_BAR; PG8_SCHED;
            PG8_LDB(B1, 0, 1); PG8_STAGE(PG8_SB(0, 0), b2, voffB);
            PG8_BAR; PG8_WAIT_L(0); PG8_MMA(0, 1, At, B1); PG8_BAR;
            PG8_LDA(At, 0, 1); PG8_STAGE(PG8_SA(0, 0), a2, voffA);
            PG8_BAR; PG8_WAIT_L(0); PG8_MMA(1, 0, At, B0); PG8_BAR; PG8_SCHED;
            PG8_STAGE(PG8_SB(0, 1), b2 + hstep, voffB);
            PG8_WAIT_V(6); PG8_BAR; PG8_MMA(1, 1, At, B1); PG8_BAR;
            PG8_LDB(B0, 1, 0); PG8_SCHED; PG8_LDA(At, 1, 0); PG8_STAGE(PG8_SA(0, 1), a2 + hstep, voffA);
            PG8_WAIT_L(8); PG8_BAR; PG8_WAIT_L(0); PG8_MMA(0, 0, At, B0); PG8_BAR; PG8_SCHED;
            PG8_LDB(B1, 1, 1); PG8_STAGE(PG8_SB(1, 0), b3, voffB);
            PG8_BAR; PG8_WAIT_L(0); PG8_MMA(0, 1, At, B1); PG8_BAR;
            PG8_LDA(At, 1, 1); PG8_STAGE(PG8_SA(1, 0), a3, voffA);
            PG8_BAR; PG8_WAIT_L(0); PG8_MMA(1, 0, At, B0); PG8_BAR; PG8_SCHED;
            PG8_STAGE(PG8_SB(1, 1), b3 + hstep, voffB);
            PG8_WAIT_V(6); PG8_BAR; PG8_MMA(1, 1, At, B1); PG8_BAR;
            }
        }
        if constexpr (ALIGN_EPI) { if (wr == 0) PG8_BAR; }
        if constexpr (!Epi::AFTER_DRAIN) { E(acc, cur, wr, wc, fr, fq); S.done(cur); }
        if (!has_next) break;
#pragma unroll
        for (int a = 0; a < 2; ++a)
#pragma unroll
            for (int b = 0; b < 2; ++b)
#pragma unroll
                for (int m = 0; m < 4; ++m)
#pragma unroll
                    for (int n = 0; n < 2; ++n) acc[a][b][m][n] = (f32x4){0.f, 0.f, 0.f, 0.f};
        cur = nxt; cA = nA; cB = nB; ++ui;
        if constexpr (ALIGN_EPI) { if (wr == 1) PG8_BAR; }
    }
    PG8_WAIT_V(0);
    if constexpr (!ALIGN_EPI) { if (wr == 0) PG8_BAR; }
    PG8_BAR;
    if constexpr (Epi::AFTER_DRAIN) { E.fused(acc, cur, wr, wc, fr, fq, lds, wid, lane); S.done(cur); }
#undef PG8_SA
#undef PG8_SB
#undef PG8_STAGE
#undef PG8_LDA
#undef PG8_LDB
#undef PG8_MMA
#undef PG8_WAIT_V
#undef PG8_WAIT_L
#undef PG8_BAR
#undef PG8_SCHED
}
}

constexpr int BATCH = 4, SEQ = 8192, DM = 2048, M = BATCH * SEQ, DG = 1024, DL = 1024, NZ = 5120, DP = 256, CHK = 128, NH = 8;
constexpr float EPS = 1e-6f;
constexpr int NWAVES = 8, NTHR = NWAVES * 64;
#ifndef MK_N_LAUNCHES
#define MK_N_LAUNCHES 1
#endif
constexpr int N_PHASES = 8;
#ifndef PROBE_DOUBLE
#define PROBE_DOUBLE 0
#endif
#define REPS(k) for (int rep_ = 0; rep_ < 1 + ((PROBE_DOUBLE >> (k)) & 1); ++rep_)

constexpr size_t MiB = 1u << 20;
constexpr size_t WS_WIN = 2 * MiB;
constexpr size_t WS_WOUT = 22 * MiB;
constexpr size_t WS_WPG = 30 * MiB;
constexpr size_t WS_WPE = 38 * MiB;
constexpr size_t WS_WA = 39 * MiB;
constexpr size_t WS_WX = WS_WA + 256 * 1024;
constexpr size_t WS_WSM = WS_WX + 256 * 1024;
constexpr size_t WS_VST = 40 * MiB;
constexpr size_t WS_SSA = 44 * MiB;
constexpr size_t WS_SSB = 45 * MiB;
constexpr size_t WS_SSO = 46 * MiB;
constexpr size_t WS_AGG = 50 * MiB;
constexpr size_t WS_RSTD = 52 * MiB;
constexpr size_t WS_A1 = 64 * MiB;
constexpr size_t WS_PBF = 192 * MiB;
constexpr size_t WS_PE = 208 * MiB;
constexpr size_t WS_Z = 336 * MiB;
constexpr size_t WS_Y = 656 * MiB;
constexpr size_t WS_O = 784 * MiB;
constexpr size_t WS_END = 912 * MiB;

constexpr int LDS_BYTES = 147456;
constexpr int IMG0 = 0, IMG1 = 32768, IMG2 = 65536, IMG3 = 98304, MISC = 131072;
constexpr int MISC_STAT = MISC, MISC_PART = MISC + 1024, MISC_CPART = MISC + 5120;

#define LAS __attribute__((address_space(3)))
typedef unsigned short bf16;
typedef unsigned char uchar;
typedef float f32x4 __attribute__((ext_vector_type(4)));
typedef float f32x2 __attribute__((ext_vector_type(2)));
typedef unsigned u32x4 __attribute__((ext_vector_type(4)));
typedef unsigned u32x2 __attribute__((ext_vector_type(2)));
typedef short bf16x8 __attribute__((ext_vector_type(8)));

__device__ __forceinline__ unsigned f2bf(float f) { unsigned u = __builtin_bit_cast(unsigned, f); return (u + 0x7fffu + ((u >> 16) & 1u)) >> 16; }
__device__ __forceinline__ unsigned pk2(float lo, float hi) { unsigned r; asm("v_cvt_pk_bf16_f32 %0, %1, %2" : "=v"(r) : "v"(lo), "v"(hi)); return r; }
__device__ __forceinline__ float bflo(unsigned w) { return __uint_as_float(w << 16); }
__device__ __forceinline__ float bfhi(unsigned w) { return __uint_as_float(w & 0xffff0000u); }
__device__ __forceinline__ float wave_sum(float v) {
#pragma unroll
    for (int o = 1; o < 64; o <<= 1) v += __shfl_xor(v, o);
    return v;
}
__device__ __forceinline__ float sigmoidf_(float x) { return __builtin_amdgcn_rcpf(1.0f + __expf(-x)); }

struct Args { const float* in[21]; float* out; unsigned char* ws; int ph_lo, ph_hi; };
typedef const __attribute__((address_space(4))) Args* ArgP;
struct Frame {
    LAS uchar* lds;
    int tid, lane, wave, G, bid;
    int wv;
    ArgP ap;
};
#define PHASE_BEGIN(F) do { int w_ = (F).wv; unsigned z_ = 0u; ArgP a_ = (ArgP)__builtin_amdgcn_kernarg_segment_ptr(); asm volatile("" : "+s"(w_), "+s"(a_), "+s"(z_)); \
    const int l_ = (int)__builtin_amdgcn_mbcnt_hi(~0u, __builtin_amdgcn_mbcnt_lo(~0u, z_));     \
    (F).lane = l_; (F).wave = w_; (F).tid = w_ * 64 + l_; (F).ap = a_; } while (0)

__device__ __forceinline__ void p0_transpose_item(const float* W, int K, int N, bf16* WT, LAS float* scr, int item, int lane, const float* ks0, const float* ks1, int ksplit) {
    const int nblk = N / 32, kb = item / nblk, nb = item % nblk, k0 = 64 * kb, n0 = 32 * nb;
#pragma unroll 8
    for (int i = 0; i < 32; ++i) { const int kk = 2 * i + (lane >> 5); float v = W[(size_t)(k0 + kk) * N + n0 + (lane & 31)];
        if (ks0) { const int k = k0 + kk; v *= (k < ksplit) ? ks0[k] : ks1[k - ksplit]; }
        scr[kk * 33 + (lane & 31)] = v; }
    asm volatile("s_waitcnt lgkmcnt(0)" ::: "memory");
    const int c = lane & 7;
#pragma unroll
    for (int j = 0; j < 4; ++j) { const int n = (lane >> 3) + 8 * j; const LAS float* s = scr + (8 * c) * 33 + n;
        u32x4 o; o.x = pk2(s[0 * 33], s[1 * 33]); o.y = pk2(s[2 * 33], s[3 * 33]); o.z = pk2(s[4 * 33], s[5 * 33]); o.w = pk2(s[6 * 33], s[7 * 33]);
        *(u32x4*)(WT + (size_t)(n0 + n) * K + k0 + 8 * c) = o; }
    asm volatile("s_waitcnt lgkmcnt(0)" ::: "memory");
}

__device__ __forceinline__ void p0_prologue(Frame& F) {
    LAS float* scr = (LAS float*)(F.lds + F.wave * 16384);
    const int gw = F.bid * NWAVES + F.wave, NGW = F.G * NWAVES;
    const float* w_in = F.ap->in[3]; const float* w_out = F.ap->in[17]; const float* w_pe = F.ap->in[19]; const float* w_pg = F.ap->in[20];
    const float* w_a = F.ap->in[10]; const float* w_x = F.ap->in[12];
    bf16* WIN = (bf16*)(((uchar*)F.ap->ws) + WS_WIN); bf16* WOUT = (bf16*)(((uchar*)F.ap->ws) + WS_WOUT); bf16* WPG = (bf16*)(((uchar*)F.ap->ws) + WS_WPG); bf16* WPE = (bf16*)(((uchar*)F.ap->ws) + WS_WPE);
    bf16* WA = (bf16*)(((uchar*)F.ap->ws) + WS_WA); bf16* WX = (bf16*)(((uchar*)F.ap->ws) + WS_WX); bf16* WSM = (bf16*)(((uchar*)F.ap->ws) + WS_WSM);
    constexpr int I_IN = (DM / 64) * (NZ / 32), I_OUT = (DM / 64) * (DM / 32), I_PG = I_OUT, I_PE = (DP / 64) * (DM / 32), I_SM = 16 * 8;
    constexpr int NITEMS = I_IN + I_OUT + I_PG + I_PE + I_SM;
    for (int it = gw; it < NITEMS; it += NGW) {
        int r = it;
        if (r < I_IN) { p0_transpose_item(w_in, DM, NZ, WIN, scr, r, F.lane, nullptr, nullptr, 0); continue; } r -= I_IN;
        if (r < I_OUT) { p0_transpose_item(w_out, DM, DM, WOUT, scr, r, F.lane, F.ap->in[15], F.ap->in[16], DG); continue; } r -= I_OUT;
        if (r < I_PG) { p0_transpose_item(w_pg, DM, DM, WPG, scr, r, F.lane, nullptr, nullptr, 0); continue; } r -= I_PG;
        if (r < I_PE) { p0_transpose_item(w_pe, DP, DM, WPE, scr, r, F.lane, nullptr, nullptr, 0); continue; } r -= I_PE;
        { const int mat = r >> 3, sub = r & 7;
          const float* src = (mat < 8 ? w_a : w_x) + (size_t)(mat & 7) * 16384; bf16* dst = (mat < 8 ? WA : WX) + (size_t)(mat & 7) * 16384;
          p0_transpose_item(src, 128, 128, dst, scr, sub, F.lane, nullptr, nullptr, 0); }
    }
    { const float* ws_ = F.ap->in[6]; const int gt = F.bid * NTHR + F.tid, NGT = F.G * NTHR;
      for (int i = gt; i < NH * CHK * CHK / 2; i += NGT) { const int e = 2 * i, s = e & 127, t = (e >> 7) & 127; const f32x2 v = *(const f32x2*)(ws_ + e);
          ((unsigned*)WSM)[i] = pk2(s <= t ? v.x : 0.f, (s + 1) <= t ? v.y : 0.f); } }
    { const float* x = F.ap->in[0]; const float* pg = F.ap->in[2]; bf16* A1 = (bf16*)(((uchar*)F.ap->ws) + WS_A1);
      for (int m = gw; m < M; m += NGW) {
          const f32x4* xr = (const f32x4*)(x + (size_t)m * DM) + F.lane; f32x4 v[8]; float ss = 0.f;
#pragma unroll
          for (int j = 0; j < 8; ++j) { v[j] = xr[64 * j]; ss += (v[j].x * v[j].x + v[j].y * v[j].y) + (v[j].z * v[j].z + v[j].w * v[j].w); }
          const float rstd = 1.0f / sqrtf(wave_sum(ss) * (1.0f / DM) + EPS);
          u32x2* o8 = (u32x2*)(A1 + (size_t)m * DM) + F.lane;
#pragma unroll
          for (int j = 0; j < 8; ++j) { const f32x4 g = ((const f32x4*)pg)[F.lane + 64 * j];
              u32x2 o; o.x = pk2(v[j].x * rstd * g.x, v[j].y * rstd * g.y); o.y = pk2(v[j].z * rstd * g.z, v[j].w * rstd * g.w); o8[64 * j] = o; }
      } }
    { const float* p = F.ap->in[1]; bf16* PB = (bf16*)(((uchar*)F.ap->ws) + WS_PBF); const size_t gt = (size_t)F.bid * NTHR + F.tid, NGT = (size_t)F.G * NTHR;
      for (size_t i = gt; i < (size_t)M * DP / 8; i += NGT) { const f32x4 a = ((const f32x4*)p)[2 * i], b = ((const f32x4*)p)[2 * i + 1];
          u32x4 o; o.x = pk2(a.x, a.y); o.y = pk2(a.z, a.w); o.z = pk2(b.x, b.y); o.w = pk2(b.z, b.w); ((u32x4*)PB)[i] = o; } }
}

__device__ __forceinline__ int sw16(int row) { return (row ^ (row >> 3)) & 15; }
__device__ __forceinline__ int img_off(int row, int chunk) { return row * 256 + ((chunk ^ sw16(row)) << 4); }
__device__ __forceinline__ void load_img(LAS uchar* img, const bf16* src, int tid) {
#pragma unroll
    for (int i = 0; i < 4; ++i) { const int q = tid + NTHR * i, row = q >> 4, ch = q & 15; const u32x4 v = *(const u32x4*)(src + row * 128 + ch * 8); *(LAS u32x4*)(img + img_off(row, ch)) = v; }
}
#define DPP_F(oldv, srcv, ctrl) __builtin_bit_cast(float, __builtin_amdgcn_update_dpp(__builtin_bit_cast(int, (float)(oldv)), __builtin_bit_cast(int, (float)(srcv)), (ctrl), 0xf, 0xf, false))
constexpr int CW_FLAG = 4096;
constexpr int CW_TMO2 = 6400;
constexpr int CTL_WORDS = 8192;

struct GmlpPref { u32x4 gv[4], uu[4], gg[4]; f32x4 st[8]; };
__device__ __forceinline__ void gmlp_prefetch(Frame& F, int tid, int c, int h, GmlpPref& R) {
    const int tg4 = tid >> 4, cg = tid & 15, t0 = c * CHK;
    const bf16* Z = (const bf16*)((uchar*)F.ap->ws + WS_Z);
#pragma unroll
    for (int j = 0; j < 4; ++j) { const bf16* zr = Z + (size_t)(t0 + 4 * tg4 + j) * NZ + 128 * h + 8 * cg;
        R.uu[j] = *(const u32x4*)zr; R.gv[j] = *(const u32x4*)(zr + DG); R.gg[j] = *(const u32x4*)(zr + 2 * DG); }
    if (tid < 128) { const f32x4* vp = (const f32x4*)((uchar*)F.ap->ws + WS_VST) + (size_t)(t0 + tid) * 8;
#pragma unroll
        for (int k = 0; k < 8; ++k) R.st[k] = vp[k]; }
}
__device__ __forceinline__ void gmlp_phase(Frame& F) {
    const int tid0 = F.tid, w = F.wave;
    bf16* Y = (bf16*)((uchar*)F.ap->ws + WS_Y); float* SSA = (float*)((uchar*)F.ap->ws + WS_SSA);
    LAS f32x2* stat = (LAS f32x2*)(F.lds + MISC_STAT); LAS float* part = (LAS float*)(F.lds + MISC_PART);
    int cur = -1; float gsc[8], bsc[8], bsv[8];
    GmlpPref R;
    int u = F.bid;
    if (u < 2048) gmlp_prefetch(F, tid0, u >> 3, u & 7, R);
    for (; u < 2048; u += F.G) { const int h = u & 7, c = u >> 3, t0 = c * CHK;
        int tid = tid0; asm volatile("" : "+v"(tid));
        const int lane = tid & 63, fr = lane & 15, fq = lane >> 4, tg4 = tid >> 4, cg = tid & 15;
        if (h != cur) {
            __syncthreads(); load_img(F.lds + IMG1, (const bf16*)((uchar*)F.ap->ws + WS_WSM) + (size_t)h * 16384, tid); cur = h;
            const float* lg = F.ap->in[4] + 128 * h + 8 * cg; const float* lb = F.ap->in[5] + 128 * h + 8 * cg;
            const f32x4 g0 = *(const f32x4*)lg, g1 = *(const f32x4*)(lg + 4), b0 = *(const f32x4*)lb, b1 = *(const f32x4*)(lb + 4);
            gsc[0] = g0.x; gsc[1] = g0.y; gsc[2] = g0.z; gsc[3] = g0.w; gsc[4] = g1.x; gsc[5] = g1.y; gsc[6] = g1.z; gsc[7] = g1.w;
            bsc[0] = b0.x; bsc[1] = b0.y; bsc[2] = b0.z; bsc[3] = b0.w; bsc[4] = b1.x; bsc[5] = b1.y; bsc[6] = b1.z; bsc[7] = b1.w;
            const float* bs = F.ap->in[7] + h * CHK;
#pragma unroll
            for (int T = 0; T < 8; ++T) bsv[T] = bs[16 * T + fr];
        }
        if (tid < 128) { float s = 0.f, q = 0.f;
#pragma unroll
            for (int k = 0; k < 8; ++k) { s += R.st[k].x + R.st[k].z; q += R.st[k].y + R.st[k].w; }
            const float mean = s * (1.0f / DG); float var = q * (1.0f / DG) - mean * mean; var = var > 0.f ? var : 0.f;
            stat[tid] = (f32x2){mean, 1.0f / sqrtf(var + EPS)}; }
        __syncthreads();
        {
            float nv[4][8];
#pragma unroll
            for (int j = 0; j < 4; ++j) { const f32x2 st = stat[4 * tg4 + j]; const unsigned wv[4] = {R.gv[j].x, R.gv[j].y, R.gv[j].z, R.gv[j].w};
#pragma unroll
                for (int k = 0; k < 4; ++k) { nv[j][2 * k] = (bflo(wv[k]) - st.x) * st.y * gsc[2 * k] + bsc[2 * k]; nv[j][2 * k + 1] = (bfhi(wv[k]) - st.x) * st.y * gsc[2 * k + 1] + bsc[2 * k + 1]; } }
#pragma unroll
            for (int cc = 0; cc < 8; ++cc) { const int d = 8 * cg + cc; u32x2 o; o.x = pk2(nv[0][cc], nv[1][cc]); o.y = pk2(nv[2][cc], nv[3][cc]);
                *(LAS u32x2*)(F.lds + IMG0 + d * 256 + (((tg4 >> 1) ^ sw16(d)) << 4) + (tg4 & 1) * 8) = o; }
#pragma unroll
            for (int j = 0; j < 4; ++j) { *(LAS u32x4*)(F.lds + IMG2 + img_off(4 * tg4 + j, cg)) = R.uu[j]; *(LAS u32x4*)(F.lds + IMG3 + img_off(4 * tg4 + j, cg)) = R.gg[j]; }
        }
        __syncthreads();
        { const int un = u + F.G; if (un < 2048) gmlp_prefetch(F, tid, un >> 3, un & 7, R); }
        f32x4 acc[8];
#pragma unroll
        for (int T = 0; T < 8; ++T) acc[T] = (f32x4){0.f, 0.f, 0.f, 0.f};
        bf16x8 af[4];
#pragma unroll
        for (int kk = 0; kk < 4; ++kk) af[kk] = *(const LAS bf16x8*)(F.lds + IMG0 + img_off(16 * w + fr, 4 * kk + fq));
#pragma unroll
        for (int T = 0; T < 8; T += 2) {
#pragma unroll
            for (int TT = T; TT < T + 2; ++TT)
#pragma unroll
                for (int kk = 0; kk <= (TT >> 1); ++kk) { const bf16x8 bfr = *(const LAS bf16x8*)(F.lds + IMG1 + img_off(16 * TT + fr, 4 * kk + fq));
                    acc[TT] = __builtin_amdgcn_mfma_f32_16x16x32_bf16(af[kk], bfr, acc[TT], 0, 0, 0); }
            __builtin_amdgcn_sched_barrier(0); }
#pragma unroll
        for (int T = 0; T < 8; ++T) { const int t = 16 * T + fr;
            const int o = img_off(t, 2 * w + (fq >> 1)) + (fq & 1) * 8;
            const u32x2 uw = *(const LAS u32x2*)(F.lds + IMG2 + o), gw = *(const LAS u32x2*)(F.lds + IMG3 + o);
            const float y0 = bflo(uw.x) * (acc[T][0] + bsv[T]) * bflo(gw.x), y1 = bfhi(uw.x) * (acc[T][1] + bsv[T]) * bfhi(gw.x);
            const float y2 = bflo(uw.y) * (acc[T][2] + bsv[T]) * bflo(gw.y), y3 = bfhi(uw.y) * (acc[T][3] + bsv[T]) * bfhi(gw.y);
            float q = (y0 * y0 + y1 * y1) + (y2 * y2 + y3 * y3);
            u32x2 ow; ow.x = pk2(y0, y1); ow.y = pk2(y2, y3);
            *(u32x2*)(Y + (size_t)(t0 + t) * DM + 128 * h + 16 * w + 4 * fq) = ow;
            q += __shfl_xor(q, 16); q += __shfl_xor(q, 32);
            if (fq == 0) part[w * 128 + t] = q; }
        __syncthreads();
        if (tid < 128) { float s = 0.f;
#pragma unroll
            for (int k = 0; k < 8; ++k) s += part[k * 128 + tid];
            SSA[(size_t)(t0 + tid) * 8 + h] = s; }
    }
    __syncthreads();
}

struct LruPref { u32x4 xb[7], gg[4]; };
constexpr int MISC_CW = MISC + 9728;
__device__ __forceinline__ void lru_prefetch(Frame& F, int tid, int c, int h, LruPref& R) {
    const int tg4 = tid >> 4, cg = tid & 15, t0 = c * CHK, tseq0 = t0 & (SEQ - 1);
    const bf16* Z = (const bf16*)((uchar*)F.ap->ws + WS_Z);
#pragma unroll
    for (int k = 0; k < 7; ++k) { const int trel = 4 * tg4 - 3 + k;
        if (tseq0 + trel >= 0) R.xb[k] = *(const u32x4*)(Z + (size_t)(t0 + trel) * NZ + 3 * DG + 128 * h + 8 * cg); else R.xb[k] = (u32x4){0u, 0u, 0u, 0u}; }
#pragma unroll
    for (int j = 0; j < 4; ++j) R.gg[j] = *(const u32x4*)(Z + (size_t)(t0 + 4 * tg4 + j) * NZ + 4 * DG + 128 * h + 8 * cg);
}
__device__ __forceinline__ void lru_phase(Frame& F) {
    const int tid0 = F.tid, w = F.wave;
    bf16* Y = (bf16*)((uchar*)F.ap->ws + WS_Y); float* SSB = (float*)((uchar*)F.ap->ws + WS_SSB);
    unsigned long long* AGG = (unsigned long long*)((uchar*)F.ap->ws + WS_AGG);
    unsigned* ctl = (unsigned*)F.ap->ws;
    LAS float* part = (LAS float*)(F.lds + MISC_PART); LAS f32x2* cpart = (LAS f32x2*)(F.lds + MISC_CPART);
    int cur = -1;
    LruPref R;
    int u = F.bid;
    if (u < 2048) lru_prefetch(F, tid0, u >> 3, u & 7, R);
    for (; u < 2048; u += F.G) { const int h = u & 7, c = u >> 3, t0 = c * CHK, tseq0 = t0 & (SEQ - 1);
        int tid = tid0; asm volatile("" : "+v"(tid));
        const int lane = tid & 63, fr = lane & 15, fq = lane >> 4, tg4 = tid >> 4, cg = tid & 15;
        const int chl = 16 * w + 4 * fq;
        if (h != cur) {
            __syncthreads(); load_img(F.lds + IMG1, (const bf16*)((uchar*)F.ap->ws + WS_WA) + (size_t)h * 16384, tid); load_img(F.lds + IMG2, (const bf16*)((uchar*)F.ap->ws + WS_WX) + (size_t)h * 16384, tid); cur = h;
            for (int i = tid; i < 640; i += NTHR) { const int k = i >> 7, chn = i & 127; ((LAS float*)(F.lds + MISC_CW))[i] = (k < 4) ? F.ap->in[8][k * DL + 128 * h + chn] : F.ap->in[9][128 * h + chn]; }
            __syncthreads(); }
        const f32x4 pba = *(const f32x4*)(F.ap->in[11] + 128 * h + chl), pbx = *(const f32x4*)(F.ap->in[13] + 128 * h + chl), plm = *(const f32x4*)(F.ap->in[14] + 128 * h + chl);
        {
            float xc[4][8], wk[4][8], cbv[8];
            { const LAS f32x4* cwt = (const LAS f32x4*)(F.lds + MISC_CW) + 2 * cg;
#pragma unroll
              for (int k = 0; k < 4; ++k) { const f32x4 a = cwt[k * 32], b = cwt[k * 32 + 1]; wk[k][0] = a.x; wk[k][1] = a.y; wk[k][2] = a.z; wk[k][3] = a.w; wk[k][4] = b.x; wk[k][5] = b.y; wk[k][6] = b.z; wk[k][7] = b.w; }
              const f32x4 a = cwt[4 * 32], b = cwt[4 * 32 + 1]; cbv[0] = a.x; cbv[1] = a.y; cbv[2] = a.z; cbv[3] = a.w; cbv[4] = b.x; cbv[5] = b.y; cbv[6] = b.z; cbv[7] = b.w; }
#pragma unroll
            for (int j = 0; j < 4; ++j)
#pragma unroll
                for (int e = 0; e < 8; ++e) xc[j][e] = cbv[e];
#pragma unroll
            for (int k = 0; k < 7; ++k) { const unsigned wv[4] = {R.xb[k].x, R.xb[k].y, R.xb[k].z, R.xb[k].w};
#pragma unroll
                for (int e2 = 0; e2 < 4; ++e2) { const float lo_ = bflo(wv[e2]), hi_ = bfhi(wv[e2]);
#pragma unroll
                    for (int j = 0; j < 4; ++j) { const int kw = k - j; if (kw >= 0 && kw < 4) { xc[j][2 * e2] += wk[kw][2 * e2] * lo_; xc[j][2 * e2 + 1] += wk[kw][2 * e2 + 1] * hi_; } } } }
#pragma unroll
            for (int j = 0; j < 4; ++j) { u32x4 o; o.x = pk2(xc[j][0], xc[j][1]); o.y = pk2(xc[j][2], xc[j][3]); o.z = pk2(xc[j][4], xc[j][5]); o.w = pk2(xc[j][6], xc[j][7]);
                *(LAS u32x4*)(F.lds + IMG0 + img_off(4 * tg4 + j, cg)) = o;
                *(LAS u32x4*)(F.lds + IMG3 + img_off(4 * tg4 + j, cg)) = R.gg[j]; }
        }
        __syncthreads();
        f32x4 accA[8], accX[8];
#pragma unroll
        for (int T = 0; T < 8; ++T) { accA[T] = (f32x4){0.f, 0.f, 0.f, 0.f}; accX[T] = (f32x4){0.f, 0.f, 0.f, 0.f}; }
        {
            bf16x8 afa[4], afx[4], b0[4], b1[4];
#pragma unroll
            for (int kk = 0; kk < 4; ++kk) { afa[kk] = *(const LAS bf16x8*)(F.lds + IMG1 + img_off(16 * w + fr, 4 * kk + fq)); afx[kk] = *(const LAS bf16x8*)(F.lds + IMG2 + img_off(16 * w + fr, 4 * kk + fq)); }
#define LRU_LDB(dst, T) do { _Pragma("unroll") for (int kk = 0; kk < 4; ++kk) dst[kk] = *(const LAS bf16x8*)(F.lds + IMG0 + img_off(16 * (T) + fr, 4 * kk + fq)); } while (0)
#define LRU_MMA(src, T) do { _Pragma("unroll") for (int kk = 0; kk < 4; ++kk) { accA[T] = __builtin_amdgcn_mfma_f32_16x16x32_bf16(afa[kk], src[kk], accA[T], 0, 0, 0); \
                accX[T] = __builtin_amdgcn_mfma_f32_16x16x32_bf16(afx[kk], src[kk], accX[T], 0, 0, 0); } } while (0)
            LRU_LDB(b0, 0);
#pragma unroll
            for (int T = 0; T < 8; T += 2) {
                LRU_LDB(b1, T + 1); __builtin_amdgcn_sched_barrier(0); LRU_MMA(b0, T); __builtin_amdgcn_sched_barrier(0);
                if (T + 2 < 8) LRU_LDB(b0, T + 2);
                __builtin_amdgcn_sched_barrier(0); LRU_MMA(b1, T + 1); __builtin_amdgcn_sched_barrier(0); }
#undef LRU_LDB
#undef LRU_MMA
        }
        float P[4], Q[4], ba[4], bx[4], sp[4];
        { const float av[4] = {pba.x, pba.y, pba.z, pba.w}, bv[4] = {pbx.x, pbx.y, pbx.z, pbx.w}, lmv[4] = {plm.x, plm.y, plm.z, plm.w};
#pragma unroll
          for (int r = 0; r < 4; ++r) { const float xx = -lmv[r]; const float spl = (xx > 0.f ? xx : 0.f) + log1pf(__expf(-fabsf(xx)));
              sp[r] = -8.0f * 1.44269504f * spl; ba[r] = av[r] * -1.44269504f; bx[r] = bv[r] * -1.44269504f; P[r] = 1.f; Q[r] = 0.f; } }
#pragma unroll
        for (int T = 0; T < 8; ++T) { const int t = 16 * T + fr; const bool first = (tseq0 + t) == 0;
            const u32x2 xw = *(const LAS u32x2*)(F.lds + IMG0 + img_off(t, 2 * w + (fq >> 1)) + (fq & 1) * 8);
            const float xcv[4] = {bflo(xw.x), bfhi(xw.x), bflo(xw.y), bfhi(xw.y)};
#pragma unroll
            for (int r = 0; r < 4; ++r) {
                const float rg = __builtin_amdgcn_rcpf(1.0f + __builtin_amdgcn_exp2f(__builtin_fmaf(accA[T][r], -1.44269504f, ba[r])));
                const float ig = __builtin_amdgcn_rcpf(1.0f + __builtin_amdgcn_exp2f(__builtin_fmaf(accX[T][r], -1.44269504f, bx[r])));
                const float a = __builtin_amdgcn_exp2f(sp[r] * rg);
                const float m2 = __builtin_fmaf(-a, a, 1.0f);
                const float mult = first ? 1.0f : __builtin_amdgcn_sqrtf(m2);
                float A = a, B = mult * (ig * xcv[r]);
                { float Aq, Bq;
                  Aq = DPP_F(1.0f, A, 0x111); Bq = DPP_F(0.0f, B, 0x111); B = A * Bq + B; A = A * Aq;
                  Aq = DPP_F(1.0f, A, 0x112); Bq = DPP_F(0.0f, B, 0x112); B = A * Bq + B; A = A * Aq;
                  Aq = DPP_F(1.0f, A, 0x114); Bq = DPP_F(0.0f, B, 0x114); B = A * Bq + B; A = A * Aq;
                  Aq = DPP_F(1.0f, A, 0x118); Bq = DPP_F(0.0f, B, 0x118); B = A * Bq + B; A = A * Aq; }
                const float At = DPP_F(0.0f, A, 0x15F), Bt = DPP_F(0.0f, B, 0x15F);
                accA[T][r] = A * P[r]; accX[T][r] = A * Q[r] + B;
                Q[r] = At * Q[r] + Bt; P[r] = At * P[r];
            }
            if (T & 1) __builtin_amdgcn_sched_barrier(0);
        }
        if (fr == 0) {
#pragma unroll
            for (int r = 0; r < 4; ++r) __hip_atomic_store(AGG + (size_t)c * DL + 128 * h + chl + r, ((unsigned long long)__float_as_uint(Q[r]) << 32) | __float_as_uint(P[r]), __ATOMIC_RELAXED, __HIP_MEMORY_SCOPE_AGENT); }
        asm volatile("s_waitcnt vmcnt(0)" ::: "memory");
        __syncthreads();
        if (tid == 0) __hip_atomic_store(ctl + CW_FLAG + c * 8 + h, 1u, __ATOMIC_RELAXED, __HIP_MEMORY_SCOPE_AGENT);
        const int cs = c & 63, cb0 = c - cs;
        if (w == 0) {
            if (cs > 0) { unsigned spins = 0;
                for (;;) { const unsigned f = (lane < cs) ? __hip_atomic_load(ctl + CW_FLAG + (cb0 + lane) * 8 + h, __ATOMIC_RELAXED, __HIP_MEMORY_SCOPE_AGENT) : 1u;
                    if (__all(f != 0u)) break;
                    __builtin_amdgcn_s_sleep(2);
                    if (++spins > (1u << 20)) { if (lane == 0) __hip_atomic_store(ctl + CW_TMO2, 1u, __ATOMIC_RELAXED, __HIP_MEMORY_SCOPE_AGENT); break; } } }
            __builtin_amdgcn_fence(__ATOMIC_ACQUIRE, "agent");
            asm volatile("s_waitcnt vmcnt(0)" ::: "memory");
        }
        __syncthreads();
        {
            const int ch = tid & 127, pt = tid >> 7; const int lo = 16 * pt, hi = (16 * pt + 16 < cs) ? 16 * pt + 16 : cs;
            float A = 1.f, B = 0.f;
#pragma unroll
            for (int half = 0; half < 2; ++half) { unsigned long long ab[8];
#pragma unroll
                for (int i = 0; i < 8; ++i) { ab[i] = 0x3f800000ull; if (lo + 8 * half + i < hi) ab[i] = AGG[(size_t)(cb0 + lo + 8 * half + i) * DL + 128 * h + ch]; }
#pragma unroll
                for (int i = 0; i < 8; ++i) { const float ax = __uint_as_float((unsigned)ab[i]), bxv = __uint_as_float((unsigned)(ab[i] >> 32)); B = ax * B + bxv; A = ax * A; } }
            cpart[pt * 128 + ch] = (f32x2){A, B};
        }
        { const int un = u + F.G; if (un < 2048) lru_prefetch(F, tid, un >> 3, un & 7, R); }
        __syncthreads();
        float H[4];
#pragma unroll
        for (int r = 0; r < 4; ++r) { float hh = 0.f;
#pragma unroll
            for (int p = 0; p < 4; ++p) { const f32x2 ab = cpart[p * 128 + chl + r]; hh = ab.x * hh + ab.y; }
            H[r] = hh; }
#pragma unroll
        for (int T = 0; T < 8; ++T) { const int t = 16 * T + fr;
            const u32x2 gw = *(const LAS u32x2*)(F.lds + IMG3 + img_off(t, 2 * w + (fq >> 1)) + (fq & 1) * 8);
            const float y0 = (accA[T][0] * H[0] + accX[T][0]) * bflo(gw.x), y1 = (accA[T][1] * H[1] + accX[T][1]) * bfhi(gw.x);
            const float y2 = (accA[T][2] * H[2] + accX[T][2]) * bflo(gw.y), y3 = (accA[T][3] * H[3] + accX[T][3]) * bfhi(gw.y);
            float q = (y0 * y0 + y1 * y1) + (y2 * y2 + y3 * y3);
            u32x2 ow; ow.x = pk2(y0, y1); ow.y = pk2(y2, y3);
            *(u32x2*)(Y + (size_t)(t0 + t) * DM + DG + 128 * h + chl) = ow;
            q += __shfl_xor(q, 16); q += __shfl_xor(q, 32);
            if (fq == 0) part[w * 128 + t] = q; }
        __syncthreads();
        if (tid < 128) { float s = 0.f;
#pragma unroll
            for (int k = 0; k < 8; ++k) s += part[k * 128 + tid];
            SSB[(size_t)(t0 + tid) * 8 + h] = s; }
    }
    __syncthreads();
}

#define XB_TMO      128
#define XB_XCNT(j)  (256  + 64 * (j))
#define XB_XSUB(j)  (1280 + 64 * (j))
#define XB_XGEN(j)  (2304 + 64 * (j))
#define XB_TOP      3328
#define XB_TOPGEN   3392
#define XCD_BAR_WORDS 3456
#define XB_SPIN_CAP (1u << 18)
constexpr int LDS_BARST = MISC + 15 * 1024;
__device__ __forceinline__ unsigned xb_ld(unsigned* p)              { return __hip_atomic_load(p, __ATOMIC_RELAXED, __HIP_MEMORY_SCOPE_AGENT); }
__device__ __forceinline__ unsigned xb_add(unsigned* p, unsigned v) { return __hip_atomic_fetch_add(p, v, __ATOMIC_RELAXED, __HIP_MEMORY_SCOPE_AGENT); }
__device__ __forceinline__ unsigned xb_xcc_id() { return (unsigned)__builtin_amdgcn_s_getreg((3 << 11) | 20) & 0xFu; }
#define XB_SPIN(cond, bar) do { unsigned _sp = 0; while (cond) { __builtin_amdgcn_s_sleep(1); \
    if ((++_sp & 255u) == 0u) { if (xb_ld(&(bar)[XB_TMO])) break; if (_sp > XB_SPIN_CAP) { atomicAdd(&(bar)[XB_TMO], 1u); break; } } } } while (0)
__device__ __forceinline__ void xcd_barrier_complete(unsigned* bar, unsigned x, unsigned& nloc, unsigned& nx) {
    const unsigned G = gridDim.x;
    unsigned sum, cnt, mine, sp = 0u;
    for (;;) {
        sum = 0u; cnt = 0u; mine = 0u;
#pragma unroll
        for (unsigned j = 0; j < 16; ++j) { const unsigned c = xb_ld(&bar[XB_XCNT(j)]); sum += c; cnt += (c > 0u) ? 1u : 0u; mine = (j == x) ? c : mine; }
        if (sum == G) break;
        __builtin_amdgcn_s_sleep(1);
        if ((++sp & 255u) == 0u) { if (xb_ld(&bar[XB_TMO])) break; if (sp > XB_SPIN_CAP) { atomicAdd(&bar[XB_TMO], 1u); break; } }
    }
    nloc = mine > 0u ? mine : 1u; nx = cnt > 0u ? cnt : 1u;
}
__device__ __forceinline__ void xcd_barrier(unsigned* bar, volatile LAS unsigned* st, int tid) {
    asm volatile("s_waitcnt vmcnt(0)" ::: "memory");
    __syncthreads();
    if (tid == 0) {
        const unsigned x = xb_xcc_id();
        __builtin_amdgcn_s_waitcnt(0);
        unsigned nloc = st[0], nx = st[1];
        if (nloc == 0u) { xcd_barrier_complete(bar, x, nloc, nx); st[0] = nloc; st[1] = nx; }
        const unsigned old = xb_add(&bar[XB_XSUB(x)], 1u);
        const unsigned gen = old / nloc;
        if (old + 1u == (gen + 1u) * nloc) {
            __builtin_amdgcn_fence(__ATOMIC_RELEASE, "agent");
            asm volatile("s_waitcnt vmcnt(0)" ::: "memory");
            const unsigned og = xb_add(&bar[XB_TOP], 1u);
            const unsigned tg = og / nx;
            if (og + 1u == (tg + 1u) * nx) xb_add(&bar[XB_TOPGEN], 1u);
            else XB_SPIN(xb_ld(&bar[XB_TOPGEN]) == tg, bar);
            __builtin_amdgcn_fence(__ATOMIC_ACQUIRE, "agent");
            xb_add(&bar[XB_XGEN(x)], 1u);
            asm volatile("s_waitcnt vmcnt(0)" ::: "memory");
        } else {
            XB_SPIN(xb_ld(&bar[XB_XGEN(x)]) == gen, bar);
            __builtin_amdgcn_fence(__ATOMIC_ACQUIRE, "agent");
            asm volatile("s_waitcnt vmcnt(0)" ::: "memory");
        }
    }
    __syncthreads();
}

__global__ void __launch_bounds__(NTHR, 2) mk_fwd(Args args_unused) {
    extern __shared__ __attribute__((aligned(16))) unsigned char lds_raw[];
    Frame F;
    F.lds = (LAS uchar*)lds_raw; F.G = gridDim.x; F.bid = blockIdx.x; F.wv = __builtin_amdgcn_readfirstlane((int)threadIdx.x >> 6);
    PHASE_BEGIN(F);
    const int lo = F.ap->ph_lo, hi = F.ap->ph_hi;
#define IN(k) (lo <= (k) && (k) < hi)
#if MK_N_LAUNCHES == 1
#define SEAM(k) do { if (IN(k) && IN((k) + 1)) { PHASE_BEGIN(F); xcd_barrier((unsigned*)F.ap->ws, (volatile LAS unsigned*)(F.lds + LDS_BARST), F.tid); } } while (0)
#else
#define SEAM(k) do { } while (0)
#endif
#define WSB(off) ((bf16*)((uchar*)F.ap->ws + (off)))
#define WSF(off) ((float*)((uchar*)F.ap->ws + (off)))

    if (F.tid < 2) ((volatile LAS unsigned*)(F.lds + LDS_BARST))[F.tid] = 0u;
    if (IN(0)) {
#if MK_N_LAUNCHES == 1
        if (F.bid == 0) { unsigned* bw = (unsigned*)F.ap->ws; for (int i = F.tid; i < CTL_WORDS; i += NTHR) __hip_atomic_store(bw + i, 0u, __ATOMIC_RELAXED, __HIP_MEMORY_SCOPE_AGENT); }
#endif
        REPS(0) { p0_prologue(F); __syncthreads(); } }
#if MK_N_LAUNCHES == 1
    cg::this_grid().sync();
    PHASE_BEGIN(F);
    if (F.tid == 0) (void)xb_add((unsigned*)F.ap->ws + XB_XCNT(xb_xcc_id()), 1u);
#endif
    if (IN(1)) REPS(1) {
        PHASE_BEGIN(F);
        { pg8::Gemm g{WSB(WS_A1), WSB(WS_WIN), M, NZ, DM}; pg8::StaticOrder S; S.init(M, NZ, F.G, F.bid);
          pg8::EpiZ E{WSB(WS_Z), NZ, (pg8::f32x2*)WSF(WS_VST)};
          pg8::gemm_phase<pg8::EpiZ, pg8::StaticOrder, true, true>(F.lds, g, S, E, F.tid); }
        PHASE_BEGIN(F);
        { pg8::Gemm g{WSB(WS_PBF), WSB(WS_WPE), M, DM, DP}; pg8::StaticOrder S; S.init(M, DM, F.G, F.bid);
          pg8::EpiPlain E{WSB(WS_PE), DM};
          pg8::gemm_phase<pg8::EpiPlain, pg8::StaticOrder, true, true>(F.lds, g, S, E, F.tid); }
    }
    SEAM(1);
    if (IN(2)) {
        REPS(2) { PHASE_BEGIN(F); gmlp_phase(F); }
        REPS(4) { PHASE_BEGIN(F); lru_phase(F); }
    }
    SEAM(2);
    if (IN(5)) REPS(5) {
        PHASE_BEGIN(F);
        pg8::StaticOrder S; S.init(M, DM, F.G, F.bid);
        {
            const float* SSA = WSF(WS_SSA); const float* SSB = WSF(WS_SSB); LAS f32x2* rr = (LAS f32x2*)(F.lds + MISC);
            for (int i = 0; i < 4; ++i) { pg8::Unit u; if (!S.next(i, u)) break;
                if (F.tid < 256) { const size_t row = (size_t)u.pm * 256 + F.tid;
                    const f32x4 a0 = *(const f32x4*)(SSA + row * 8), a1 = *(const f32x4*)(SSA + row * 8 + 4), b0 = *(const f32x4*)(SSB + row * 8), b1 = *(const f32x4*)(SSB + row * 8 + 4);
                    const float ra = 1.0f / sqrtf(((a0.x + a0.y) + (a0.z + a0.w) + (a1.x + a1.y) + (a1.z + a1.w)) * (1.0f / DG) + EPS);
                    const float rb = 1.0f / sqrtf(((b0.x + b0.y) + (b0.z + b0.w) + (b1.x + b1.y) + (b1.z + b1.w)) * (1.0f / DL) + EPS);
                    rr[i * 256 + F.tid] = (f32x2){ra / rb, rb}; } }
            __syncthreads();
        }
        pg8::Gemm g{WSB(WS_Y), WSB(WS_WOUT), M, DM, DM};
        pg8::EpiO E{WSB(WS_O), DM, WSF(WS_SSO), (const LAS pg8::f32x2*)(F.lds + MISC), 0};
        pg8::gemm_phase<pg8::EpiO, pg8::StaticOrder, true, true>(F.lds, g, S, E, F.tid);
        __syncthreads();
    }
    SEAM(5);
    if (IN(6)) REPS(6) {
        PHASE_BEGIN(F);
        const float* SSO = WSF(WS_SSO); const float* x = F.ap->in[0]; const float* pg = F.ap->in[18]; const bf16* Ob = WSB(WS_O); bf16* H1 = WSB(WS_A1); float* RS = WSF(WS_RSTD);
        const int gw = F.bid * NWAVES + F.wave, NGW = F.G * NWAVES;
        for (int m = gw; m < M; m += NGW) {
            float s = (F.lane < 32) ? SSO[(size_t)m * 32 + F.lane] : 0.f; s = wave_sum(s);
            const float rstd = 1.0f / sqrtf(s * (1.0f / DM) + EPS);
            if (F.lane == 0) RS[m] = rstd;
            const f32x4* xr = (const f32x4*)(x + (size_t)m * DM) + F.lane; const u32x2* orow = (const u32x2*)(Ob + (size_t)m * DM) + F.lane;
            u32x2* hr = (u32x2*)(H1 + (size_t)m * DM) + F.lane;
#pragma unroll
            for (int j = 0; j < 8; ++j) { const f32x4 xv = xr[64 * j]; const u32x2 ov = orow[64 * j]; const f32x4 g = ((const f32x4*)pg)[F.lane + 64 * j];
                u32x2 hb; hb.x = pk2(xv.x + bflo(ov.x) * rstd * g.x, xv.y + bfhi(ov.x) * rstd * g.y); hb.y = pk2(xv.z + bflo(ov.y) * rstd * g.z, xv.w + bfhi(ov.y) * rstd * g.w); hr[64 * j] = hb; }
        }
    }
    SEAM(6);
    if (IN(7)) {
        PHASE_BEGIN(F);
        pg8::Gemm g{WSB(WS_A1), WSB(WS_WPG), M, DM, DM}; pg8::StaticOrder S; S.init(M, DM, F.G, F.bid);
        pg8::EpiOut E{(float*)F.ap->out, F.ap->in[0], WSB(WS_O), WSB(WS_PE), WSF(WS_RSTD), F.ap->in[18], DM};
        pg8::gemm_phase<pg8::EpiOut, pg8::StaticOrder, true, true>(F.lds, g, S, E, F.tid);
    }
#undef IN
#undef SEAM
}

extern "C" void kernel_launch(void* const* d_in, const int* in_sizes, int n_in, void* d_out, int out_size, void* d_ws, size_t ws_size, hipStream_t stream) {
    static int grid = 0;
    if (grid == 0) {
        if (n_in != 21 || in_sizes[0] != M * DM || out_size != M * DM || ws_size < WS_END) { fprintf(stderr, "kernel_launch: unexpected problem (n_in %d, in0 %d, out %d, ws %zu); nothing launched\n", n_in, n_in > 0 ? in_sizes[0] : -1, out_size, ws_size); grid = -1; return; }
        int dev = 0, cus = 0, per_cu = 0;
        if (hipGetDevice(&dev) != hipSuccess || hipDeviceGetAttribute(&cus, hipDeviceAttributeMultiprocessorCount, dev) != hipSuccess) { fprintf(stderr, "kernel_launch: device query failed\n"); grid = -1; return; }
        if (hipFuncSetAttribute((const void*)mk_fwd, hipFuncAttributeMaxDynamicSharedMemorySize, LDS_BYTES) != hipSuccess) { fprintf(stderr, "kernel_launch: hipFuncSetAttribute failed\n"); grid = -1; return; }
        if (hipOccupancyMaxActiveBlocksPerMultiprocessor(&per_cu, (const void*)mk_fwd, NTHR, LDS_BYTES) != hipSuccess || per_cu < 1) { fprintf(stderr, "kernel_launch: occupancy query says %d blocks per CU\n", per_cu); per_cu = 1; }
        (void)hipGetLastError();
        grid = cus;
    }
    if (grid < 0) return;
    Args a{};
    for (int i = 0; i < 21; ++i) a.in[i] = (const float*)d_in[i];
    a.out = (float*)d_out; a.ws = (unsigned char*)d_ws;
#if MK_N_LAUNCHES == 1
    a.ph_lo = 0; a.ph_hi = N_PHASES;
    void* kargs[] = {&a};
    hipError_t e = hipLaunchCooperativeKernel((const void*)mk_fwd, dim3(grid), dim3(NTHR), kargs, LDS_BYTES, stream);
    if (e != hipSuccess) fprintf(stderr, "kernel_launch: cooperative launch failed: %s (grid %d)\n", hipGetErrorString(e), grid);
#else
    for (int li = 0; li < N_PHASES; ++li) { a.ph_lo = li; a.ph_hi = li + 1;
        hipLaunchKernelGGL(mk_fwd, dim3(grid), dim3(NTHR), LDS_BYTES, stream, a);
        const hipError_t le = hipPeekAtLastError(); if (le != hipSuccess) { fprintf(stderr, "kernel_launch: launch %d failed: %s\n", li, hipGetErrorName(le)); break; } }
#endif
}
```

```cpp
#define MK_N_LAUNCHES 1
#include <hip/hip_runtime.h>
#include <hip/hip_cooperative_groups.h>
#include <cstdio>
#include <cstdint>
namespace cg = cooperative_groups;
namespace pg8 {
#define PG8_LAS __attribute__((address_space(3)))
typedef unsigned short bf16_t;
typedef short bf16x8 __attribute__((ext_vector_type(8)));
typedef float f32x4 __attribute__((ext_vector_type(4)));
typedef unsigned u32x4 __attribute__((ext_vector_type(4)));
constexpr int BM = 256, BK = 64, HALF = 128, HTB = HALF * BK * 2  , STAGE_BYTES = 8 * HTB, NXCD = 8, WGM = 8;

__host__ __device__ __forceinline__ int lds_byte(int r, int c) { const int st = (r >> 4) * 2 + (c >> 5), rr = r & 15, cc = c & 31, ob = rr * 64 + cc * 2; return st * 1024 + (ob ^ (((ob >> 9) & 1) << 5)); }
__host__ __device__ __forceinline__ void stage_rc(int b, int& R, int& C) { const int st = b / 1024, sb = b % 1024, swz = sb ^ (((sb >> 9) & 1) << 5); R = (st >> 1) * 16 + swz / 64; C = (st & 1) * 32 + (swz % 64) / 2; }
__host__ __device__ __forceinline__ int perm32(int rho) { const int n = rho >> 4, i = rho & 15; return 8 * (i >> 2) + 4 * n + (i & 3); }

struct Unit { int pm, pn; };
struct Gemm { const bf16_t* A; const bf16_t* Bt; int M, N, K; };

struct StaticOrder {
    int nM, nN, nwg, G, c;
    __host__ __device__ void init(int M, int N, int G_, int c_) { nM = M / BM; nN = N / BM; nwg = nM * nN; G = G_; c = c_; }
    __host__ __device__ bool next(int i, Unit& u) const {
        const long L = (long)i * G + c; if (L >= nwg) return false;
        int wgid = (int)L; { const int q = nwg / NXCD, r = nwg % NXCD, xcd = wgid % NXCD, off = wgid / NXCD; wgid = (xcd < r ? xcd * (q + 1) : r * (q + 1) + (xcd - r) * q) + off; }
        const int nig = WGM * nN, gid = wgid / nig, fm = gid * WGM, gsz = (nM - fm) < WGM ? (nM - fm) : WGM;
        u.pm = fm + ((wgid % nig) % gsz); u.pn = (wgid % nig) / gsz; return true;
    }
    __device__ __forceinline__ void a_ready(const Unit&) const {}
    __device__ __forceinline__ void done(const Unit&) const {}
};

__device__ __forceinline__ unsigned cvt_pk_bf16(float lo, float hi) { unsigned r; asm volatile("v_cvt_pk_bf16_f32 %0, %1, %2" : "=v"(r) : "v"(lo), "v"(hi)); return r; }
typedef float f32x2 __attribute__((ext_vector_type(2)));
typedef unsigned u32x2 __attribute__((ext_vector_type(2)));
__device__ __forceinline__ float fast_sigmoid(float x) { return __builtin_amdgcn_rcpf(1.0f + __expf(-x)); }

__device__ __forceinline__ f32x2 gelu2(f32x2 x) { const f32x2 t = x * x; const f32x2 uu = t * (-0.10294323f) + (-2.30220819f); const f32x2 wv = x * uu;
    f32x2 ev; ev.x = __builtin_amdgcn_exp2f(wv.x); ev.y = __builtin_amdgcn_exp2f(wv.y); const f32x2 d = ev + 1.0f; f32x2 r; r.x = __builtin_amdgcn_rcpf(d.x); r.y = __builtin_amdgcn_rcpf(d.y); return x * r; }
__device__ __forceinline__ f32x2 gelu_silu2(f32x2 u, f32x2 g) { const f32x2 t = u * u; const f32x2 uu = t * (-0.10294323f) + (-2.30220819f); const f32x2 wu = u * uu, wg = g * (-1.44269504f);
    f32x2 eu, eg; eu.x = __builtin_amdgcn_exp2f(wu.x); eu.y = __builtin_amdgcn_exp2f(wu.y); eg.x = __builtin_amdgcn_exp2f(wg.x); eg.y = __builtin_amdgcn_exp2f(wg.y);
    const f32x2 d = (eu + 1.0f) * (eg + 1.0f); f32x2 r; r.x = __builtin_amdgcn_rcpf(d.x); r.y = __builtin_amdgcn_rcpf(d.y); return (u * g) * r; }
__device__ __forceinline__ f32x2 silu2(f32x2 x) { const f32x2 wv = x * (-1.44269504f);
    f32x2 ev; ev.x = __builtin_amdgcn_exp2f(wv.x); ev.y = __builtin_amdgcn_exp2f(wv.y); const f32x2 d = ev + 1.0f; f32x2 r; r.x = __builtin_amdgcn_rcpf(d.x); r.y = __builtin_amdgcn_rcpf(d.y); return x * r; }

#ifndef PROBE_KLOOP
#define PROBE_KLOOP 0
#endif
#ifndef PROBE_EPI2
#define PROBE_EPI2 0
#endif
struct RepOrder : StaticOrder { __host__ __device__ bool next(int i, Unit& u) const { return StaticOrder::next(i >> 1, u); } };
struct EpiZ {
    static constexpr bool PERM = true, AFTER_DRAIN = false, MIDSCALE = false, PREFETCH = false, PROBE2 = true;
    bf16_t* Z; int ldc; f32x2* vst;
    mutable int cnt;
    __device__ __forceinline__ void operator()(const f32x4 (&acc)[2][2][4][2], const Unit& u, int wr, int wc, int fr, int fq) const {
#if PROBE_KLOOP
        if ((cnt++ & 1) == 0) return;
#endif
        const int row0 = u.pm * BM + wr * 64 + fr;
        if (u.pn < 8) {
            const int col0 = u.pn * HALF + wc * 32 + 8 * fq;
#pragma unroll
            for (int ai = 0; ai < 2; ++ai)
#pragma unroll
                for (int m = 0; m < 4; ++m) { const int row = row0 + ai * HALF + m * 16; f32x2 p[4];
#pragma unroll
                    for (int n = 0; n < 2; ++n) { const f32x4 a = acc[ai][0][m][n], g = acc[ai][1][m][n];
                        p[2 * n] = gelu_silu2((f32x2){a[0], a[1]}, (f32x2){g[0], g[1]}); p[2 * n + 1] = gelu_silu2((f32x2){a[2], a[3]}, (f32x2){g[2], g[3]}); }
                    u32x4 w; w.x = cvt_pk_bf16(p[0].x, p[0].y); w.y = cvt_pk_bf16(p[1].x, p[1].y); w.z = cvt_pk_bf16(p[2].x, p[2].y); w.w = cvt_pk_bf16(p[3].x, p[3].y);
                    __builtin_nontemporal_store(w, (u32x4*)(Z + (size_t)row * ldc + col0)); }
            return; }
        const int col0 = 1024 + (u.pn - 8) * BM + wc * 32 + 8 * fq;
        const bool isv = (u.pn >> 2) == 2, isg = u.pn >= 16;
#pragma unroll
        for (int ai = 0; ai < 2; ++ai)
#pragma unroll
            for (int m = 0; m < 4; ++m) { const int row = row0 + ai * HALF + m * 16; bf16_t* rowp = Z + (size_t)row * ldc + col0;
                float s = 0.f, q = 0.f;
#pragma unroll
                for (int bj = 0; bj < 2; ++bj) { f32x4 v[2] = {acc[ai][bj][m][0], acc[ai][bj][m][1]};
                    if (isv) {
#pragma unroll
                        for (int n = 0; n < 2; ++n) { const f32x2 a = gelu2((f32x2){v[n][0], v[n][1]}), b = gelu2((f32x2){v[n][2], v[n][3]}); v[n] = (f32x4){a.x, a.y, b.x, b.y};
                            s += (a.x + a.y) + (b.x + b.y); q += (a.x * a.x + a.y * a.y) + (b.x * b.x + b.y * b.y); } }
                    if (isg) {
#pragma unroll
                        for (int n = 0; n < 2; ++n) { const f32x2 a = silu2((f32x2){v[n][0], v[n][1]}), b = silu2((f32x2){v[n][2], v[n][3]}); v[n] = (f32x4){a.x, a.y, b.x, b.y}; } }
                    u32x4 w; w.x = cvt_pk_bf16(v[0][0], v[0][1]); w.y = cvt_pk_bf16(v[0][2], v[0][3]); w.z = cvt_pk_bf16(v[1][0], v[1][1]); w.w = cvt_pk_bf16(v[1][2], v[1][3]);
                    __builtin_nontemporal_store(w, (u32x4*)(rowp + bj * HALF)); }
                if (isv) { s += __shfl_xor(s, 16); s += __shfl_xor(s, 32); q += __shfl_xor(q, 16); q += __shfl_xor(q, 32);
                    if (fq == 0) vst[(size_t)row * 16 + (u.pn - 8) * 4 + wc] = (f32x2){s, q}; }
            }
    }
};

struct PanelOrder {
    int c, G;
    __host__ __device__ void init(int, int, int G_, int c_) { G = G_; c = c_; }
    __host__ __device__ bool next(int i, Unit& u) const { if (i >= 4 || G != 256) return false; const int cls = c & 7, j = c >> 3; u.pm = 16 * cls + 4 * i + (j & 3); u.pn = j >> 2; return true; }
    __device__ __forceinline__ void a_ready(const Unit&) const {}
    __device__ __forceinline__ void done(const Unit&) const {}
};
struct EpiH {
    static constexpr bool PERM = true, AFTER_DRAIN = false, MIDSCALE = true, PROBE2 = false;
    bf16_t* H; int ldh; const bf16_t* xa; int ldx; const float* sx; const float* pg; const PG8_LAS f32x2* rr; PG8_LAS float* P; PG8_LAS float* S; float* X; unsigned* cnt; unsigned* tmo; mutable int ui; mutable unsigned pfd; mutable u32x4 xp[2][2][2];
    __device__ __forceinline__ EpiH(bf16_t* H_, int ldh_, const bf16_t* xa_, int ldx_, const float* sx_, const float* pg_, const PG8_LAS f32x2* rr_, PG8_LAS float* P_, PG8_LAS float* S_, float* X_, unsigned* cnt_, unsigned* tmo_) : H(H_), ldh(ldh_), xa(xa_), ldx(ldx_), sx(sx_), pg(pg_), rr(rr_), P(P_), S(S_), X(X_), cnt(cnt_), tmo(tmo_), ui(0) {}
    __device__ __forceinline__ int hook_tile(int nt) const { return nt / 2; }
    __device__ __forceinline__ void midscale(f32x4 (&acc)[2][2][4][2], const Unit& u, int wr, int wc, int fr, int fq) const {
#pragma unroll
        for (int ai = 0; ai < 2; ++ai)
#pragma unroll
            for (int m = 0; m < 4; ++m) { const float s = rr[ui * 256 + ai * HALF + wr * 64 + m * 16 + fr].x;
#pragma unroll
                for (int bj = 0; bj < 2; ++bj)
#pragma unroll
                    for (int n = 0; n < 2; ++n) acc[ai][bj][m][n] *= s; }
        int fr2 = fr, fq2 = fq; asm volatile("" : "+v"(fr2), "+v"(fq2));
        const int row0 = u.pm * BM + wr * 64 + fr2, col0 = u.pn * BM + wc * 32 + 8 * fq2;
#pragma unroll
        for (int gi = 0; gi < 2; ++gi)
#pragma unroll
            for (int mm = 0; mm < 2; ++mm) { const bf16_t* xr = xa + (size_t)(row0 + (2 * gi + mm) * 16) * ldx + col0;
#pragma unroll
                for (int bj = 0; bj < 2; ++bj) xp[gi][mm][bj] = __builtin_nontemporal_load((const u32x4*)(xr + bj * HALF)); }
        { const int l = fq2 * 16 + fr2; const char* pa = (const char*)(xa + (size_t)(u.pm * BM + HALF + 16 * (wr * 4 + wc) + (l >> 2)) * ldx + u.pn * BM) + (l & 3) * 128;
          asm volatile("global_load_dword %0, %1, off" : "=v"(pfd) : "v"(pa) : "memory"); }
    }
    __device__ __forceinline__ void operator()(f32x4 (&acc)[2][2][4][2], const Unit& u, int wr, int wc, int fr_in, int fq_in) const {
        int fr = fr_in, fq = fq_in; asm volatile("" : "+v"(fr), "+v"(fq));
        const int wid = wr * 4 + wc, lane = fq * 16 + fr, tid = wid * 64 + lane;
        const int row0 = u.pm * BM + wr * 64 + fr, col0 = u.pn * BM + wc * 32 + 8 * fq;
        u32x4 xw2[2][2], xw3[2][2]; float xs[4][2]; f32x4 gv[2][2];
#define XLOADG(DST, GI) do { _Pragma("unroll") for (int mm = 0; mm < 2; ++mm) { const int row = row0 + ((GI) >> 1) * HALF + (2 * ((GI) & 1) + mm) * 16; const bf16_t* xr = xa + (size_t)row * ldx + col0; xs[GI][mm] = sx[row]; \
            _Pragma("unroll") for (int bj = 0; bj < 2; ++bj) DST[mm][bj] = __builtin_nontemporal_load((const u32x4*)(xr + bj * HALF)); } } while (0)
#define XLOADS() do { _Pragma("unroll") for (int bj = 0; bj < 2; ++bj) { gv[bj][0] = *(const f32x4*)(pg + col0 + bj * HALF); gv[bj][1] = *(const f32x4*)(pg + col0 + bj * HALF + 4); } \
        _Pragma("unroll") for (int gi = 0; gi < 2; ++gi) _Pragma("unroll") for (int mm = 0; mm < 2; ++mm) xs[gi][mm] = sx[row0 + (2 * gi + mm) * 16]; \
        XLOADG(xw2, 2); } while (0)
#define XSTORE(XV, GI) do { _Pragma("unroll") for (int mm = 0; mm < 2; ++mm) { const int ai = (GI) >> 1, m = 2 * ((GI) & 1) + mm; const int rl = ai * HALF + wr * 64 + m * 16 + fr; const float rs = S[rl], xsc = xs[GI][mm]; bf16_t* hr = H + (size_t)(u.pm * BM + rl) * ldh + col0; \
            _Pragma("unroll") for (int bj = 0; bj < 2; ++bj) { const u32x4 xv_ = XV[mm][bj]; \
                const f32x4 x0 = (f32x4){__uint_as_float(xv_.x << 16), __uint_as_float(xv_.x & 0xffff0000u), __uint_as_float(xv_.y << 16), __uint_as_float(xv_.y & 0xffff0000u)} * xsc; \
                const f32x4 x1 = (f32x4){__uint_as_float(xv_.z << 16), __uint_as_float(xv_.z & 0xffff0000u), __uint_as_float(xv_.w << 16), __uint_as_float(xv_.w & 0xffff0000u)} * xsc; \
                const f32x4 v0 = x0 + acc[ai][bj][m][0] * rs * gv[bj][0], v1 = x1 + acc[ai][bj][m][1] * rs * gv[bj][1]; \
                u32x4 w; w.x = cvt_pk_bf16(v0[0], v0[1]); w.y = cvt_pk_bf16(v0[2], v0[3]); w.z = cvt_pk_bf16(v1[0], v1[1]); w.w = cvt_pk_bf16(v1[2], v1[3]); \
                *(u32x4*)(hr + bj * HALF) = w; } } } while (0)
#pragma unroll
        for (int ai = 0; ai < 2; ++ai)
#pragma unroll
            for (int m = 0; m < 4; ++m) { const int rl = ai * HALF + wr * 64 + m * 16 + fr; const float s = rr[ui * 256 + rl].y; float q = 0.f;
#pragma unroll
                for (int bj = 0; bj < 2; ++bj)
#pragma unroll
                    for (int n = 0; n < 2; ++n) { acc[ai][bj][m][n] *= s; const f32x4 v = acc[ai][bj][m][n]; q += (v[0] * v[0] + v[1] * v[1]) + (v[2] * v[2] + v[3] * v[3]); }
                q += __shfl_xor(q, 16); q += __shfl_xor(q, 32);
                if (fq == 0) P[rl * 4 + wc] = q; }
        asm volatile("s_waitcnt lgkmcnt(0)" ::: "memory"); __builtin_amdgcn_s_barrier(); asm volatile("" ::: "memory");
        if (tid < 256) { const float t = (P[tid * 4 + 0] + P[tid * 4 + 1]) + (P[tid * 4 + 2] + P[tid * 4 + 3]);
            __hip_atomic_store(X + ((size_t)u.pm * 256 + tid) * 8 + u.pn, -t, __ATOMIC_RELAXED, __HIP_MEMORY_SCOPE_AGENT);
            if (lane == 0) __hip_atomic_fetch_add(cnt + 16 * u.pm, 1u, __ATOMIC_RELAXED, __HIP_MEMORY_SCOPE_AGENT);
        } else { XLOADS(); }
        if (wid == 0) { unsigned spins = 0;
            while ((unsigned)__builtin_amdgcn_readfirstlane(__hip_atomic_load(cnt + 16 * u.pm, __ATOMIC_RELAXED, __HIP_MEMORY_SCOPE_AGENT)) < 32u) {
                __builtin_amdgcn_s_sleep(1);
                if (++spins > (1u << 17)) { if (lane == 0) __hip_atomic_store(tmo, 1u, __ATOMIC_RELAXED, __HIP_MEMORY_SCOPE_AGENT); break; } } }
        asm volatile("s_waitcnt lgkmcnt(0)" ::: "memory"); __builtin_amdgcn_s_barrier(); asm volatile("" ::: "memory");
        if (tid < 256) { const unsigned long long* xq = (const unsigned long long*)(X + ((size_t)u.pm * 256 + tid) * 8); unsigned long long w4[4];
#pragma unroll
            for (int k = 0; k < 4; ++k) w4[k] = __hip_atomic_load(xq + k, __ATOMIC_RELAXED, __HIP_MEMORY_SCOPE_AGENT);
            for (unsigned spins = 0;; ++spins) {
                bool ok = true;
#pragma unroll
                for (int k = 0; k < 4; ++k) ok = ok && ((w4[k] & 0x8000000080000000ull) == 0x8000000080000000ull);
                if (__all(ok)) break;
                if (spins > (1u << 17)) { if (lane == 0) __hip_atomic_store(tmo, 1u, __ATOMIC_RELAXED, __HIP_MEMORY_SCOPE_AGENT); break; }
                __builtin_amdgcn_s_sleep(2);
#pragma unroll
                for (int k = 0; k < 4; ++k) if ((w4[k] & 0x8000000080000000ull) != 0x8000000080000000ull) w4[k] = __hip_atomic_load(xq + k, __ATOMIC_RELAXED, __HIP_MEMORY_SCOPE_AGENT);
            }
            asm volatile("" ::: "memory");
            XLOADS();
            asm volatile("" ::: "memory");
            float t = 0.f;
#pragma unroll
            for (int k = 0; k < 4; ++k) t -= __uint_as_float((unsigned)w4[k]) + __uint_as_float((unsigned)(w4[k] >> 32));
            S[tid] = __builtin_amdgcn_rsqf(t * (1.0f / 2048.0f) + 1e-6f); }
        asm volatile("s_waitcnt lgkmcnt(0)" ::: "memory"); __builtin_amdgcn_s_barrier(); asm volatile("" ::: "memory");
        XSTORE(xp[0], 0); asm volatile("" ::: "memory"); XLOADG(xw3, 3); asm volatile("" ::: "memory");
        XSTORE(xp[1], 1); asm volatile("" ::: "memory"); XSTORE(xw2, 2); asm volatile("" ::: "memory"); XSTORE(xw3, 3);
        asm volatile("" :: "v"(pfd));
#undef XLOADS
#undef XLOADG
#undef XSTORE
        ++ui;
    }
};

struct EpiOut {
    static constexpr bool PERM = false, AFTER_DRAIN = false, MIDSCALE = true, PROBE2 = false;
    float* out; const bf16_t* h1; int ldc, lda; mutable unsigned g8[2][2][4][2]; mutable u32x2 hp[2][2][2];
    __device__ __forceinline__ EpiOut(float* out_, const bf16_t* h1_, int ldc_, int lda_) : out(out_), h1(h1_), ldc(ldc_), lda(lda_) {}
    __device__ __forceinline__ int hook_tile(int nt) const { return nt - 4; }
    __device__ __forceinline__ void midscale(f32x4 (&acc)[2][2][4][2], const Unit& u, int wr, int wc, int fr, int fq) const {
#pragma unroll
        for (int ai = 0; ai < 2; ++ai)
#pragma unroll
            for (int bj = 0; bj < 2; ++bj)
#pragma unroll
                for (int m = 0; m < 4; ++m)
#pragma unroll
                    for (int n = 0; n < 2; ++n) { const f32x4 a = acc[ai][bj][m][n];
                        const f32x2 s0 = (f32x2){a[0], a[1]} * 16.0f + 128.0f, s1 = (f32x2){a[2], a[3]} * 16.0f + 128.0f;
                        unsigned w = __builtin_amdgcn_cvt_pk_u8_f32(s0.x, 0u, 0u); w = __builtin_amdgcn_cvt_pk_u8_f32(s0.y, 1u, w); w = __builtin_amdgcn_cvt_pk_u8_f32(s1.x, 2u, w); w = __builtin_amdgcn_cvt_pk_u8_f32(s1.y, 3u, w);
                        g8[ai][bj][m][n] = w; acc[ai][bj][m][n] = (f32x4){0.f, 0.f, 0.f, 0.f}; }
        int fr2 = fr, fq2 = fq; asm volatile("" : "+v"(fr2), "+v"(fq2));
        const int row0 = u.pm * BM + wr * 64 + fr2, col0 = u.pn * BM + wc * 32 + 4 * fq2;
#pragma unroll
        for (int mm = 0; mm < 2; ++mm) { const size_t offa = (size_t)(row0 + mm * 16) * lda + col0;
#pragma unroll
            for (int bj = 0; bj < 2; ++bj)
#pragma unroll
                for (int n = 0; n < 2; ++n) hp[mm][bj][n] = *(const u32x2*)(h1 + offa + bj * HALF + n * 16); }
    }
    __device__ __forceinline__ void operator()(const f32x4 (&acc)[2][2][4][2], const Unit& u, int wr, int wc, int fr_in, int fq_in) const {
        int fr = fr_in, fq = fq_in; asm volatile("" : "+v"(fr), "+v"(fq));
        const int row0 = u.pm * BM + wr * 64 + fr, col0 = u.pn * BM + wc * 32 + 4 * fq;
        u32x2 hw[2][2][2][2];
#define HLOAD(B, GI) do { _Pragma("unroll") for (int mm = 0; mm < 2; ++mm) { const size_t offa = (size_t)(row0 + ((GI) >> 1) * HALF + (2 * ((GI) & 1) + mm) * 16) * lda + col0; \
            _Pragma("unroll") for (int bj = 0; bj < 2; ++bj) _Pragma("unroll") for (int n = 0; n < 2; ++n) hw[B][mm][bj][n] = *(const u32x2*)(h1 + offa + bj * HALF + n * 16); } } while (0)
#define HSTORE(B, GI) do { _Pragma("unroll") for (int mm = 0; mm < 2; ++mm) { const int ai = (GI) >> 1, m = 2 * ((GI) & 1) + mm; const size_t off = (size_t)(row0 + ai * HALF + m * 16) * ldc + col0; \
            _Pragma("unroll") for (int bj = 0; bj < 2; ++bj) _Pragma("unroll") for (int n = 0; n < 2; ++n) { const int cc = bj * HALF + n * 16; \
                const u32x2 hv = hw[B][mm][bj][n]; const f32x4 a = acc[ai][bj][m][n]; const unsigned w = g8[ai][bj][m][n]; f32x4 r; \
                const f32x2 z0 = (f32x2){(float)(w & 0xffu), (float)((w >> 8) & 0xffu)} * (-0.09016844f) + 11.5415603f, z1 = (f32x2){(float)((w >> 16) & 0xffu), (float)(w >> 24)} * (-0.09016844f) + 11.5415603f;        \
                f32x2 e0, e1; e0.x = __builtin_amdgcn_exp2f(z0.x); e0.y = __builtin_amdgcn_exp2f(z0.y); e1.x = __builtin_amdgcn_exp2f(z1.x); e1.y = __builtin_amdgcn_exp2f(z1.y); \
                const f32x2 d0 = e0 + 1.0f, d1 = e1 + 1.0f; \
                r[0] = __uint_as_float(hv.x << 16) + a[0] * __builtin_amdgcn_rcpf(d0.x); \
                r[1] = __uint_as_float(hv.x & 0xffff0000u) + a[1] * __builtin_amdgcn_rcpf(d0.y); \
                r[2] = __uint_as_float(hv.y << 16) + a[2] * __builtin_amdgcn_rcpf(d1.x); \
                r[3] = __uint_as_float(hv.y & 0xffff0000u) + a[3] * __builtin_amdgcn_rcpf(d1.y); \
                __builtin_nontemporal_store(r, (f32x4*)(out + off + cc)); } } } while (0)
#pragma unroll
        for (int mm = 0; mm < 2; ++mm)
#pragma unroll
            for (int bj = 0; bj < 2; ++bj)
#pragma unroll
                for (int n = 0; n < 2; ++n) hw[0][mm][bj][n] = hp[mm][bj][n];
        HLOAD(1, 1);
        asm volatile("" ::: "memory"); HSTORE(0, 0); asm volatile("" ::: "memory"); HLOAD(0, 2);
        asm volatile("" ::: "memory"); HSTORE(1, 1); asm volatile("" ::: "memory"); HLOAD(1, 3);
        asm volatile("" ::: "memory"); HSTORE(0, 2);
        asm volatile("" ::: "memory"); HSTORE(1, 3);
#undef HLOAD
#undef HSTORE
    }
};

template <class Epi, class Sched, bool ALIGN_EPI = false, bool SP2 = false>
__device__ __forceinline__ void gemm_phase(PG8_LAS unsigned char* lds, const Gemm g, const Sched& S, const Epi& E, int tid_in) {
    int tid_ = tid_in; asm volatile("" : "+v"(tid_));
    const int tid = tid_, wid = __builtin_amdgcn_readfirstlane(tid >> 6), lane = tid & 63, wr = wid >> 2, wc = wid & 3, fr = lane & 15, fq = lane >> 4;
    const int K = g.K, nt = K / BK;
    unsigned voffA[2], voffB[2];
#pragma unroll
    for (int i = 0; i < 2; ++i) { int R, C; stage_rc(tid * 16 + i * 8192, R, C); const int Rb = Epi::PERM ? ((R & ~31) + perm32(R & 31)) : R;
        voffA[i] = (unsigned)(R * K + C) * 2u; voffB[i] = (unsigned)(Rb * K + C) * 2u; }
    const size_t kstep = (size_t)(BK * 2);
    const size_t hstep = (size_t)HALF * K * 2;
    const size_t tstep = 2 * hstep;
    const unsigned ldsw = (unsigned)wid * 1024u;
    const int aoff = lds_byte(wr * 64 + fr, fq * 8), boff = lds_byte(wc * 32 + fr, fq * 8);
#define PG8_SA(b, h) (((b) * 2 + (h)) * HTB)
#define PG8_SB(b, h) ((4 + (b) * 2 + (h)) * HTB)
#define PG8_STAGE(bufoff, gbase, voff) do { const char* gb_ = (const char*)(gbase); asm volatile("" : "+s"(gb_)); _Pragma("unroll") for (int _i = 0; _i < 2; ++_i) { \
        unsigned vo_ = (voff)[_i]; asm volatile("" : "+v"(vo_));        \
        __builtin_amdgcn_global_load_lds((const unsigned*)(gb_ + vo_), (PG8_LAS unsigned*)(lds + (bufoff) + ldsw + _i * 8192), 16, 0, 0); } } while (0)
#define PG8_LDA(dst, b, h) do { _Pragma("unroll") for (int m = 0; m < 4; ++m) _Pragma("unroll") for (int k = 0; k < 2; ++k) dst[m][k] = *(const PG8_LAS bf16x8*)(lds + PG8_SA(b, h) + aoff + m * 2048 + k * 1024); } while (0)
#define PG8_LDB(dst, b, h) do { _Pragma("unroll") for (int n = 0; n < 2; ++n) _Pragma("unroll") for (int k = 0; k < 2; ++k) dst[n][k] = *(const PG8_LAS bf16x8*)(lds + PG8_SB(b, h) + boff + n * 2048 + k * 1024); } while (0)
#define PG8_MMA(ai, bj, At, Bt) do { __builtin_amdgcn_s_setprio(1); _Pragma("unroll") for (int m = 0; m < 4; ++m) _Pragma("unroll") for (int n = 0; n < 2; ++n) _Pragma("unroll") for (int k = 0; k < 2; ++k) \
        acc[ai][bj][m][n] = __builtin_amdgcn_mfma_f32_16x16x32_bf16(Bt[n][k], At[m][k], acc[ai][bj][m][n], 0, 0, 0); __builtin_amdgcn_s_setprio(0); } while (0)
#define PG8_WAIT_V(n) asm volatile("s_waitcnt vmcnt(" #n ")" ::: "memory")
#define PG8_WAIT_L(n) asm volatile("s_waitcnt lgkmcnt(" #n ")" ::: "memory")
#define PG8_BAR __builtin_amdgcn_s_barrier()
#define PG8_SCHED __builtin_amdgcn_sched_barrier(0)
    Unit cur, nxt; int ui = 0;
    if (!S.next(0, cur)) return;
    f32x4 acc[2][2][4][2];
#pragma unroll
    for (int a = 0; a < 2; ++a)
#pragma unroll
        for (int b = 0; b < 2; ++b)
#pragma unroll
            for (int m = 0; m < 4; ++m)
#pragma unroll
                for (int n = 0; n < 2; ++n) acc[a][b][m][n] = (f32x4){0.f, 0.f, 0.f, 0.f};
    bf16x8 At[4][2], B0[2][2], B1[2][2];
    const char* cA = (const char*)g.A + (size_t)cur.pm * tstep; const char* cB = (const char*)g.Bt + (size_t)cur.pn * tstep;
    S.a_ready(cur);
    if constexpr (SP2) {
        PG8_STAGE(PG8_SB(0, 0), cB, voffB); PG8_STAGE(PG8_SB(0, 1), cB + hstep, voffB); PG8_STAGE(PG8_SA(0, 0), cA, voffA); PG8_STAGE(PG8_SA(0, 1), cA + hstep, voffA);
        if (wr == 1) PG8_BAR;
        PG8_WAIT_V(2); PG8_BAR;
        PG8_STAGE(PG8_SB(1, 0), cB + kstep, voffB); PG8_STAGE(PG8_SA(1, 0), cA + kstep, voffA); PG8_STAGE(PG8_SB(1, 1), cB + hstep + kstep, voffB);
        PG8_WAIT_V(6); PG8_BAR;
    } else {
        PG8_STAGE(PG8_SB(0, 0), cB, voffB); PG8_STAGE(PG8_SA(0, 0), cA, voffA); PG8_STAGE(PG8_SB(0, 1), cB + hstep, voffB); PG8_STAGE(PG8_SA(0, 1), cA + hstep, voffA);
        if (wr == 1) PG8_BAR;
        PG8_WAIT_V(4); PG8_BAR;
        PG8_STAGE(PG8_SB(1, 0), cB + kstep, voffB); PG8_STAGE(PG8_SA(1, 0), cA + kstep, voffA); PG8_STAGE(PG8_SB(1, 1), cB + hstep + kstep, voffB);
        PG8_WAIT_V(6); PG8_BAR;
    }
    for (;;) {
        const bool has_next = S.next(ui + 1, nxt);
        const char* nA = has_next ? (const char*)g.A + (size_t)nxt.pm * tstep : cA; const char* nB = has_next ? (const char*)g.Bt + (size_t)nxt.pn * tstep : cB;
        for (int t = 0; t < nt; t += 2) {
            const bool last = (t == nt - 2);
            const char* a1 = cA + (size_t)(t + 1) * kstep;
            const char* a2 = last ? nA : cA + (size_t)(t + 2) * kstep; const char* b2 = last ? nB : cB + (size_t)(t + 2) * kstep;
            const char* a3 = a2 + kstep; const char* b3 = b2 + kstep;
            if (last && has_next) S.a_ready(nxt);
            if constexpr (Epi::MIDSCALE) { if (t == E.hook_tile(nt)) E.midscale(acc, cur, wr, wc, fr, fq); }
            if constexpr (SP2) {
            PG8_LDB(B0, 0, 0); PG8_LDB(B1, 0, 1); PG8_SCHED; PG8_LDA(At, 0, 0); PG8_STAGE(PG8_SA(1, 1), a1 + hstep, voffA);
            PG8_WAIT_V(8); PG8_WAIT_L(0); PG8_BAR; PG8_MMA(0, 0, At, B0); PG8_MMA(0, 1, At, B1); PG8_BAR; PG8_SCHED;
            PG8_LDA(At, 0, 1); PG8_STAGE(PG8_SB(0, 0), b2, voffB); PG8_STAGE(PG8_SB(0, 1), b2 + hstep, voffB); PG8_STAGE(PG8_SA(0, 0), a2, voffA);
            PG8_WAIT_V(8); PG8_WAIT_L(0); PG8_BAR; PG8_MMA(1, 0, At, B0); PG8_MMA(1, 1, At, B1); PG8_BAR; PG8_SCHED;
            PG8_LDB(B0, 1, 0); PG8_LDB(B1, 1, 1); PG8_SCHED; PG8_LDA(At, 1, 0); PG8_STAGE(PG8_SA(0, 1), a2 + hstep, voffA);
            PG8_WAIT_V(8); PG8_WAIT_L(0); PG8_BAR; PG8_MMA(0, 0, At, B0); PG8_MMA(0, 1, At, B1); PG8_BAR; PG8_SCHED;
            PG8_LDA(At, 1, 1); PG8_STAGE(PG8_SB(1, 0), b3, voffB); PG8_STAGE(PG8_SB(1, 1), b3 + hstep, voffB); PG8_STAGE(PG8_SA(1, 0), a3, voffA);
            PG8_WAIT_V(8); PG8_WAIT_L(0); PG8_BAR; PG8_MMA(1, 0, At, B0); PG8_MMA(1, 1, At, B1); PG8_BAR; PG8_SCHED;
            } else {
            PG8_LDB(B0, 0, 0); PG8_SCHED; PG8_LDA(At, 0, 0); PG8_STAGE(PG8_SA(1, 1), a1 + hstep, voffA);
            PG8_WAIT_L(8); PG8_BAR; PG8_WAIT_L(0); PG8_MMA(0, 0, At, B0); PG8_BAR; PG8_SCHED;
            PG8_LDB(B1, 0, 1); PG8_STAGE(PG8_SB(0, 0), b2, voffB);
            PG8_BAR; PG8_WAIT_L(0); PG8_MMA(0, 1, At, B1); PG8_BAR;
            PG8_LDA(At, 0, 1); PG8_STAGE(PG8_SA(0, 0), a2, voffA);
            PG8_BAR; PG8_WAIT_L(0); PG8_MMA(1, 0, At, B0); PG8_BAR; PG8_SCHED;
            PG8_STAGE(PG8_SB(0, 1), b2 + hstep, voffB);
            PG8_WAIT_V(6); PG8_BAR; PG8_MMA(1, 1, At, B1); PG8_BAR;
            PG8_LDB(B0, 1, 0); PG8_SCHED; PG8_LDA(At, 1, 0); PG8_STAGE(PG8_SA(0, 1), a2 + hstep, voffA);
            PG8_WAIT_L(8); PG8_BAR; PG8_WAIT_L(0); PG8_MMA(0, 0, At, B0); PG8_BAR; PG8_SCHED;
            PG8_LDB(B1, 1, 1); PG8_STAGE(PG8_SB(1, 0), b3, voffB);
            PG8_BAR; PG8_WAIT_L(0); PG8_MMA(0, 1, At, B1); PG8_BAR;
            PG8_LDA(At, 1, 1); PG8_STAGE(PG8_SA(1, 0), a3, voffA);
            PG8_BAR; PG8_WAIT_L(0); PG8_MMA(1, 0, At, B0); PG8_BAR; PG8_SCHED;
            PG8_STAGE(PG8_SB(1, 1), b3 + hstep, voffB);
            PG8_WAIT_V(6); PG8_BAR; PG8_MMA(1, 1, At, B1); PG8_BAR;
            }
        }
        if constexpr (ALIGN_EPI) { if (wr == 0) PG8_BAR; }
        if constexpr (!Epi::AFTER_DRAIN) { E(acc, cur, wr, wc, fr, fq);
#if PROBE_EPI2
            if constexpr (Epi::PROBE2) { asm volatile("" ::: "memory");
                _Pragma("unroll") for (int a = 0; a < 2; ++a) _Pragma("unroll") for (int b = 0; b < 2; ++b) _Pragma("unroll") for (int m = 0; m < 4; ++m) _Pragma("unroll") for (int n = 0; n < 2; ++n) asm volatile("" : "+v"(acc[a][b][m][n]));
                int fr2 = fr, fq2 = fq; asm volatile("" : "+v"(fr2), "+v"(fq2));
                E(acc, cur, wr, wc, fr2, fq2); }
#endif
            S.done(cur); }
        if (!has_next) break;
#pragma unroll
        for (int a = 0; a < 2; ++a)
#pragma unroll
            for (int b = 0; b < 2; ++b)
#pragma unroll
                for (int m = 0; m < 4; ++m)
#pragma unroll
                    for (int n = 0; n < 2; ++n) acc[a][b][m][n] = (f32x4){0.f, 0.f, 0.f, 0.f};
        cur = nxt; cA = nA; cB = nB; ++ui;
        if constexpr (ALIGN_EPI) { if (wr == 1) PG8_BAR; }
    }
    PG8_WAIT_V(0);
    if constexpr (!ALIGN_EPI) { if (wr == 0) PG8_BAR; }
    PG8_BAR;
    if constexpr (Epi::AFTER_DRAIN) { E.fused(acc, cur, wr, wc, fr, fq, lds, wid, lane); S.done(cur); }
#undef PG8_SA
#undef PG8_SB
#undef PG8_STAGE
#undef PG8_LDA
#undef PG8_LDB
#undef PG8_MMA
#undef PG8_WAIT_V
#undef PG8_WAIT_L
#undef PG8_BAR
#undef PG8_SCHED
}
}

constexpr int BATCH = 4, SEQ = 8192, DM = 2048, M = BATCH * SEQ, DG = 1024, DL = 1024, NZ = 5120, NZO = 4096, DP = 256, CHK = 128, NH = 8;
constexpr float EPS = 1e-6f;
constexpr int NWAVES = 8, NTHR = NWAVES * 64;
#ifndef MK_N_LAUNCHES
#define MK_N_LAUNCHES 1
#endif
constexpr int N_PHASES = 8;
#ifndef MK_CG_SYNC
#define MK_CG_SYNC 0
#endif
#ifndef SKEW7_TICKS
#define SKEW7_TICKS 0
#endif
#ifndef PROBE_DOUBLE
#define PROBE_DOUBLE 0
#endif
#define REPS(k) for (int rep_ = 0; rep_ < 1 + ((PROBE_DOUBLE >> (k)) & 1); ++rep_)

constexpr size_t MiB = 1u << 20;
constexpr size_t WS_WIN = 2 * MiB;
constexpr size_t WS_WOUT = 22 * MiB;
constexpr size_t WS_WA = 39 * MiB;
constexpr size_t WS_WX = WS_WA + 256 * 1024;
constexpr size_t WS_WSM = WS_WX + 256 * 1024;
constexpr size_t WS_VST = 40 * MiB;
constexpr size_t WS_SSA = 44 * MiB;
constexpr size_t WS_SSB = 45 * MiB;
constexpr size_t WS_SSO = 46 * MiB;
constexpr size_t WS_AGG = 50 * MiB;
constexpr size_t WS_SPT = 53 * MiB;
constexpr size_t WS_SX = 52 * MiB;
constexpr size_t WS_A1 = 64 * MiB;
constexpr int K3 = DM + DP;
constexpr size_t WS_A3 = 192 * MiB;
constexpr size_t WS_Z = 336 * MiB;
constexpr size_t WS_Y = 656 * MiB;
constexpr size_t WS_B3 = 912 * MiB;
constexpr size_t WS_END = 922 * MiB;

constexpr int LDS_BYTES = 147456;
constexpr int IMG0 = 0, IMG1 = 32768, IMG2 = 65536, IMG3 = 98304, MISC = 131072;
constexpr int MISC_STAT = MISC, MISC_PART = MISC + 1024, MISC_CPART = MISC + 5120;

#define LAS __attribute__((address_space(3)))
typedef unsigned short bf16;
typedef unsigned char uchar;
typedef float f32x4 __attribute__((ext_vector_type(4)));
typedef float f32x2 __attribute__((ext_vector_type(2)));
typedef unsigned u32x4 __attribute__((ext_vector_type(4)));
typedef unsigned u32x2 __attribute__((ext_vector_type(2)));
typedef short bf16x8 __attribute__((ext_vector_type(8)));

__device__ __forceinline__ unsigned f2bf(float f) { unsigned u = __builtin_bit_cast(unsigned, f); return (u + 0x7fffu + ((u >> 16) & 1u)) >> 16; }
__device__ __forceinline__ unsigned pk2(float lo, float hi) { unsigned r; asm("v_cvt_pk_bf16_f32 %0, %1, %2" : "=v"(r) : "v"(lo), "v"(hi)); return r; }
__device__ __forceinline__ float bflo(unsigned w) { return __uint_as_float(w << 16); }
__device__ __forceinline__ float bfhi(unsigned w) { return __uint_as_float(w & 0xffff0000u); }
__device__ __forceinline__ float wave_sum(float v) {
#pragma unroll
    for (int o = 1; o < 64; o <<= 1) v += __shfl_xor(v, o);
    return v;
}
__device__ __forceinline__ float sigmoidf_(float x) { return __builtin_amdgcn_rcpf(1.0f + __expf(-x)); }

__device__ __forceinline__ f32x2 gelu2(f32x2 x) { const f32x2 t = x * x; const f32x2 uu = t * (-0.10294323f) + (-2.30220819f); const f32x2 wv = x * uu;
    f32x2 ev; ev.x = __builtin_amdgcn_exp2f(wv.x); ev.y = __builtin_amdgcn_exp2f(wv.y); const f32x2 d = ev + 1.0f; f32x2 r; r.x = __builtin_amdgcn_rcpf(d.x); r.y = __builtin_amdgcn_rcpf(d.y); return x * r; }
__device__ __forceinline__ f32x2 silu2(f32x2 x) { const f32x2 wv = x * (-1.44269504f);
    f32x2 ev; ev.x = __builtin_amdgcn_exp2f(wv.x); ev.y = __builtin_amdgcn_exp2f(wv.y); const f32x2 d = ev + 1.0f; f32x2 r; r.x = __builtin_amdgcn_rcpf(d.x); r.y = __builtin_amdgcn_rcpf(d.y); return x * r; }

struct Args { const float* in[21]; float* out; unsigned char* ws; int ph_lo, ph_hi; };
typedef const __attribute__((address_space(4))) Args* ArgP;
struct Frame {
    LAS uchar* lds;
    int tid, lane, wave, G, bid;
    int wv;
    ArgP ap;
};
#define PHASE_BEGIN(F) do { int w_ = (F).wv; unsigned z_ = 0u; ArgP a_ = (ArgP)__builtin_amdgcn_kernarg_segment_ptr(); asm volatile("" : "+s"(w_), "+s"(a_), "+s"(z_)); \
    const int l_ = (int)__builtin_amdgcn_mbcnt_hi(~0u, __builtin_amdgcn_mbcnt_lo(~0u, z_));     \
    (F).lane = l_; (F).wave = w_; (F).tid = w_ * 64 + l_; (F).ap = a_; } while (0)

__device__ __forceinline__ void p0_transpose_item(const float* W, int K, int N, bf16* WT, LAS float* scr, int item, int lane, const float* ks0, const float* ks1, int ksplit, int ldt = 0, bool winperm = false) {
    if (ldt == 0) ldt = K;
    const int nblk = N / 32, kb = item / nblk, nb = item % nblk, k0 = 64 * kb, n0 = 32 * nb;
    int n0s = n0;
    if (winperm) { if (n0 < 2048) { const int k = n0 >> 8, r = n0 & 255; n0s = (r < 128) ? 128 * k + r : 2048 + 128 * k + (r - 128); } else if (n0 < 3072) n0s = n0 - 1024; }
#pragma unroll 8
    for (int i = 0; i < 32; ++i) { const int kk = 2 * i + (lane >> 5); scr[kk * 33 + (lane & 31)] = __builtin_nontemporal_load(W + (size_t)(k0 + kk) * N + n0s + (lane & 31)); }
    const int c = lane & 7;
    f32x4 s0 = (f32x4){1.f, 1.f, 1.f, 1.f}, s1 = s0;
    if (ks0) { const float* ks = (k0 < ksplit) ? ks0 + k0 : ks1 + (k0 - ksplit); s0 = *(const f32x4*)(ks + 8 * c); s1 = *(const f32x4*)(ks + 8 * c + 4); }
    asm volatile("s_waitcnt lgkmcnt(0)" ::: "memory");
#pragma unroll
    for (int j = 0; j < 4; ++j) { const int n = (lane >> 3) + 8 * j; const LAS float* s = scr + (8 * c) * 33 + n;
        u32x4 o; o.x = pk2(s[0 * 33] * s0.x, s[1 * 33] * s0.y); o.y = pk2(s[2 * 33] * s0.z, s[3 * 33] * s0.w); o.z = pk2(s[4 * 33] * s1.x, s[5 * 33] * s1.y); o.w = pk2(s[6 * 33] * s1.z, s[7 * 33] * s1.w);
        *(u32x4*)(WT + (size_t)(n0 + n) * ldt + k0 + 8 * c) = o; }
    asm volatile("s_waitcnt lgkmcnt(0)" ::: "memory");
}

__device__ __forceinline__ void p0_prologue(Frame& F) {
    LAS float* scr = (LAS float*)(F.lds + F.wave * 16384);
    const int gw = F.bid * NWAVES + F.wave, NGW = F.G * NWAVES;
    const float* w_in = F.ap->in[3]; const float* w_out = F.ap->in[17]; const float* w_pe = F.ap->in[19]; const float* w_pg = F.ap->in[20];
    const float* w_a = F.ap->in[10]; const float* w_x = F.ap->in[12];
    bf16* WIN = (bf16*)(((uchar*)F.ap->ws) + WS_WIN); bf16* WOUT = (bf16*)(((uchar*)F.ap->ws) + WS_WOUT); bf16* B3 = (bf16*)(((uchar*)F.ap->ws) + WS_B3);
    bf16* WA = (bf16*)(((uchar*)F.ap->ws) + WS_WA); bf16* WX = (bf16*)(((uchar*)F.ap->ws) + WS_WX); bf16* WSM = (bf16*)(((uchar*)F.ap->ws) + WS_WSM);
    constexpr int I_IN = (DM / 64) * (NZ / 32), I_OUT = (DM / 64) * (DM / 32), I_PG = I_OUT, I_PE = (DP / 64) * (DM / 32), I_SM = 16 * 8;
    constexpr int NITEMS = I_IN + I_OUT + I_PG + I_PE + I_SM;
    for (int it = gw; it < NITEMS; it += NGW) {
        int r = it;
        if (r < I_IN) { p0_transpose_item(w_in, DM, NZ, WIN, scr, r, F.lane, F.ap->in[2], F.ap->in[2], DM, 0, true); continue; } r -= I_IN;
        if (r < I_OUT) { p0_transpose_item(w_out, DM, DM, WOUT, scr, r, F.lane, F.ap->in[15], F.ap->in[16], DG); continue; } r -= I_OUT;
        if (r < I_PG) { p0_transpose_item(w_pg, DM, DM, B3, scr, r, F.lane, nullptr, nullptr, 0, K3); continue; } r -= I_PG;
        if (r < I_PE) { p0_transpose_item(w_pe, DP, DM, B3 + DM, scr, r, F.lane, nullptr, nullptr, 0, K3); continue; } r -= I_PE;
        { const int mat = r >> 3, sub = r & 7;
          const float* src = (mat < 8 ? w_a : w_x) + (size_t)(mat & 7) * 16384; bf16* dst = (mat < 8 ? WA : WX) + (size_t)(mat & 7) * 16384;
          p0_transpose_item(src, 128, 128, dst, scr, sub, F.lane, nullptr, nullptr, 0); }
    }
    { unsigned long long* AGGz = (unsigned long long*)(((uchar*)F.ap->ws) + WS_AGG); const int gt = F.bid * NTHR + F.tid, NGT = F.G * NTHR;
      for (int i = gt; i < 256 * DL; i += NGT) __hip_atomic_store(AGGz + i, 0ull, __ATOMIC_RELAXED, __HIP_MEMORY_SCOPE_AGENT); }
    if (F.bid == 1) { float* spt = (float*)(((uchar*)F.ap->ws) + WS_SPT); const float* lam = F.ap->in[14];
      for (int i = F.tid; i < DL; i += NTHR) { const float xx = -lam[i]; const float spl = (xx > 0.f ? xx : 0.f) + log1pf(__expf(-fabsf(xx)));
          spt[i] = -8.0f * 1.44269504f * spl; } }
    { unsigned long long* Xz = (unsigned long long*)(((uchar*)F.ap->ws) + WS_SSO); const int gt = F.bid * NTHR + F.tid, NGT = F.G * NTHR;
      for (int i = gt; i < M * 4; i += NGT) __hip_atomic_store(Xz + i, 0ull, __ATOMIC_RELAXED, __HIP_MEMORY_SCOPE_AGENT); }
    { const float* ws_ = F.ap->in[6]; const int gt = F.bid * NTHR + F.tid, NGT = F.G * NTHR;
      for (int i = gt; i < NH * CHK * CHK / 2; i += NGT) { const int e = 2 * i, s = e & 127, t = (e >> 7) & 127; const f32x2 v = *(const f32x2*)(ws_ + e);
          ((unsigned*)WSM)[i] = pk2(s <= t ? v.x : 0.f, (s + 1) <= t ? v.y : 0.f); } }
    { const float* x = F.ap->in[0]; bf16* A1 = (bf16*)((uchar*)F.ap->ws + WS_A1); float* SX = (float*)((uchar*)F.ap->ws + WS_SX);
      f32x4 v[8], nx[8];
      int m = gw;
      if (m < M) { const f32x4* xr = (const f32x4*)(x + (size_t)m * DM) + 2 * F.lane;
#pragma unroll
          for (int j = 0; j < 4; ++j) { v[2 * j] = __builtin_nontemporal_load(xr + 128 * j); v[2 * j + 1] = __builtin_nontemporal_load(xr + 128 * j + 1); } }
      for (; m < M; m += NGW) {
          const int mn = m + NGW;
          if (mn < M) { const f32x4* xr = (const f32x4*)(x + (size_t)mn * DM) + 2 * F.lane;
#pragma unroll
              for (int j = 0; j < 4; ++j) { nx[2 * j] = __builtin_nontemporal_load(xr + 128 * j); nx[2 * j + 1] = __builtin_nontemporal_load(xr + 128 * j + 1); } }
          float ss = 0.f;
#pragma unroll
          for (int j = 0; j < 8; ++j) ss += (v[j].x * v[j].x + v[j].y * v[j].y) + (v[j].z * v[j].z + v[j].w * v[j].w);
          const float sx = sqrtf(wave_sum(ss) * (1.0f / DM) + EPS), rstd = 1.0f / sx;
          if (F.lane == 0) SX[m] = sx;
          u32x4* o16 = (u32x4*)(A1 + (size_t)m * DM) + F.lane;
#pragma unroll
          for (int j = 0; j < 4; ++j) { const f32x4 a = v[2 * j], b = v[2 * j + 1];
              u32x4 o; o.x = pk2(a.x * rstd, a.y * rstd); o.y = pk2(a.z * rstd, a.w * rstd); o.z = pk2(b.x * rstd, b.y * rstd); o.w = pk2(b.z * rstd, b.w * rstd); o16[64 * j] = o; }
#pragma unroll
          for (int j = 0; j < 8; ++j) v[j] = nx[j];
      } }
    { const float* p = F.ap->in[1]; bf16* A3 = (bf16*)(((uchar*)F.ap->ws) + WS_A3); const size_t gt = (size_t)F.bid * NTHR + F.tid, NGT = (size_t)F.G * NTHR;
      for (size_t i = gt; i < (size_t)M * DP / 8; i += NGT) { const f32x4 a = __builtin_nontemporal_load((const f32x4*)p + 2 * i), b = __builtin_nontemporal_load((const f32x4*)p + 2 * i + 1); const size_t row = i >> 5, c8 = i & 31;
          u32x4 o; o.x = pk2(a.x, a.y); o.y = pk2(a.z, a.w); o.z = pk2(b.x, b.y); o.w = pk2(b.z, b.w); *(u32x4*)(A3 + row * K3 + DM + c8 * 8) = o; } }
}

__device__ __forceinline__ int sw16(int row) { return (row ^ (row >> 3)) & 15; }
__device__ __forceinline__ int img_off(int row, int chunk) { return row * 256 + ((chunk ^ sw16(row)) << 4); }
__device__ __forceinline__ int img_xt(int b0, int T) { return (b0 ^ (T << 5)) + (T << 12); }
__device__ __forceinline__ void load_img(LAS uchar* img, const bf16* src, int tid) {
#pragma unroll
    for (int i = 0; i < 4; ++i) { const int q = tid + NTHR * i, row = q >> 4, ch = q & 15; const u32x4 v = *(const u32x4*)(src + row * 128 + ch * 8); *(LAS u32x4*)(img + img_off(row, ch)) = v; }
}
#define DPP_F(oldv, srcv, ctrl) __builtin_bit_cast(float, __builtin_amdgcn_update_dpp(__builtin_bit_cast(int, (float)(oldv)), __builtin_bit_cast(int, (float)(srcv)), (ctrl), 0xf, 0xf, false))
constexpr int CW_FLAG = 4096;
constexpr int CW_TMO2 = 6400;
constexpr int CW_PCNT = 6464;
constexpr int CTL_WORDS = 9216;

struct GmlpPref { u32x4 gv[4], uu[4]; f32x4 st[8]; };
__device__ __forceinline__ void gmlp_prefetch(Frame& F, int tid, int c, int h, GmlpPref& R) {
    const int tg4 = tid >> 4, cg = tid & 15, t0 = c * CHK;
    const bf16* Z = (const bf16*)((uchar*)F.ap->ws + WS_Z);
#pragma unroll
    for (int j = 0; j < 4; ++j) { const bf16* zr = Z + (size_t)(t0 + 4 * tg4 + j) * NZO + 128 * h + 8 * cg;
        R.uu[j] = __builtin_nontemporal_load((const u32x4*)zr); R.gv[j] = __builtin_nontemporal_load((const u32x4*)(zr + DG)); }
    if (tid < 128) { const f32x4* vp = (const f32x4*)((uchar*)F.ap->ws + WS_VST) + (size_t)(t0 + tid) * 8;
#pragma unroll
        for (int k = 0; k < 8; ++k) R.st[k] = vp[k]; }
}
__device__ __forceinline__ void gmlp_phase(Frame& F) {
    const int tid0 = F.tid, w = F.wave;
    bf16* Y = (bf16*)((uchar*)F.ap->ws + WS_Y); float* SSA = (float*)((uchar*)F.ap->ws + WS_SSA);
    LAS f32x2* stat = (LAS f32x2*)(F.lds + MISC_STAT); LAS float* part = (LAS float*)(F.lds + MISC_PART);
    int cur = -1; float gsc[8], bsc[8], bsv[8];
    GmlpPref R;
    int u = F.bid;
    if (u < 2048) gmlp_prefetch(F, tid0, u >> 3, u & 7, R);
    for (; u < 2048; u += F.G) { const int h = u & 7, c = u >> 3, t0 = c * CHK;
        int tid = tid0; asm volatile("" : "+v"(tid));
        const int lane = tid & 63, fr = lane & 15, fq = lane >> 4, tg4 = tid >> 4, cg = tid & 15;
        if (h != cur) {
            __syncthreads(); load_img(F.lds + IMG1, (const bf16*)((uchar*)F.ap->ws + WS_WSM) + (size_t)h * 16384, tid); cur = h;
            const float* lg = F.ap->in[4] + 128 * h + 8 * cg; const float* lb = F.ap->in[5] + 128 * h + 8 * cg;
            const f32x4 g0 = *(const f32x4*)lg, g1 = *(const f32x4*)(lg + 4), b0 = *(const f32x4*)lb, b1 = *(const f32x4*)(lb + 4);
            gsc[0] = g0.x; gsc[1] = g0.y; gsc[2] = g0.z; gsc[3] = g0.w; gsc[4] = g1.x; gsc[5] = g1.y; gsc[6] = g1.z; gsc[7] = g1.w;
            bsc[0] = b0.x; bsc[1] = b0.y; bsc[2] = b0.z; bsc[3] = b0.w; bsc[4] = b1.x; bsc[5] = b1.y; bsc[6] = b1.z; bsc[7] = b1.w;
            const float* bs = F.ap->in[7] + h * CHK;
#pragma unroll
            for (int T = 0; T < 8; ++T) bsv[T] = bs[16 * T + fr];
        }
        if (tid < 128) { float s = 0.f, q = 0.f;
#pragma unroll
            for (int k = 0; k < 8; ++k) { s += R.st[k].x + R.st[k].z; q += R.st[k].y + R.st[k].w; }
            const float mean = s * (1.0f / DG); float var = q * (1.0f / DG) - mean * mean; var = var > 0.f ? var : 0.f;
            stat[tid] = (f32x2){mean, __builtin_amdgcn_rsqf(var + EPS)}; }
        __syncthreads();
        {
            float nv[4][8];
#pragma unroll
            for (int j = 0; j < 4; ++j) { const f32x2 st = stat[4 * tg4 + j]; const unsigned wv[4] = {R.gv[j].x, R.gv[j].y, R.gv[j].z, R.gv[j].w};
#pragma unroll
                for (int k = 0; k < 4; ++k) { nv[j][2 * k] = (bflo(wv[k]) - st.x) * st.y * gsc[2 * k] + bsc[2 * k]; nv[j][2 * k + 1] = (bfhi(wv[k]) - st.x) * st.y * gsc[2 * k + 1] + bsc[2 * k + 1]; } }
#pragma unroll
            for (int cc = 0; cc < 8; ++cc) { const int d = 8 * cg + cc; u32x2 o; o.x = pk2(nv[0][cc], nv[1][cc]); o.y = pk2(nv[2][cc], nv[3][cc]);
                *(LAS u32x2*)(F.lds + IMG0 + d * 256 + (((tg4 >> 1) ^ sw16(d)) << 4) + (tg4 & 1) * 8) = o; }
#pragma unroll
            for (int j = 0; j < 4; ++j) *(LAS u32x4*)(F.lds + IMG2 + img_off(4 * tg4 + j, cg)) = R.uu[j];
        }
        __syncthreads();
        { const int un = u + F.G; if (un < 2048) gmlp_prefetch(F, tid, un >> 3, un & 7, R); }
        f32x4 acc[8];
#pragma unroll
        for (int T = 0; T < 8; ++T) acc[T] = (f32x4){0.f, 0.f, 0.f, 0.f};
        bf16x8 af[4];
        int bk[4];
#pragma unroll
        for (int kk = 0; kk < 4; ++kk) bk[kk] = img_off(fr, 4 * kk + fq);
#pragma unroll
        for (int kk = 0; kk < 4; ++kk) af[kk] = *(const LAS bf16x8*)(F.lds + IMG0 + img_xt(bk[kk], w));
#pragma unroll
        for (int T = 0; T < 8; T += 2) {
#pragma unroll
            for (int TT = T; TT < T + 2; ++TT)
#pragma unroll
                for (int kk = 0; kk <= (TT >> 1); ++kk) { const bf16x8 bfr = *(const LAS bf16x8*)(F.lds + IMG1 + img_xt(bk[kk], TT));
                    acc[TT] = __builtin_amdgcn_mfma_f32_16x16x32_bf16(af[kk], bfr, acc[TT], 0, 0, 0); }
            __builtin_amdgcn_sched_barrier(0); }
        u32x2 ow[8];
        const int o0 = img_off(fr, 2 * w + (fq >> 1)) + (fq & 1) * 8;
#pragma unroll
        for (int T = 0; T < 8; ++T) { const int t = 16 * T + fr;
            const int o = img_xt(o0, T);
            const u32x2 uw = *(const LAS u32x2*)(F.lds + IMG2 + o);
            const float y0 = bflo(uw.x) * (acc[T][0] + bsv[T]), y1 = bfhi(uw.x) * (acc[T][1] + bsv[T]);
            const float y2 = bflo(uw.y) * (acc[T][2] + bsv[T]), y3 = bfhi(uw.y) * (acc[T][3] + bsv[T]);
            float q = (y0 * y0 + y1 * y1) + (y2 * y2 + y3 * y3);
            ow[T].x = pk2(y0, y1); ow[T].y = pk2(y2, y3);
            q += __shfl_xor(q, 16); q += __shfl_xor(q, 32);
            if (fq == 0) part[w * 128 + t] = q; }
#pragma unroll
        for (int T = 0; T < 8; T += 2) { u32x2 a = ow[T], b = ow[T + 1];
            { const auto r = __builtin_amdgcn_permlane16_swap(a.x, b.x, false, false); a.x = r[0]; b.x = r[1]; }
            { const auto r = __builtin_amdgcn_permlane16_swap(a.y, b.y, false, false); a.y = r[0]; b.y = r[1]; }
            const int t = 16 * (T + (fq & 1)) + fr;
            *(u32x4*)(Y + (size_t)(t0 + t) * DM + 128 * h + 16 * w + 8 * (fq >> 1)) = (u32x4){a.x, a.y, b.x, b.y}; }
        __syncthreads();
        if (tid < 128) { float s = 0.f;
#pragma unroll
            for (int k = 0; k < 8; ++k) s += part[k * 128 + tid];
            SSA[(size_t)(t0 + tid) * 8 + h] = s; }
    }
    __syncthreads();
}

struct LruPref { u32x4 xb[7], gg[4]; };
constexpr int MISC_CW = MISC + 9728;
__device__ __forceinline__ void lru_prefetch(Frame& F, int tid, int c, int h, LruPref& R) {
    const int tg4 = tid >> 4, cg = tid & 15, t0 = c * CHK;
    typedef const __attribute__((address_space(1))) char* gcp; typedef const __attribute__((address_space(1))) u32x4* gvp;
    gcp zb = (gcp)((uchar*)F.ap->ws + WS_Z) + ((long)(t0 - 3) * NZO + 2 * DG + 128 * h) * 2; asm volatile("" : "+s"(zb));
    const unsigned lo = (unsigned)((4 * tg4) * NZO + 8 * cg) * 2u;
#pragma unroll
    for (int k = 0; k < 7; ++k) R.xb[k] = __builtin_nontemporal_load((gvp)(zb + (lo + (unsigned)(k * NZO * 2))));
#pragma unroll
    for (int j = 0; j < 4; ++j) R.gg[j] = __builtin_nontemporal_load((gvp)(zb + (lo + (unsigned)(((3 + j) * NZO + DG) * 2))));
}
__device__ __forceinline__ void lru_phase(Frame& F) {
    const int tid0 = F.tid, w = F.wave;
    bf16* Y = (bf16*)((uchar*)F.ap->ws + WS_Y); float* SSB = (float*)((uchar*)F.ap->ws + WS_SSB);
    unsigned long long* AGG = (unsigned long long*)((uchar*)F.ap->ws + WS_AGG);
    unsigned* ctl = (unsigned*)F.ap->ws;
    LAS float* part = (LAS float*)(F.lds + MISC_PART); LAS f32x2* cpart = (LAS f32x2*)(F.lds + MISC_CPART);
    int cur = -1;
    LruPref R;
    unsigned pk[8][4];
    int pc = -1, ph = 0;
    int u = F.bid;
    if (u < 2048) lru_prefetch(F, tid0, u >> 3, u & 7, R);
    for (;; u += F.G) {
        const bool live = u < 2048;
        if (!live && pc < 0) break;
        const int h = u & 7, c = u >> 3, t0 = c * CHK, tseq0 = t0 & (SEQ - 1);
        int tid = tid0; asm volatile("" : "+v"(tid));
        const int lane = tid & 63, fr = lane & 15, fq = lane >> 4, tg4 = tid >> 4, cg = tid & 15;
        const int chl = 16 * w + 4 * fq;
        const int pcs = pc & 63, pcb0 = pc - pcs;
        asm volatile("" : "+v"(R.xb[0]), "+v"(R.xb[1]), "+v"(R.xb[2]), "+v"(R.xb[3]), "+v"(R.xb[4]), "+v"(R.xb[5]), "+v"(R.xb[6]), "+v"(R.gg[0]), "+v"(R.gg[1]), "+v"(R.gg[2]), "+v"(R.gg[3]));
        f32x4 pba, pbx, plm;
        if (live) {
            if (h != cur) {
                __syncthreads(); load_img(F.lds + IMG1, (const bf16*)((uchar*)F.ap->ws + WS_WA) + (size_t)h * 16384, tid); load_img(F.lds + IMG2, (const bf16*)((uchar*)F.ap->ws + WS_WX) + (size_t)h * 16384, tid); cur = h;
                for (int i = tid; i < 640; i += NTHR) { const int k = i >> 7, chn = i & 127; ((LAS float*)(F.lds + MISC_CW))[i] = (k < 4) ? F.ap->in[8][k * DL + 128 * h + chn] : F.ap->in[9][128 * h + chn]; }
                __syncthreads(); }
            pba = *(const f32x4*)(F.ap->in[11] + 128 * h + chl); pbx = *(const f32x4*)(F.ap->in[13] + 128 * h + chl); plm = *(const f32x4*)((const float*)((uchar*)F.ap->ws + WS_SPT) + 128 * h + chl);
        }
        unsigned long long ab[16]; int nv = 0;
        asm volatile("" ::: "memory");
        if (pc >= 0) {
            const int ch = tid & 127, pt = __builtin_amdgcn_readfirstlane(tid >> 7);
            nv = pcs - 16 * pt; nv = nv < 0 ? 0 : (nv > 16 ? 16 : nv);
            const unsigned long long* ab0 = AGG + (size_t)(pcb0 + 16 * pt) * DL + 128 * ph + ch;
#pragma unroll
            for (int i = 0; i < 16; ++i) if (__builtin_expect(i < nv, 1)) ab[i] = __hip_atomic_load(ab0 + (size_t)i * DL, __ATOMIC_RELAXED, __HIP_MEMORY_SCOPE_AGENT);
        }
        asm volatile("" ::: "memory");
        if (live) {
            {
                float xc[4][8], wk[4][8], cbv[8];
                { const LAS f32x4* cwt = (const LAS f32x4*)(F.lds + MISC_CW) + 2 * cg;
#pragma unroll
                  for (int k = 0; k < 4; ++k) { const f32x4 a = cwt[k * 32], b = cwt[k * 32 + 1]; wk[k][0] = a.x; wk[k][1] = a.y; wk[k][2] = a.z; wk[k][3] = a.w; wk[k][4] = b.x; wk[k][5] = b.y; wk[k][6] = b.z; wk[k][7] = b.w; }
                  const f32x4 a = cwt[4 * 32], b = cwt[4 * 32 + 1]; cbv[0] = a.x; cbv[1] = a.y; cbv[2] = a.z; cbv[3] = a.w; cbv[4] = b.x; cbv[5] = b.y; cbv[6] = b.z; cbv[7] = b.w; }
#pragma unroll
                for (int j = 0; j < 4; ++j)
#pragma unroll
                    for (int e = 0; e < 8; ++e) xc[j][e] = cbv[e];
                if (tseq0 == 0) {
#pragma unroll
                    for (int k = 0; k < 3; ++k) if (4 * tg4 - 3 + k < 0) R.xb[k] = (u32x4){0u, 0u, 0u, 0u}; }
#pragma unroll
                for (int k = 0; k < 7; ++k) { const unsigned wv[4] = {R.xb[k].x, R.xb[k].y, R.xb[k].z, R.xb[k].w};
#pragma unroll
                    for (int e2 = 0; e2 < 4; ++e2) { const float lo_ = bflo(wv[e2]), hi_ = bfhi(wv[e2]);
#pragma unroll
                        for (int j = 0; j < 4; ++j) { const int kw = k - j; if (kw >= 0 && kw < 4) { xc[j][2 * e2] += wk[kw][2 * e2] * lo_; xc[j][2 * e2 + 1] += wk[kw][2 * e2 + 1] * hi_; } } } }
#pragma unroll
                for (int j = 0; j < 4; ++j) { u32x4 o; o.x = pk2(xc[j][0], xc[j][1]); o.y = pk2(xc[j][2], xc[j][3]); o.z = pk2(xc[j][4], xc[j][5]); o.w = pk2(xc[j][6], xc[j][7]);
                    *(LAS u32x4*)(F.lds + IMG0 + img_off(4 * tg4 + j, cg)) = o;
                    *(LAS u32x4*)(F.lds + IMG3 + img_off(4 * tg4 + j, cg)) = R.gg[j]; }
            }
        }
        asm volatile("" : "+v"(pba), "+v"(pbx), "+v"(plm));
        if (pc >= 0) {
            { const int ch = tid & 127, pt = __builtin_amdgcn_readfirstlane(tid >> 7);
              const unsigned long long* ab0 = AGG + (size_t)(pcb0 + 16 * pt) * DL + 128 * ph + ch;
              for (unsigned spins = 0;; ++spins) {
                  bool ok = true;
#pragma unroll
                  for (int i = 0; i < 16; ++i) if (i < nv) ok = ok && ((unsigned)ab[i] != 0u);
                  if (__all(ok)) break;
                  if (spins > (1u << 17)) { if (lane == 0) __hip_atomic_store(ctl + CW_TMO2, 1u, __ATOMIC_RELAXED, __HIP_MEMORY_SCOPE_AGENT); break; }
                  __builtin_amdgcn_s_sleep(1);
#pragma unroll
                  for (int i = 0; i < 16; ++i) if (i < nv) { if ((unsigned)ab[i] == 0u) ab[i] = __hip_atomic_load(ab0 + (size_t)i * DL, __ATOMIC_RELAXED, __HIP_MEMORY_SCOPE_AGENT); }
              }
              float A = 1.f, B = 0.f;
#pragma unroll
              for (int i = 0; i < 16; ++i) if (i < nv) { const float ax = __uint_as_float((unsigned)ab[i]), bxv = __uint_as_float((unsigned)(ab[i] >> 32)); B = ax * B + bxv; A = ax * A; }
              cpart[pt * 128 + ch] = (f32x2){A, B}; }
            __syncthreads();
            float H[4];
#pragma unroll
            for (int r = 0; r < 4; ++r) { float hh = 0.f;
#pragma unroll
                for (int p = 0; p < 4; ++p) { const f32x2 abp = cpart[p * 128 + chl + r]; hh = abp.x * hh + abp.y; }
                H[r] = hh; }
            const int pt0 = pc * CHK;
            u32x2 ow[8];
#pragma unroll
            for (int T = 0; T < 8; ++T) { const int t = 16 * T + fr;
                const float y0 = bflo(pk[T][0]) * H[0] + bfhi(pk[T][0]), y1 = bflo(pk[T][1]) * H[1] + bfhi(pk[T][1]);
                const float y2 = bflo(pk[T][2]) * H[2] + bfhi(pk[T][2]), y3 = bflo(pk[T][3]) * H[3] + bfhi(pk[T][3]);
                float q = (y0 * y0 + y1 * y1) + (y2 * y2 + y3 * y3);
                ow[T].x = pk2(y0, y1); ow[T].y = pk2(y2, y3);
                q += __shfl_xor(q, 16); q += __shfl_xor(q, 32);
                if (fq == 0) part[w * 128 + t] = q; }
#pragma unroll
            for (int T = 0; T < 8; T += 2) { u32x2 a = ow[T], b = ow[T + 1];
                { const auto r = __builtin_amdgcn_permlane16_swap(a.x, b.x, false, false); a.x = r[0]; b.x = r[1]; }
                { const auto r = __builtin_amdgcn_permlane16_swap(a.y, b.y, false, false); a.y = r[0]; b.y = r[1]; }
                const int t = 16 * (T + (fq & 1)) + fr;
                *(u32x4*)(Y + (size_t)(pt0 + t) * DM + DG + 128 * ph + 16 * w + 8 * (fq >> 1)) = (u32x4){a.x, a.y, b.x, b.y}; }
        }
        __syncthreads();
        if (pc >= 0) { if (tid < 128) { float s = 0.f;
#pragma unroll
            for (int k = 0; k < 8; ++k) s += part[k * 128 + tid];
            SSB[(size_t)(pc * CHK + tid) * 8 + ph] = s; } }
        pc = -1;
        if (!live) break;
        { const int un = u + F.G; if (un < 2048) lru_prefetch(F, tid, un >> 3, un & 7, R); }
        f32x4 accA[8], accX[8];
#pragma unroll
        for (int T = 0; T < 8; ++T) { accA[T] = (f32x4){0.f, 0.f, 0.f, 0.f}; accX[T] = (f32x4){0.f, 0.f, 0.f, 0.f}; }
        {
            bf16x8 afa[4], afx[4], b0[4], b1[4];
            int bk[4];
#pragma unroll
            for (int kk = 0; kk < 4; ++kk) bk[kk] = img_off(fr, 4 * kk + fq);
#pragma unroll
            for (int kk = 0; kk < 4; ++kk) { afa[kk] = *(const LAS bf16x8*)(F.lds + IMG1 + img_xt(bk[kk], w)); afx[kk] = *(const LAS bf16x8*)(F.lds + IMG2 + img_xt(bk[kk], w)); }
#define LRU_LDB(dst, T) do { _Pragma("unroll") for (int kk = 0; kk < 4; ++kk) dst[kk] = *(const LAS bf16x8*)(F.lds + IMG0 + img_xt(bk[kk], (T))); } while (0)
#define LRU_MMA(src, T) do { _Pragma("unroll") for (int kk = 0; kk < 4; ++kk) { accA[T] = __builtin_amdgcn_mfma_f32_16x16x32_bf16(afa[kk], src[kk], accA[T], 0, 0, 0); \
                accX[T] = __builtin_amdgcn_mfma_f32_16x16x32_bf16(afx[kk], src[kk], accX[T], 0, 0, 0); } } while (0)
            LRU_LDB(b0, 0);
#pragma unroll
            for (int T = 0; T < 8; T += 2) {
                LRU_LDB(b1, T + 1); __builtin_amdgcn_sched_barrier(0); LRU_MMA(b0, T); __builtin_amdgcn_sched_barrier(0);
                if (T + 2 < 8) LRU_LDB(b0, T + 2);
                __builtin_amdgcn_sched_barrier(0); LRU_MMA(b1, T + 1); __builtin_amdgcn_sched_barrier(0); }
#undef LRU_LDB
#undef LRU_MMA
        }
        {
            float P[4], Q[4], ba[4], bx[4], sp[4];
            { const float av[4] = {pba.x, pba.y, pba.z, pba.w}, bv[4] = {pbx.x, pbx.y, pbx.z, pbx.w}, lmv[4] = {plm.x, plm.y, plm.z, plm.w};
#pragma unroll
              for (int r = 0; r < 4; ++r) { sp[r] = lmv[r];
                  ba[r] = av[r] * -1.44269504f; bx[r] = bv[r] * -1.44269504f; P[r] = 1.f; Q[r] = 0.f; } }
            const int o0 = img_off(fr, 2 * w + (fq >> 1)) + (fq & 1) * 8;
#pragma unroll
            for (int T = 0; T < 8; ++T) { const int t = 16 * T + fr; const bool first = (tseq0 + t) == 0;
                const int o = img_xt(o0, T);
                const u32x2 xw = *(const LAS u32x2*)(F.lds + IMG0 + o), gw = *(const LAS u32x2*)(F.lds + IMG3 + o);
                const f32x2 g01 = (f32x2){bflo(gw.x), bfhi(gw.x)}, g23 = (f32x2){bflo(gw.y), bfhi(gw.y)};
                const float xcv[4] = {bflo(xw.x), bfhi(xw.x), bflo(xw.y), bfhi(xw.y)}, gvv[4] = {g01.x, g01.y, g23.x, g23.y};
                float A[4], B[4], At[4], Bt[4];
                {
#pragma unroll
                    for (int hp = 0; hp < 2; ++hp) { const int r0 = 2 * hp, r1 = 2 * hp + 1;
                        const f32x2 ta = (f32x2){accA[T][r0], accA[T][r1]} * (-1.44269504f) + (f32x2){ba[r0], ba[r1]}, tx = (f32x2){accX[T][r0], accX[T][r1]} * (-1.44269504f) + (f32x2){bx[r0], bx[r1]};
                        f32x2 ea, ex; ea.x = __builtin_amdgcn_exp2f(ta.x); ea.y = __builtin_amdgcn_exp2f(ta.y); ex.x = __builtin_amdgcn_exp2f(tx.x); ex.y = __builtin_amdgcn_exp2f(tx.y);
                        const f32x2 da = ea + 1.0f, dx = ex + 1.0f;
                        f32x2 rg, ig; rg.x = __builtin_amdgcn_rcpf(da.x); rg.y = __builtin_amdgcn_rcpf(da.y); ig.x = __builtin_amdgcn_rcpf(dx.x); ig.y = __builtin_amdgcn_rcpf(dx.y);
                        const f32x2 la = (f32x2){sp[r0], sp[r1]} * rg;
                        f32x2 a; a.x = __builtin_amdgcn_exp2f(la.x); a.y = __builtin_amdgcn_exp2f(la.y);
                        const f32x2 m2 = 1.0f - a * a;
                        f32x2 mult; mult.x = __builtin_amdgcn_sqrtf(m2.x); mult.y = __builtin_amdgcn_sqrtf(m2.y);
                        if (first) mult = (f32x2){1.0f, 1.0f};
                        const f32x2 b = mult * (ig * (f32x2){xcv[r0], xcv[r1]});
                        A[r0] = a.x; A[r1] = a.y; B[r0] = b.x; B[r1] = b.y; }
                }
#define LRU_SCAN_STEP(K) \
                    "v_fmac_f32_dpp %4, %4, %0 row_shr:" #K " row_mask:0xf bank_mask:0xf\n\t" "v_fmac_f32_dpp %5, %5, %1 row_shr:" #K " row_mask:0xf bank_mask:0xf\n\t" \
                    "v_fmac_f32_dpp %6, %6, %2 row_shr:" #K " row_mask:0xf bank_mask:0xf\n\t" "v_fmac_f32_dpp %7, %7, %3 row_shr:" #K " row_mask:0xf bank_mask:0xf\n\t" \
                    "v_mul_f32_dpp %0, %0, %0 row_shr:" #K " row_mask:0xf bank_mask:0xf\n\t" "v_mul_f32_dpp %1, %1, %1 row_shr:" #K " row_mask:0xf bank_mask:0xf\n\t" \
                    "v_mul_f32_dpp %2, %2, %2 row_shr:" #K " row_mask:0xf bank_mask:0xf\n\t" "v_mul_f32_dpp %3, %3, %3 row_shr:" #K " row_mask:0xf bank_mask:0xf\n\t"
                asm volatile("s_nop 1\n\t"
                    LRU_SCAN_STEP(1) LRU_SCAN_STEP(2) LRU_SCAN_STEP(4) LRU_SCAN_STEP(8)
                    "v_mov_b32_dpp %8, %0 row_newbcast:15 row_mask:0xf bank_mask:0xf\n\t" "v_mov_b32_dpp %9, %1 row_newbcast:15 row_mask:0xf bank_mask:0xf\n\t"
                    "v_mov_b32_dpp %10, %2 row_newbcast:15 row_mask:0xf bank_mask:0xf\n\t" "v_mov_b32_dpp %11, %3 row_newbcast:15 row_mask:0xf bank_mask:0xf\n\t"
                    "v_mov_b32_dpp %12, %4 row_newbcast:15 row_mask:0xf bank_mask:0xf\n\t" "v_mov_b32_dpp %13, %5 row_newbcast:15 row_mask:0xf bank_mask:0xf\n\t"
                    "v_mov_b32_dpp %14, %6 row_newbcast:15 row_mask:0xf bank_mask:0xf\n\t" "v_mov_b32_dpp %15, %7 row_newbcast:15 row_mask:0xf bank_mask:0xf\n\t"
                    "s_nop 0"
                    : "+v"(A[0]), "+v"(A[1]), "+v"(A[2]), "+v"(A[3]), "+v"(B[0]), "+v"(B[1]), "+v"(B[2]), "+v"(B[3]),
                      "=&v"(At[0]), "=&v"(At[1]), "=&v"(At[2]), "=&v"(At[3]), "=&v"(Bt[0]), "=&v"(Bt[1]), "=&v"(Bt[2]), "=&v"(Bt[3]));
#undef LRU_SCAN_STEP
#pragma unroll
                for (int hp = 0; hp < 2; ++hp) { const int r0 = 2 * hp, r1 = 2 * hp + 1;
                    const f32x2 Av = (f32x2){A[r0], A[r1]}, Bv = (f32x2){B[r0], B[r1]}, Pv = (f32x2){P[r0], P[r1]}, Qv = (f32x2){Q[r0], Q[r1]}, gv2 = (f32x2){gvv[r0], gvv[r1]}, Atv = (f32x2){At[r0], At[r1]}, Btv = (f32x2){Bt[r0], Bt[r1]};
                    const f32x2 acc_ = Av * Pv * gv2, bcc_ = (Av * Qv + Bv) * gv2;
                    pk[T][r0] = pk2(acc_.x, bcc_.x); pk[T][r1] = pk2(acc_.y, bcc_.y);
                    const f32x2 Qn = Atv * Qv + Btv, Pn = Atv * Pv; Q[r0] = Qn.x; Q[r1] = Qn.y; P[r0] = Pn.x; P[r1] = Pn.y; }
                if (T & 1) __builtin_amdgcn_sched_barrier(0);
            }
            if (fr == 0) {
#pragma unroll
                for (int r = 0; r < 4; ++r) __hip_atomic_store(AGG + (size_t)c * DL + 128 * h + chl + r, ((unsigned long long)__float_as_uint(Q[r]) << 32) | __float_as_uint(fmaxf(P[r], 1e-37f)), __ATOMIC_RELAXED, __HIP_MEMORY_SCOPE_AGENT); }
        }
        __syncthreads();
        pc = c; ph = h;
    }
    __syncthreads();
}

#define XB_TMO      128
#define XB_XCNT(j)  (256  + 64 * (j))
#define XB_XSUB(j)  (1280 + 64 * (j))
#define XB_XGEN(j)  (2304 + 64 * (j))
#define XB_TOP      3328
#define XB_TOPGEN   3392
#define XCD_BAR_WORDS 3456
#define XB_SPIN_CAP (1u << 18)
constexpr int LDS_BARST = MISC + 15 * 1024;
__device__ __forceinline__ unsigned xb_ld(unsigned* p)              { return __hip_atomic_load(p, __ATOMIC_RELAXED, __HIP_MEMORY_SCOPE_AGENT); }
__device__ __forceinline__ unsigned xb_add(unsigned* p, unsigned v) { return __hip_atomic_fetch_add(p, v, __ATOMIC_RELAXED, __HIP_MEMORY_SCOPE_AGENT); }
__device__ __forceinline__ unsigned xb_xcc_id() { return (unsigned)__builtin_amdgcn_s_getreg((3 << 11) | 20) & 0xFu; }
#define XB_SPIN(cond, bar) do { unsigned _sp = 0; while (cond) { __builtin_amdgcn_s_sleep(1); \
    if ((++_sp & 255u) == 0u) { if (xb_ld(&(bar)[XB_TMO])) break; if (_sp > XB_SPIN_CAP) { atomicAdd(&(bar)[XB_TMO], 1u); break; } } } } while (0)
__device__ __forceinline__ void xcd_barrier_complete(unsigned* bar, unsigned x, unsigned& nloc, unsigned& nx) {
    const unsigned G = gridDim.x;
    unsigned sum, cnt, mine, sp = 0u;
    for (;;) {
        sum = 0u; cnt = 0u; mine = 0u;
#pragma unroll
        for (unsigned j = 0; j < 16; ++j) { const unsigned c = xb_ld(&bar[XB_XCNT(j)]); sum += c; cnt += (c > 0u) ? 1u : 0u; mine = (j == x) ? c : mine; }
        if (sum == G) break;
        __builtin_amdgcn_s_sleep(1);
        if ((++sp & 255u) == 0u) { if (xb_ld(&bar[XB_TMO])) break; if (sp > XB_SPIN_CAP) { atomicAdd(&bar[XB_TMO], 1u); break; } }
    }
    nloc = mine > 0u ? mine : 1u; nx = cnt > 0u ? cnt : 1u;
}
__device__ __forceinline__ void xcd_barrier(unsigned* bar, volatile LAS unsigned* st, int tid) {
    asm volatile("s_waitcnt vmcnt(0)" ::: "memory");
    __syncthreads();
    if (tid == 0) {
        const unsigned x = xb_xcc_id();
        __builtin_amdgcn_s_waitcnt(0);
        unsigned nloc = st[0], nx = st[1];
        if (nloc == 0u) { xcd_barrier_complete(bar, x, nloc, nx); st[0] = nloc; st[1] = nx; }
        const unsigned old = xb_add(&bar[XB_XSUB(x)], 1u);
        const unsigned gen = old / nloc;
        if (old + 1u == (gen + 1u) * nloc) {
            __builtin_amdgcn_fence(__ATOMIC_RELEASE, "agent");
            asm volatile("s_waitcnt vmcnt(0)" ::: "memory");
            const unsigned og = xb_add(&bar[XB_TOP], 1u);
            const unsigned tg = og / nx;
            if (og + 1u == (tg + 1u) * nx) xb_add(&bar[XB_TOPGEN], 1u);
            else XB_SPIN(xb_ld(&bar[XB_TOPGEN]) == tg, bar);
            __builtin_amdgcn_fence(__ATOMIC_ACQUIRE, "agent");
            xb_add(&bar[XB_XGEN(x)], 1u);
            asm volatile("s_waitcnt vmcnt(0)" ::: "memory");
        } else {
            XB_SPIN(xb_ld(&bar[XB_XGEN(x)]) == gen, bar);
            __builtin_amdgcn_fence(__ATOMIC_ACQUIRE, "agent");
            asm volatile("s_waitcnt vmcnt(0)" ::: "memory");
        }
    }
    __syncthreads();
}

__global__ void __launch_bounds__(NTHR, 2) mk_fwd(Args args_unused) {
    extern __shared__ __attribute__((aligned(16))) unsigned char lds_raw[];
    Frame F;
    F.lds = (LAS uchar*)lds_raw; F.G = gridDim.x; F.bid = blockIdx.x; F.wv = __builtin_amdgcn_readfirstlane((int)threadIdx.x >> 6);
    PHASE_BEGIN(F);
    const int lo = F.ap->ph_lo, hi = F.ap->ph_hi;
#define IN(k) (lo <= (k) && (k) < hi)
#if MK_N_LAUNCHES == 1
#define SEAM(k) do { if (IN(k) && IN((k) + 1)) { PHASE_BEGIN(F); xcd_barrier((unsigned*)F.ap->ws, (volatile LAS unsigned*)(F.lds + LDS_BARST), F.tid); } } while (0)
#else
#define SEAM(k) do { } while (0)
#endif
#define WSB(off) ((bf16*)((uchar*)F.ap->ws + (off)))
#define WSF(off) ((float*)((uchar*)F.ap->ws + (off)))

    if (F.tid < 2) ((volatile LAS unsigned*)(F.lds + LDS_BARST))[F.tid] = 0u;
#if MK_N_LAUNCHES == 1 && !MK_CG_SYNC
    if (F.tid == 0) (void)xb_add((unsigned*)F.ap->ws + XB_XCNT(xb_xcc_id()), 1u);
#endif
    if (IN(0)) {
#if MK_N_LAUNCHES == 1 && MK_CG_SYNC
        if (F.bid == 0) { unsigned* bw = (unsigned*)F.ap->ws; for (int i = F.tid; i < CTL_WORDS; i += NTHR) __hip_atomic_store(bw + i, 0u, __ATOMIC_RELAXED, __HIP_MEMORY_SCOPE_AGENT); }
#endif
        REPS(0) { p0_prologue(F); __syncthreads(); } }
#if MK_N_LAUNCHES == 1 && MK_CG_SYNC
    cg::this_grid().sync();
    PHASE_BEGIN(F);
    if (F.tid == 0) (void)xb_add((unsigned*)F.ap->ws + XB_XCNT(xb_xcc_id()), 1u);
#else
    SEAM(0);
#endif
    if (IN(1)) REPS(1) {
        PHASE_BEGIN(F);
#if PROBE_KLOOP
        { pg8::Gemm g{WSB(WS_A1), WSB(WS_WIN), M, NZ, DM}; pg8::RepOrder S; S.init(M, NZ, F.G, F.bid);
          pg8::EpiZ E{WSB(WS_Z), NZO, (pg8::f32x2*)WSF(WS_VST), 0};
          pg8::gemm_phase<pg8::EpiZ, pg8::RepOrder, true, true>(F.lds, g, S, E, F.tid); }
#else
        { pg8::Gemm g{WSB(WS_A1), WSB(WS_WIN), M, NZ, DM}; pg8::StaticOrder S; S.init(M, NZ, F.G, F.bid);
          pg8::EpiZ E{WSB(WS_Z), NZO, (pg8::f32x2*)WSF(WS_VST), 0};
          pg8::gemm_phase<pg8::EpiZ, pg8::StaticOrder, true, true>(F.lds, g, S, E, F.tid); }
#endif
    }
    SEAM(1);
    if (IN(2)) {
        if ((F.bid & 7) < 4) { REPS(4) { PHASE_BEGIN(F); lru_phase(F); } REPS(2) { PHASE_BEGIN(F); gmlp_phase(F); } }
        else                 { REPS(2) { PHASE_BEGIN(F); gmlp_phase(F); } REPS(4) { PHASE_BEGIN(F); lru_phase(F); } }
    }
    SEAM(2);
    if (IN(5)) REPS(5) {
        PHASE_BEGIN(F);
        pg8::PanelOrder S; S.init(M, DM, F.G, F.bid);
        {
            const float* SSA = WSF(WS_SSA); const float* SSB = WSF(WS_SSB); LAS f32x2* rr = (LAS f32x2*)(F.lds + MISC);
            f32x4 a0[2], a1[2], b0[2], b1[2]; bool ok[2];
#pragma unroll
            for (int k = 0; k < 2; ++k) { pg8::Unit u; ok[k] = S.next((F.tid >> 8) + 2 * k, u); const size_t row = (size_t)(ok[k] ? u.pm : 0) * 256 + (F.tid & 255);
                a0[k] = *(const f32x4*)(SSA + row * 8); a1[k] = *(const f32x4*)(SSA + row * 8 + 4); b0[k] = *(const f32x4*)(SSB + row * 8); b1[k] = *(const f32x4*)(SSB + row * 8 + 4); }
#pragma unroll
            for (int k = 0; k < 2; ++k) {
                const float ra = 1.0f / sqrtf(((a0[k].x + a0[k].y) + (a0[k].z + a0[k].w) + (a1[k].x + a1[k].y) + (a1[k].z + a1[k].w)) * (1.0f / DG) + EPS);
                const float rb = 1.0f / sqrtf(((b0[k].x + b0[k].y) + (b0[k].z + b0[k].w) + (b1[k].x + b1[k].y) + (b1[k].z + b1[k].w)) * (1.0f / DL) + EPS);
                if (ok[k]) rr[((F.tid >> 8) + 2 * k) * 256 + (F.tid & 255)] = (f32x2){ra / rb, rb}; }
            __syncthreads();
        }
        pg8::Gemm g{WSB(WS_Y), WSB(WS_WOUT), M, DM, DM};
        pg8::EpiH E(WSB(WS_A3), K3, WSB(WS_A1), DM, WSF(WS_SX), F.ap->in[18], (const LAS pg8::f32x2*)(F.lds + MISC), (LAS float*)(F.lds + MISC + 8192), (LAS float*)(F.lds + MISC + 12288),
                    WSF(WS_SSO), (unsigned*)F.ap->ws + CW_PCNT, (unsigned*)F.ap->ws + CW_TMO2);
        pg8::gemm_phase<pg8::EpiH, pg8::PanelOrder, true, true>(F.lds, g, S, E, F.tid);
        __syncthreads();
    }
    SEAM(5);
    if (IN(7)) REPS(7) {
        PHASE_BEGIN(F);
#if SKEW7_TICKS > 0
        {
            const unsigned long long t0 = __builtin_amdgcn_s_memrealtime(); const unsigned long long dl = (unsigned long long)(F.bid & 7) * SKEW7_TICKS;
            while (__builtin_amdgcn_s_memrealtime() - t0 < dl) __builtin_amdgcn_s_sleep(8);
        }
#endif
        pg8::Gemm g{WSB(WS_A3), WSB(WS_B3), M, DM, K3}; pg8::StaticOrder S; S.init(M, DM, F.G, F.bid);
        pg8::EpiOut E((float*)F.ap->out, WSB(WS_A3), DM, K3);
        pg8::gemm_phase<pg8::EpiOut, pg8::StaticOrder, true, true>(F.lds, g, S, E, F.tid);
    }
#undef IN
#undef SEAM
}

extern "C" void kernel_launch(void* const* d_in, const int* in_sizes, int n_in, void* d_out, int out_size, void* d_ws, size_t ws_size, hipStream_t stream) {
    static int grid = 0;
    if (grid == 0) {
        if (n_in != 21 || in_sizes[0] != M * DM || out_size != M * DM || ws_size < WS_END) { fprintf(stderr, "kernel_launch: unexpected problem (n_in %d, in0 %d, out %d, ws %zu); nothing launched\n", n_in, n_in > 0 ? in_sizes[0] : -1, out_size, ws_size); grid = -1; return; }
        int dev = 0, cus = 0, per_cu = 0;
        if (hipGetDevice(&dev) != hipSuccess || hipDeviceGetAttribute(&cus, hipDeviceAttributeMultiprocessorCount, dev) != hipSuccess) { fprintf(stderr, "kernel_launch: device query failed\n"); grid = -1; return; }
        if (hipFuncSetAttribute((const void*)mk_fwd, hipFuncAttributeMaxDynamicSharedMemorySize, LDS_BYTES) != hipSuccess) { fprintf(stderr, "kernel_launch: hipFuncSetAttribute failed\n"); grid = -1; return; }
        if (hipOccupancyMaxActiveBlocksPerMultiprocessor(&per_cu, (const void*)mk_fwd, NTHR, LDS_BYTES) != hipSuccess || per_cu < 1) { fprintf(stderr, "kernel_launch: occupancy query says %d blocks per CU\n", per_cu); per_cu = 1; }
        (void)hipGetLastError();
        grid = cus * (per_cu < 1 ? 1 : per_cu);
    }
    if (grid < 0) return;
    Args a{};
    for (int i = 0; i < 21; ++i) a.in[i] = (const float*)d_in[i];
    a.out = (float*)d_out; a.ws = (unsigned char*)d_ws;
#if MK_N_LAUNCHES == 1
    a.ph_lo = 0; a.ph_hi = N_PHASES;
#if MK_CG_SYNC
    void* kargs[] = {&a};
    hipError_t e = hipLaunchCooperativeKernel((const void*)mk_fwd, dim3(grid), dim3(NTHR), kargs, LDS_BYTES, stream);
    if (e != hipSuccess) fprintf(stderr, "kernel_launch: cooperative launch failed: %s (grid %d)\n", hipGetErrorString(e), grid);
#else
    if (hipMemsetAsync(d_ws, 0, CTL_WORDS * 4, stream) != hipSuccess) { fprintf(stderr, "kernel_launch: hipMemsetAsync of the control words failed; nothing launched\n"); return; }
    hipLaunchKernelGGL(mk_fwd, dim3(grid), dim3(NTHR), LDS_BYTES, stream, a);
    { const hipError_t le = hipPeekAtLastError(); if (le != hipSuccess) fprintf(stderr, "kernel_launch: launch failed: %s (grid %d)\n", hipGetErrorName(le), grid); }
#endif
#else
    for (int li = 0; li < N_PHASES; ++li) { a.ph_lo = li; a.ph_hi = li + 1;
        hipLaunchKernelGGL(mk_fwd, dim3(grid), dim3(NTHR), LDS_BYTES, stream, a);
        const hipError_t le = hipPeekAtLastError(); if (le != hipSuccess) { fprintf(stderr, "kernel_launch: launch %d failed: %s\n", li, hipGetErrorName(le)); break; } }
#endif
}
```

```cpp
#define MK_N_LAUNCHES 1
#include <hip/hip_runtime.h>
#include <hip/hip_cooperative_groups.h>
#include <cstdio>
#include <cstdint>
namespace cg = cooperative_groups;
namespace pg8 {
#define PG8_LAS __attribute__((address_space(3)))
typedef unsigned short bf16_t;
typedef short bf16x8 __attribute__((ext_vector_type(8)));
typedef float f32x4 __attribute__((ext_vector_type(4)));
typedef unsigned u32x4 __attribute__((ext_vector_type(4)));
constexpr int BM = 256, BK = 64, HALF = 128, HTB = HALF * BK * 2  , STAGE_BYTES = 8 * HTB, NXCD = 8, WGM = 8;

__host__ __device__ __forceinline__ int lds_byte(int r, int c) { const int st = (r >> 4) * 2 + (c >> 5), rr = r & 15, cc = c & 31, ob = rr * 64 + cc * 2; return st * 1024 + (ob ^ (((ob >> 9) & 1) << 5)); }
__host__ __device__ __forceinline__ void stage_rc(int b, int& R, int& C) { const int st = b / 1024, sb = b % 1024, swz = sb ^ (((sb >> 9) & 1) << 5); R = (st >> 1) * 16 + swz / 64; C = (st & 1) * 32 + (swz % 64) / 2; }
__host__ __device__ __forceinline__ int perm32(int rho) { const int n = rho >> 4, i = rho & 15; return 8 * (i >> 2) + 4 * n + (i & 3); }

struct Unit { int pm, pn; };
struct Gemm { const bf16_t* A; const bf16_t* Bt; int M, N, K; };

struct StaticOrder {
    int nM, nN, nwg, G, c;
    __host__ __device__ void init(int M, int N, int G_, int c_) { nM = M / BM; nN = N / BM; nwg = nM * nN; G = G_; c = c_; }
    __host__ __device__ bool next(int i, Unit& u) const {
        const long L = (long)i * G + c; if (L >= nwg) return false;
        int wgid = (int)L; { const int q = nwg / NXCD, r = nwg % NXCD, xcd = wgid % NXCD, off = wgid / NXCD; wgid = (xcd < r ? xcd * (q + 1) : r * (q + 1) + (xcd - r) * q) + off; }
        const int nig = WGM * nN, gid = wgid / nig, fm = gid * WGM, gsz = (nM - fm) < WGM ? (nM - fm) : WGM;
        u.pm = fm + ((wgid % nig) % gsz); u.pn = (wgid % nig) / gsz; return true;
    }
    __device__ __forceinline__ void a_ready(const Unit&) const {}
    __device__ __forceinline__ void done(const Unit&) const {}
};

__device__ __forceinline__ unsigned cvt_pk_bf16(float lo, float hi) { unsigned r; asm volatile("v_cvt_pk_bf16_f32 %0, %1, %2" : "=v"(r) : "v"(lo), "v"(hi)); return r; }
typedef float f32x2 __attribute__((ext_vector_type(2)));
typedef unsigned u32x2 __attribute__((ext_vector_type(2)));
__device__ __forceinline__ float fast_sigmoid(float x) { return __builtin_amdgcn_rcpf(1.0f + __expf(-x)); }

__device__ __forceinline__ f32x2 gelu2(f32x2 x) { const f32x2 t = x * x; const f32x2 uu = t * (-0.10294323f) + (-2.30220819f); const f32x2 wv = x * uu;
    f32x2 ev; ev.x = __builtin_amdgcn_exp2f(wv.x); ev.y = __builtin_amdgcn_exp2f(wv.y); const f32x2 d = ev + 1.0f; f32x2 r; r.x = __builtin_amdgcn_rcpf(d.x); r.y = __builtin_amdgcn_rcpf(d.y); return x * r; }
__device__ __forceinline__ f32x2 gelu_silu2(f32x2 u, f32x2 g) { const f32x2 t = u * u; const f32x2 uu = t * (-0.10294323f) + (-2.30220819f); const f32x2 wu = u * uu, wg = g * (-1.44269504f);
    f32x2 eu, eg; eu.x = __builtin_amdgcn_exp2f(wu.x); eu.y = __builtin_amdgcn_exp2f(wu.y); eg.x = __builtin_amdgcn_exp2f(wg.x); eg.y = __builtin_amdgcn_exp2f(wg.y);
    const f32x2 d = (eu + 1.0f) * (eg + 1.0f); f32x2 r; r.x = __builtin_amdgcn_rcpf(d.x); r.y = __builtin_amdgcn_rcpf(d.y); return (u * g) * r; }
__device__ __forceinline__ f32x2 silu2(f32x2 x) { const f32x2 wv = x * (-1.44269504f);
    f32x2 ev; ev.x = __builtin_amdgcn_exp2f(wv.x); ev.y = __builtin_amdgcn_exp2f(wv.y); const f32x2 d = ev + 1.0f; f32x2 r; r.x = __builtin_amdgcn_rcpf(d.x); r.y = __builtin_amdgcn_rcpf(d.y); return x * r; }

#ifndef PROBE_KLOOP
#define PROBE_KLOOP 0
#endif
#ifndef PROBE_EPI2
#define PROBE_EPI2 0
#endif
struct RepOrder : StaticOrder { __host__ __device__ bool next(int i, Unit& u) const { return StaticOrder::next(i >> 1, u); } };
struct EpiZ {
    static constexpr bool PERM = true, AFTER_DRAIN = false, MIDSCALE = false, PREFETCH = false, PROBE2 = true;
    bf16_t* Z; int ldc; f32x2* vst;
    mutable int cnt;
    __device__ __forceinline__ void operator()(const f32x4 (&acc)[2][2][4][2], const Unit& u, int wr, int wc, int fr, int fq) const {
#if PROBE_KLOOP
        if ((cnt++ & 1) == 0) return;
#endif
        const int row0 = u.pm * BM + wr * 64 + fr;
        if (u.pn < 8) {
            const int col0 = u.pn * HALF + wc * 32 + 8 * fq;
#pragma unroll
            for (int ai = 0; ai < 2; ++ai)
#pragma unroll
                for (int m = 0; m < 4; ++m) { const int row = row0 + ai * HALF + m * 16; f32x2 p[4];
#pragma unroll
                    for (int n = 0; n < 2; ++n) { const f32x4 a = acc[ai][0][m][n], g = acc[ai][1][m][n];
                        p[2 * n] = gelu_silu2((f32x2){a[0], a[1]}, (f32x2){g[0], g[1]}); p[2 * n + 1] = gelu_silu2((f32x2){a[2], a[3]}, (f32x2){g[2], g[3]}); }
                    u32x4 w; w.x = cvt_pk_bf16(p[0].x, p[0].y); w.y = cvt_pk_bf16(p[1].x, p[1].y); w.z = cvt_pk_bf16(p[2].x, p[2].y); w.w = cvt_pk_bf16(p[3].x, p[3].y);
                    __builtin_nontemporal_store(w, (u32x4*)(Z + (size_t)row * ldc + col0)); }
            return; }
        const int col0 = 1024 + (u.pn - 8) * BM + wc * 32 + 8 * fq;
        const bool isv = (u.pn >> 2) == 2, isg = u.pn >= 16;
#pragma unroll
        for (int ai = 0; ai < 2; ++ai)
#pragma unroll
            for (int m = 0; m < 4; ++m) { const int row = row0 + ai * HALF + m * 16; bf16_t* rowp = Z + (size_t)row * ldc + col0;
                float s = 0.f, q = 0.f;
#pragma unroll
                for (int bj = 0; bj < 2; ++bj) { f32x4 v[2] = {acc[ai][bj][m][0], acc[ai][bj][m][1]};
                    if (isv) {
#pragma unroll
                        for (int n = 0; n < 2; ++n) { const f32x2 a = gelu2((f32x2){v[n][0], v[n][1]}), b = gelu2((f32x2){v[n][2], v[n][3]}); v[n] = (f32x4){a.x, a.y, b.x, b.y};
                            s += (a.x + a.y) + (b.x + b.y); q += (a.x * a.x + a.y * a.y) + (b.x * b.x + b.y * b.y); } }
                    if (isg) {
#pragma unroll
                        for (int n = 0; n < 2; ++n) { const f32x2 a = silu2((f32x2){v[n][0], v[n][1]}), b = silu2((f32x2){v[n][2], v[n][3]}); v[n] = (f32x4){a.x, a.y, b.x, b.y}; } }
                    u32x4 w; w.x = cvt_pk_bf16(v[0][0], v[0][1]); w.y = cvt_pk_bf16(v[0][2], v[0][3]); w.z = cvt_pk_bf16(v[1][0], v[1][1]); w.w = cvt_pk_bf16(v[1][2], v[1][3]);
                    __builtin_nontemporal_store(w, (u32x4*)(rowp + bj * HALF)); }
                if (isv) { s += __shfl_xor(s, 16); s += __shfl_xor(s, 32); q += __shfl_xor(q, 16); q += __shfl_xor(q, 32);
                    if (fq == 0) vst[(size_t)row * 16 + (u.pn - 8) * 4 + wc] = (f32x2){s, q}; }
            }
    }
};

struct PanelOrder {
    int c, G;
    __host__ __device__ void init(int, int, int G_, int c_) { G = G_; c = c_; }
    __host__ __device__ bool next(int i, Unit& u) const { if (i >= 4 || G != 256) return false; const int cls = c & 7, j = c >> 3; u.pm = 16 * cls + 4 * i + (j & 3); u.pn = j >> 2; return true; }
    __device__ __forceinline__ void a_ready(const Unit&) const {}
    __device__ __forceinline__ void done(const Unit&) const {}
};
struct EpiH {
    static constexpr bool PERM = true, AFTER_DRAIN = false, MIDSCALE = true, PROBE2 = false;
    bf16_t* H; int ldh; const bf16_t* xa; int ldx; const float* sx; const float* pg; const PG8_LAS f32x2* rr; PG8_LAS float* P; PG8_LAS float* S; float* X; unsigned* cnt; unsigned* tmo; mutable int ui; mutable u32x4 xp[2][2][2];
    __device__ __forceinline__ EpiH(bf16_t* H_, int ldh_, const bf16_t* xa_, int ldx_, const float* sx_, const float* pg_, const PG8_LAS f32x2* rr_, PG8_LAS float* P_, PG8_LAS float* S_, float* X_, unsigned* cnt_, unsigned* tmo_) : H(H_), ldh(ldh_), xa(xa_), ldx(ldx_), sx(sx_), pg(pg_), rr(rr_), P(P_), S(S_), X(X_), cnt(cnt_), tmo(tmo_), ui(0) {}
    __device__ __forceinline__ int hook_tile(int nt) const { return nt / 2; }
    __device__ __forceinline__ void midscale(f32x4 (&acc)[2][2][4][2], const Unit& u, int wr, int wc, int fr, int fq) const {
#pragma unroll
        for (int ai = 0; ai < 2; ++ai)
#pragma unroll
            for (int m = 0; m < 4; ++m) { const float s = rr[ui * 256 + ai * HALF + wr * 64 + m * 16 + fr].x;
#pragma unroll
                for (int bj = 0; bj < 2; ++bj)
#pragma unroll
                    for (int n = 0; n < 2; ++n) acc[ai][bj][m][n] *= s; }
        int fr2 = fr, fq2 = fq; asm volatile("" : "+v"(fr2), "+v"(fq2));
        const int row0 = u.pm * BM + wr * 64 + fr2, col0 = u.pn * BM + wc * 32 + 8 * fq2;
#pragma unroll
        for (int gi = 0; gi < 2; ++gi)
#pragma unroll
            for (int mm = 0; mm < 2; ++mm) { const bf16_t* xr = xa + (size_t)(row0 + (2 * gi + mm) * 16) * ldx + col0;
#pragma unroll
                for (int bj = 0; bj < 2; ++bj) xp[gi][mm][bj] = __builtin_nontemporal_load((const u32x4*)(xr + bj * HALF)); }
    }
    __device__ __forceinline__ void operator()(f32x4 (&acc)[2][2][4][2], const Unit& u, int wr, int wc, int fr_in, int fq_in) const {
        int fr = fr_in, fq = fq_in; asm volatile("" : "+v"(fr), "+v"(fq));
        const int wid = wr * 4 + wc, lane = fq * 16 + fr, tid = wid * 64 + lane;
        const int row0 = u.pm * BM + wr * 64 + fr, col0 = u.pn * BM + wc * 32 + 8 * fq;
        u32x4 xw2[2][2], xw3[2][2]; float xs[4][2]; f32x4 gv[2][2];
#define XLOADG(DST, GI) do { _Pragma("unroll") for (int mm = 0; mm < 2; ++mm) { const int row = row0 + ((GI) >> 1) * HALF + (2 * ((GI) & 1) + mm) * 16; const bf16_t* xr = xa + (size_t)row * ldx + col0; xs[GI][mm] = sx[row]; \
            _Pragma("unroll") for (int bj = 0; bj < 2; ++bj) DST[mm][bj] = __builtin_nontemporal_load((const u32x4*)(xr + bj * HALF)); } } while (0)
#define XLOADS() do { _Pragma("unroll") for (int bj = 0; bj < 2; ++bj) { gv[bj][0] = *(const f32x4*)(pg + col0 + bj * HALF); gv[bj][1] = *(const f32x4*)(pg + col0 + bj * HALF + 4); } \
        _Pragma("unroll") for (int gi = 0; gi < 2; ++gi) _Pragma("unroll") for (int mm = 0; mm < 2; ++mm) xs[gi][mm] = sx[row0 + (2 * gi + mm) * 16]; \
        XLOADG(xw2, 2); } while (0)
#define XSTORE(XV, GI) do { _Pragma("unroll") for (int mm = 0; mm < 2; ++mm) { const int ai = (GI) >> 1, m = 2 * ((GI) & 1) + mm; const int rl = ai * HALF + wr * 64 + m * 16 + fr; const float rs = S[rl], xsc = xs[GI][mm]; bf16_t* hr = H + (size_t)(u.pm * BM + rl) * ldh + col0; \
            _Pragma("unroll") for (int bj = 0; bj < 2; ++bj) { const u32x4 xv_ = XV[mm][bj]; \
                const f32x4 x0 = (f32x4){__uint_as_float(xv_.x << 16), __uint_as_float(xv_.x & 0xffff0000u), __uint_as_float(xv_.y << 16), __uint_as_float(xv_.y & 0xffff0000u)} * xsc; \
                const f32x4 x1 = (f32x4){__uint_as_float(xv_.z << 16), __uint_as_float(xv_.z & 0xffff0000u), __uint_as_float(xv_.w << 16), __uint_as_float(xv_.w & 0xffff0000u)} * xsc; \
                const f32x4 v0 = x0 + acc[ai][bj][m][0] * rs * gv[bj][0], v1 = x1 + acc[ai][bj][m][1] * rs * gv[bj][1]; \
                u32x4 w; w.x = cvt_pk_bf16(v0[0], v0[1]); w.y = cvt_pk_bf16(v0[2], v0[3]); w.z = cvt_pk_bf16(v1[0], v1[1]); w.w = cvt_pk_bf16(v1[2], v1[3]); \
                *(u32x4*)(hr + bj * HALF) = w; } } } while (0)
#pragma unroll
        for (int ai = 0; ai < 2; ++ai)
#pragma unroll
            for (int m = 0; m < 4; ++m) { const int rl = ai * HALF + wr * 64 + m * 16 + fr; const float s = rr[ui * 256 + rl].y; float q = 0.f;
#pragma unroll
                for (int bj = 0; bj < 2; ++bj)
#pragma unroll
                    for (int n = 0; n < 2; ++n) { acc[ai][bj][m][n] *= s; const f32x4 v = acc[ai][bj][m][n]; q += (v[0] * v[0] + v[1] * v[1]) + (v[2] * v[2] + v[3] * v[3]); }
                q += __shfl_xor(q, 16); q += __shfl_xor(q, 32);
                if (fq == 0) P[rl * 4 + wc] = q; }
        asm volatile("s_waitcnt lgkmcnt(0)" ::: "memory"); __builtin_amdgcn_s_barrier(); asm volatile("" ::: "memory");
        if (tid < 256) { const float t = (P[tid * 4 + 0] + P[tid * 4 + 1]) + (P[tid * 4 + 2] + P[tid * 4 + 3]);
            __hip_atomic_store(X + ((size_t)u.pm * 256 + tid) * 8 + u.pn, -t, __ATOMIC_RELAXED, __HIP_MEMORY_SCOPE_AGENT);
            if (lane == 0) __hip_atomic_fetch_add(cnt + 16 * u.pm, 1u, __ATOMIC_RELAXED, __HIP_MEMORY_SCOPE_AGENT);
        } else { XLOADS(); }
        if (wid == 0) { unsigned spins = 0;
            while ((unsigned)__builtin_amdgcn_readfirstlane(__hip_atomic_load(cnt + 16 * u.pm, __ATOMIC_RELAXED, __HIP_MEMORY_SCOPE_AGENT)) < 32u) {
                __builtin_amdgcn_s_sleep(1);
                if (++spins > (1u << 17)) { if (lane == 0) __hip_atomic_store(tmo, 1u, __ATOMIC_RELAXED, __HIP_MEMORY_SCOPE_AGENT); break; } } }
        asm volatile("s_waitcnt lgkmcnt(0)" ::: "memory"); __builtin_amdgcn_s_barrier(); asm volatile("" ::: "memory");
        if (tid < 256) { const unsigned long long* xq = (const unsigned long long*)(X + ((size_t)u.pm * 256 + tid) * 8); unsigned long long w4[4];
#pragma unroll
            for (int k = 0; k < 4; ++k) w4[k] = __hip_atomic_load(xq + k, __ATOMIC_RELAXED, __HIP_MEMORY_SCOPE_AGENT);
            for (unsigned spins = 0;; ++spins) {
                bool ok = true;
#pragma unroll
                for (int k = 0; k < 4; ++k) ok = ok && ((w4[k] & 0x8000000080000000ull) == 0x8000000080000000ull);
                if (__all(ok)) break;
                if (spins > (1u << 17)) { if (lane == 0) __hip_atomic_store(tmo, 1u, __ATOMIC_RELAXED, __HIP_MEMORY_SCOPE_AGENT); break; }
                __builtin_amdgcn_s_sleep(2);
#pragma unroll
                for (int k = 0; k < 4; ++k) if ((w4[k] & 0x8000000080000000ull) != 0x8000000080000000ull) w4[k] = __hip_atomic_load(xq + k, __ATOMIC_RELAXED, __HIP_MEMORY_SCOPE_AGENT);
            }
            asm volatile("" ::: "memory");
            XLOADS();
            asm volatile("" ::: "memory");
            float t = 0.f;
#pragma unroll
            for (int k = 0; k < 4; ++k) t -= __uint_as_float((unsigned)w4[k]) + __uint_as_float((unsigned)(w4[k] >> 32));
            S[tid] = __builtin_amdgcn_rsqf(t * (1.0f / 2048.0f) + 1e-6f); }
        asm volatile("s_waitcnt lgkmcnt(0)" ::: "memory"); __builtin_amdgcn_s_barrier(); asm volatile("" ::: "memory");
        XLOADG(xw3, 3); asm volatile("" ::: "memory"); XSTORE(xp[0], 0); asm volatile("" ::: "memory");
        XSTORE(xp[1], 1); asm volatile("" ::: "memory"); XSTORE(xw2, 2); asm volatile("" ::: "memory"); XSTORE(xw3, 3);
#undef XLOADS
#undef XLOADG
#undef XSTORE
        ++ui;
    }
};

struct EpiOut {
    static constexpr bool PERM = false, AFTER_DRAIN = false, MIDSCALE = true, PROBE2 = false;
    float* out; const bf16_t* h1; int ldc, lda; mutable unsigned g8[2][2][4][2]; mutable u32x2 hp[2][2][2];
    __device__ __forceinline__ EpiOut(float* out_, const bf16_t* h1_, int ldc_, int lda_) : out(out_), h1(h1_), ldc(ldc_), lda(lda_) {}
    __device__ __forceinline__ int hook_tile(int nt) const { return nt - 4; }
    __device__ __forceinline__ void midscale(f32x4 (&acc)[2][2][4][2], const Unit& u, int wr, int wc, int fr, int fq) const {
#pragma unroll
        for (int ai = 0; ai < 2; ++ai)
#pragma unroll
            for (int bj = 0; bj < 2; ++bj)
#pragma unroll
                for (int m = 0; m < 4; ++m)
#pragma unroll
                    for (int n = 0; n < 2; ++n) { const f32x4 a = acc[ai][bj][m][n];
                        const f32x2 s0 = (f32x2){a[0], a[1]} * 16.0f + 128.0f, s1 = (f32x2){a[2], a[3]} * 16.0f + 128.0f;
                        unsigned w = __builtin_amdgcn_cvt_pk_u8_f32(s0.x, 0u, 0u); w = __builtin_amdgcn_cvt_pk_u8_f32(s0.y, 1u, w); w = __builtin_amdgcn_cvt_pk_u8_f32(s1.x, 2u, w); w = __builtin_amdgcn_cvt_pk_u8_f32(s1.y, 3u, w);
                        g8[ai][bj][m][n] = w; acc[ai][bj][m][n] = (f32x4){0.f, 0.f, 0.f, 0.f}; }
        int fr2 = fr, fq2 = fq; asm volatile("" : "+v"(fr2), "+v"(fq2));
        const int row0 = u.pm * BM + wr * 64 + fr2, col0 = u.pn * BM + wc * 32 + 4 * fq2;
#pragma unroll
        for (int mm = 0; mm < 2; ++mm) { const size_t offa = (size_t)(row0 + mm * 16) * lda + col0;
#pragma unroll
            for (int bj = 0; bj < 2; ++bj)
#pragma unroll
                for (int n = 0; n < 2; ++n) hp[mm][bj][n] = *(const u32x2*)(h1 + offa + bj * HALF + n * 16); }
    }
    __device__ __forceinline__ void operator()(const f32x4 (&acc)[2][2][4][2], const Unit& u, int wr, int wc, int fr_in, int fq_in) const {
        int fr = fr_in, fq = fq_in; asm volatile("" : "+v"(fr), "+v"(fq));
        const int row0 = u.pm * BM + wr * 64 + fr, col0 = u.pn * BM + wc * 32 + 4 * fq;
        u32x2 hw[2][2][2][2];
#define HLOAD(B, GI) do { _Pragma("unroll") for (int mm = 0; mm < 2; ++mm) { const size_t offa = (size_t)(row0 + ((GI) >> 1) * HALF + (2 * ((GI) & 1) + mm) * 16) * lda + col0; \
            _Pragma("unroll") for (int bj = 0; bj < 2; ++bj) _Pragma("unroll") for (int n = 0; n < 2; ++n) hw[B][mm][bj][n] = *(const u32x2*)(h1 + offa + bj * HALF + n * 16); } } while (0)
#define HSTORE(B, GI) do { _Pragma("unroll") for (int mm = 0; mm < 2; ++mm) { const int ai = (GI) >> 1, m = 2 * ((GI) & 1) + mm; const size_t off = (size_t)(row0 + ai * HALF + m * 16) * ldc + col0; \
            _Pragma("unroll") for (int bj = 0; bj < 2; ++bj) _Pragma("unroll") for (int n = 0; n < 2; ++n) { const int cc = bj * HALF + n * 16; \
                const u32x2 hv = hw[B][mm][bj][n]; const f32x4 a = acc[ai][bj][m][n]; const unsigned w = g8[ai][bj][m][n]; f32x4 r; \
                const f32x2 z0 = (f32x2){(float)(w & 0xffu), (float)((w >> 8) & 0xffu)} * (-0.09016844f) + 11.5415603f, z1 = (f32x2){(float)((w >> 16) & 0xffu), (float)(w >> 24)} * (-0.09016844f) + 11.5415603f;        \
                f32x2 e0, e1; e0.x = __builtin_amdgcn_exp2f(z0.x); e0.y = __builtin_amdgcn_exp2f(z0.y); e1.x = __builtin_amdgcn_exp2f(z1.x); e1.y = __builtin_amdgcn_exp2f(z1.y); \
                const f32x2 d0 = e0 + 1.0f, d1 = e1 + 1.0f; \
                r[0] = __uint_as_float(hv.x << 16) + a[0] * __builtin_amdgcn_rcpf(d0.x); \
                r[1] = __uint_as_float(hv.x & 0xffff0000u) + a[1] * __builtin_amdgcn_rcpf(d0.y); \
                r[2] = __uint_as_float(hv.y << 16) + a[2] * __builtin_amdgcn_rcpf(d1.x); \
                r[3] = __uint_as_float(hv.y & 0xffff0000u) + a[3] * __builtin_amdgcn_rcpf(d1.y); \
                __builtin_nontemporal_store(r, (f32x4*)(out + off + cc)); } } } while (0)
#pragma unroll
        for (int mm = 0; mm < 2; ++mm)
#pragma unroll
            for (int bj = 0; bj < 2; ++bj)
#pragma unroll
                for (int n = 0; n < 2; ++n) hw[0][mm][bj][n] = hp[mm][bj][n];
        HLOAD(1, 1);
        asm volatile("" ::: "memory"); HSTORE(0, 0); asm volatile("" ::: "memory"); HLOAD(0, 2);
        asm volatile("" ::: "memory"); HSTORE(1, 1); asm volatile("" ::: "memory"); HLOAD(1, 3);
        asm volatile("" ::: "memory"); HSTORE(0, 2);
        asm volatile("" ::: "memory"); HSTORE(1, 3);
#undef HLOAD
#undef HSTORE
    }
};

template <class Epi, class Sched, bool ALIGN_EPI = false, bool SP2 = false>
__device__ __forceinline__ void gemm_phase(PG8_LAS unsigned char* lds, const Gemm g, const Sched& S, const Epi& E, int tid_in) {
    int tid_ = tid_in; asm volatile("" : "+v"(tid_));
    const int tid = tid_, wid = __builtin_amdgcn_readfirstlane(tid >> 6), lane = tid & 63, wr = wid >> 2, wc = wid & 3, fr = lane & 15, fq = lane >> 4;
    const int K = g.K, nt = K / BK;
    unsigned voffA[2], voffB[2];
#pragma unroll
    for (int i = 0; i < 2; ++i) { int R, C; stage_rc(tid * 16 + i * 8192, R, C); const int Rb = Epi::PERM ? ((R & ~31) + perm32(R & 31)) : R;
        voffA[i] = (unsigned)(R * K + C) * 2u; voffB[i] = (unsigned)(Rb * K + C) * 2u; }
    const size_t kstep = (size_t)(BK * 2);
    const size_t hstep = (size_t)HALF * K * 2;
    const size_t tstep = 2 * hstep;
    const unsigned ldsw = (unsigned)wid * 1024u;
    const int aoff = lds_byte(wr * 64 + fr, fq * 8), boff = lds_byte(wc * 32 + fr, fq * 8);
#define PG8_SA(b, h) (((b) * 2 + (h)) * HTB)
#define PG8_SB(b, h) ((4 + (b) * 2 + (h)) * HTB)
#define PG8_STAGE(bufoff, gbase, voff) do { const char* gb_ = (const char*)(gbase); asm volatile("" : "+s"(gb_)); _Pragma("unroll") for (int _i = 0; _i < 2; ++_i) { \
        unsigned vo_ = (voff)[_i]; asm volatile("" : "+v"(vo_));        \
        __builtin_amdgcn_global_load_lds((const unsigned*)(gb_ + vo_), (PG8_LAS unsigned*)(lds + (bufoff) + ldsw + _i * 8192), 16, 0, 0); } } while (0)
#define PG8_LDA(dst, b, h) do { _Pragma("unroll") for (int m = 0; m < 4; ++m) _Pragma("unroll") for (int k = 0; k < 2; ++k) dst[m][k] = *(const PG8_LAS bf16x8*)(lds + PG8_SA(b, h) + aoff + m * 2048 + k * 1024); } while (0)
#define PG8_LDB(dst, b, h) do { _Pragma("unroll") for (int n = 0; n < 2; ++n) _Pragma("unroll") for (int k = 0; k < 2; ++k) dst[n][k] = *(const PG8_LAS bf16x8*)(lds + PG8_SB(b, h) + boff + n * 2048 + k * 1024); } while (0)
#define PG8_MMA(ai, bj, At, Bt) do { __builtin_amdgcn_s_setprio(1); _Pragma("unroll") for (int m = 0; m < 4; ++m) _Pragma("unroll") for (int n = 0; n < 2; ++n) _Pragma("unroll") for (int k = 0; k < 2; ++k) \
        acc[ai][bj][m][n] = __builtin_amdgcn_mfma_f32_16x16x32_bf16(Bt[n][k], At[m][k], acc[ai][bj][m][n], 0, 0, 0); __builtin_amdgcn_s_setprio(0); } while (0)
#define PG8_WAIT_V(n) asm volatile("s_waitcnt vmcnt(" #n ")" ::: "memory")
#define PG8_WAIT_L(n) asm volatile("s_waitcnt lgkmcnt(" #n ")" ::: "memory")
#define PG8_BAR __builtin_amdgcn_s_barrier()
#define PG8_SCHED __builtin_amdgcn_sched_barrier(0)
    Unit cur, nxt; int ui = 0;
    if (!S.next(0, cur)) return;
    f32x4 acc[2][2][4][2];
#pragma unroll
    for (int a = 0; a < 2; ++a)
#pragma unroll
        for (int b = 0; b < 2; ++b)
#pragma unroll
            for (int m = 0; m < 4; ++m)
#pragma unroll
                for (int n = 0; n < 2; ++n) acc[a][b][m][n] = (f32x4){0.f, 0.f, 0.f, 0.f};
    bf16x8 At[4][2], B0[2][2], B1[2][2];
    const char* cA = (const char*)g.A + (size_t)cur.pm * tstep; const char* cB = (const char*)g.Bt + (size_t)cur.pn * tstep;
    S.a_ready(cur);
    if constexpr (SP2) {
        PG8_STAGE(PG8_SB(0, 0), cB, voffB); PG8_STAGE(PG8_SB(0, 1), cB + hstep, voffB); PG8_STAGE(PG8_SA(0, 0), cA, voffA); PG8_STAGE(PG8_SA(0, 1), cA + hstep, voffA);
        if (wr == 1) PG8_BAR;
        PG8_WAIT_V(2); PG8_BAR;
        PG8_STAGE(PG8_SB(1, 0), cB + kstep, voffB); PG8_STAGE(PG8_SA(1, 0), cA + kstep, voffA); PG8_STAGE(PG8_SB(1, 1), cB + hstep + kstep, voffB);
        PG8_WAIT_V(6); PG8_BAR;
    } else {
        PG8_STAGE(PG8_SB(0, 0), cB, voffB); PG8_STAGE(PG8_SA(0, 0), cA, voffA); PG8_STAGE(PG8_SB(0, 1), cB + hstep, voffB); PG8_STAGE(PG8_SA(0, 1), cA + hstep, voffA);
        if (wr == 1) PG8_BAR;
        PG8_WAIT_V(4); PG8_BAR;
        PG8_STAGE(PG8_SB(1, 0), cB + kstep, voffB); PG8_STAGE(PG8_SA(1, 0), cA + kstep, voffA); PG8_STAGE(PG8_SB(1, 1), cB + hstep + kstep, voffB);
        PG8_WAIT_V(6); PG8_BAR;
    }
    for (;;) {
        const bool has_next = S.next(ui + 1, nxt);
        const char* nA = has_next ? (const char*)g.A + (size_t)nxt.pm * tstep : cA; const char* nB = has_next ? (const char*)g.Bt + (size_t)nxt.pn * tstep : cB;
        for (int t = 0; t < nt; t += 2) {
            const bool last = (t == nt - 2);
            const char* a1 = cA + (size_t)(t + 1) * kstep;
            const char* a2 = last ? nA : cA + (size_t)(t + 2) * kstep; const char* b2 = last ? nB : cB + (size_t)(t + 2) * kstep;
            const char* a3 = a2 + kstep; const char* b3 = b2 + kstep;
            if (last && has_next) S.a_ready(nxt);
            if constexpr (Epi::MIDSCALE) { if (t == E.hook_tile(nt)) E.midscale(acc, cur, wr, wc, fr, fq); }
            if constexpr (SP2) {
            PG8_LDB(B0, 0, 0); PG8_LDB(B1, 0, 1); PG8_SCHED; PG8_LDA(At, 0, 0); PG8_STAGE(PG8_SA(1, 1), a1 + hstep, voffA);
            PG8_WAIT_V(8); PG8_WAIT_L(0); PG8_BAR; PG8_MMA(0, 0, At, B0); PG8_MMA(0, 1, At, B1); PG8_BAR; PG8_SCHED;
            PG8_LDA(At, 0, 1); PG8_STAGE(PG8_SB(0, 0), b2, voffB); PG8_STAGE(PG8_SB(0, 1), b2 + hstep, voffB); PG8_STAGE(PG8_SA(0, 0), a2, voffA);
            PG8_WAIT_V(8); PG8_WAIT_L(0); PG8_BAR; PG8_MMA(1, 0, At, B0); PG8_MMA(1, 1, At, B1); PG8_BAR; PG8_SCHED;
            PG8_LDB(B0, 1, 0); PG8_LDB(B1, 1, 1); PG8_SCHED; PG8_LDA(At, 1, 0); PG8_STAGE(PG8_SA(0, 1), a2 + hstep, voffA);
            PG8_WAIT_V(8); PG8_WAIT_L(0); PG8_BAR; PG8_MMA(0, 0, At, B0); PG8_MMA(0, 1, At, B1); PG8_BAR; PG8_SCHED;
            PG8_LDA(At, 1, 1); PG8_STAGE(PG8_SB(1, 0), b3, voffB); PG8_STAGE(PG8_SB(1, 1), b3 + hstep, voffB); PG8_STAGE(PG8_SA(1, 0), a3, voffA);
            PG8_WAIT_V(8); PG8_WAIT_L(0); PG8_BAR; PG8_MMA(1, 0, At, B0); PG8_MMA(1, 1, At, B1); PG8_BAR; PG8_SCHED;
            } else {
            PG8_LDB(B0, 0, 0); PG8_SCHED; PG8_LDA(At, 0, 0); PG8_STAGE(PG8_SA(1, 1), a1 + hstep, voffA);
            PG8_WAIT_L(8); PG8_BAR; PG8_WAIT_L(0); PG8_MMA(0, 0, At, B0); PG8_BAR; PG8_SCHED;
            PG8_LDB(B1, 0, 1); PG8_STAGE(PG8_SB(0, 0), b2, voffB);
            PG8_BAR; PG8_WAIT_L(0); PG8_MMA(0, 1, At, B1); PG8_BAR;
            PG8_LDA(At, 0, 1); PG8_STAGE(PG8_SA(0, 0), a2, voffA);
            PG8_BAR; PG8_WAIT_L(0); PG8_MMA(1, 0, At, B0); PG8_BAR; PG8_SCHED;
            PG8_STAGE(PG8_SB(0, 1), b2 + hstep, voffB);
            PG8_WAIT_V(6); PG8_BAR; PG8_MMA(1, 1, At, B1); PG8_BAR;
            PG8_LDB(B0, 1, 0); PG8_SCHED; PG8_LDA(At, 1, 0); PG8_STAGE(PG8_SA(0, 1), a2 + hstep, voffA);
            PG8_WAIT_L(8); PG8_BAR; PG8_WAIT_L(0); PG8_MMA(0, 0, At, B0); PG8_BAR; PG8_SCHED;
            PG8_LDB(B1, 1, 1); PG8_STAGE(PG8_SB(1, 0), b3, voffB);
            PG8_BAR; PG8_WAIT_L(0); PG8_MMA(0, 1, At, B1); PG8_BAR;
            PG8_LDA(At, 1, 1); PG8_STAGE(PG8_SA(1, 0), a3, voffA);
            PG8_BAR; PG8_WAIT_L(0); PG8_MMA(1, 0, At, B0); PG8_BAR; PG8_SCHED;
            PG8_STAGE(PG8_SB(1, 1), b3 + hstep, voffB);
            PG8_WAIT_V(6); PG8_BAR; PG8_MMA(1, 1, At, B1); PG8_BAR;
            }
        }
        if constexpr (ALIGN_EPI) { if (wr == 0) PG8_BAR; }
        if constexpr (!Epi::AFTER_DRAIN) { E(acc, cur, wr, wc, fr, fq);
#if PROBE_EPI2
            if constexpr (Epi::PROBE2) { asm volatile("" ::: "memory");
                _Pragma("unroll") for (int a = 0; a < 2; ++a) _Pragma("unroll") for (int b = 0; b < 2; ++b) _Pragma("unroll") for (int m = 0; m < 4; ++m) _Pragma("unroll") for (int n = 0; n < 2; ++n) asm volatile("" : "+v"(acc[a][b][m][n]));
                int fr2 = fr, fq2 = fq; asm volatile("" : "+v"(fr2), "+v"(fq2));
                E(acc, cur, wr, wc, fr2, fq2); }
#endif
            S.done(cur); }
        if (!has_next) break;
#pragma unroll
        for (int a = 0; a < 2; ++a)
#pragma unroll
            for (int b = 0; b < 2; ++b)
#pragma unroll
                for (int m = 0; m < 4; ++m)
#pragma unroll
                    for (int n = 0; n < 2; ++n) acc[a][b][m][n] = (f32x4){0.f, 0.f, 0.f, 0.f};
        cur = nxt; cA = nA; cB = nB; ++ui;
        if constexpr (ALIGN_EPI) { if (wr == 1) PG8_BAR; }
    }
    PG8_WAIT_V(0);
    if constexpr (!ALIGN_EPI) { if (wr == 0) PG8_BAR; }
    PG8_BAR;
    if constexpr (Epi::AFTER_DRAIN) { E.fused(acc, cur, wr, wc, fr, fq, lds, wid, lane); S.done(cur); }
#undef PG8_SA
#undef PG8_SB
#undef PG8_STAGE
#undef PG8_LDA
#undef PG8_LDB
#undef PG8_MMA
#undef PG8_WAIT_V
#undef PG8_WAIT_L
#undef PG8_BAR
#undef PG8_SCHED
}
}

constexpr int BATCH = 4, SEQ = 8192, DM = 2048, M = BATCH * SEQ, DG = 1024, DL = 1024, NZ = 5120, NZO = 4096, DP = 256, CHK = 128, NH = 8;
constexpr float EPS = 1e-6f;
constexpr int NWAVES = 8, NTHR = NWAVES * 64;
#ifndef MK_N_LAUNCHES
#define MK_N_LAUNCHES 1
#endif
constexpr int N_PHASES = 8;
#ifndef MK_CG_SYNC
#define MK_CG_SYNC 0
#endif
#ifndef SKEW7_TICKS
#define SKEW7_TICKS 0
#endif
#ifndef PROBE_DOUBLE
#define PROBE_DOUBLE 0
#endif
#define REPS(k) for (int rep_ = 0; rep_ < 1 + ((PROBE_DOUBLE >> (k)) & 1); ++rep_)

constexpr size_t MiB = 1u << 20;
constexpr size_t WS_WIN = 2 * MiB;
constexpr size_t WS_WOUT = 22 * MiB;
constexpr size_t WS_WA = 39 * MiB;
constexpr size_t WS_WX = WS_WA + 256 * 1024;
constexpr size_t WS_WSM = WS_WX + 256 * 1024;
constexpr size_t WS_VST = 40 * MiB;
constexpr size_t WS_SSA = 44 * MiB;
constexpr size_t WS_SSB = 45 * MiB;
constexpr size_t WS_SSO = 46 * MiB;
constexpr size_t WS_AGG = 50 * MiB;
constexpr size_t WS_SPT = 53 * MiB;
constexpr size_t WS_SX = 52 * MiB;
constexpr size_t WS_A1 = 64 * MiB;
constexpr int K3 = DM + DP;
constexpr size_t WS_A3 = 192 * MiB;
constexpr size_t WS_Z = 336 * MiB;
constexpr size_t WS_Y = 656 * MiB;
constexpr size_t WS_B3 = 912 * MiB;
constexpr size_t WS_END = 922 * MiB;

constexpr int LDS_BYTES = 147456;
constexpr int IMG0 = 0, IMG1 = 32768, IMG2 = 65536, IMG3 = 98304, MISC = 131072;
constexpr int MISC_STAT = MISC, MISC_PART = MISC + 1024, MISC_CPART = MISC + 5120;

#define LAS __attribute__((address_space(3)))
typedef unsigned short bf16;
typedef unsigned char uchar;
typedef float f32x4 __attribute__((ext_vector_type(4)));
typedef float f32x2 __attribute__((ext_vector_type(2)));
typedef unsigned u32x4 __attribute__((ext_vector_type(4)));
typedef unsigned u32x2 __attribute__((ext_vector_type(2)));
typedef short bf16x8 __attribute__((ext_vector_type(8)));

__device__ __forceinline__ unsigned f2bf(float f) { unsigned u = __builtin_bit_cast(unsigned, f); return (u + 0x7fffu + ((u >> 16) & 1u)) >> 16; }
__device__ __forceinline__ unsigned pk2(float lo, float hi) { unsigned r; asm("v_cvt_pk_bf16_f32 %0, %1, %2" : "=v"(r) : "v"(lo), "v"(hi)); return r; }
__device__ __forceinline__ float bflo(unsigned w) { return __uint_as_float(w << 16); }
__device__ __forceinline__ float bfhi(unsigned w) { return __uint_as_float(w & 0xffff0000u); }
__device__ __forceinline__ float wave_sum(float v) {
#pragma unroll
    for (int o = 1; o < 64; o <<= 1) v += __shfl_xor(v, o);
    return v;
}
__device__ __forceinline__ float sigmoidf_(float x) { return __builtin_amdgcn_rcpf(1.0f + __expf(-x)); }

__device__ __forceinline__ f32x2 gelu2(f32x2 x) { const f32x2 t = x * x; const f32x2 uu = t * (-0.10294323f) + (-2.30220819f); const f32x2 wv = x * uu;
    f32x2 ev; ev.x = __builtin_amdgcn_exp2f(wv.x); ev.y = __builtin_amdgcn_exp2f(wv.y); const f32x2 d = ev + 1.0f; f32x2 r; r.x = __builtin_amdgcn_rcpf(d.x); r.y = __builtin_amdgcn_rcpf(d.y); return x * r; }
__device__ __forceinline__ f32x2 silu2(f32x2 x) { const f32x2 wv = x * (-1.44269504f);
    f32x2 ev; ev.x = __builtin_amdgcn_exp2f(wv.x); ev.y = __builtin_amdgcn_exp2f(wv.y); const f32x2 d = ev + 1.0f; f32x2 r; r.x = __builtin_amdgcn_rcpf(d.x); r.y = __builtin_amdgcn_rcpf(d.y); return x * r; }

struct Args { const float* in[21]; float* out; unsigned char* ws; int ph_lo, ph_hi; };
typedef const __attribute__((address_space(4))) Args* ArgP;
struct Frame {
    LAS uchar* lds;
    int tid, lane, wave, G, bid;
    int wv;
    ArgP ap;
};
#define PHASE_BEGIN(F) do { int w_ = (F).wv; unsigned z_ = 0u; ArgP a_ = (ArgP)__builtin_amdgcn_kernarg_segment_ptr(); asm volatile("" : "+s"(w_), "+s"(a_), "+s"(z_)); \
    const int l_ = (int)__builtin_amdgcn_mbcnt_hi(~0u, __builtin_amdgcn_mbcnt_lo(~0u, z_));     \
    (F).lane = l_; (F).wave = w_; (F).tid = w_ * 64 + l_; (F).ap = a_; } while (0)

__device__ __forceinline__ void p0_transpose_item(const float* W, int K, int N, bf16* WT, LAS float* scr, int item, int lane, const float* ks0, const float* ks1, int ksplit, int ldt = 0, bool winperm = false) {
    if (ldt == 0) ldt = K;
    const int nblk = N / 32, kb = item / nblk, nb = item % nblk, k0 = 64 * kb, n0 = 32 * nb;
    int n0s = n0;
    if (winperm) { if (n0 < 2048) { const int k = n0 >> 8, r = n0 & 255; n0s = (r < 128) ? 128 * k + r : 2048 + 128 * k + (r - 128); } else if (n0 < 3072) n0s = n0 - 1024; }
#pragma unroll 8
    for (int i = 0; i < 32; ++i) { const int kk = 2 * i + (lane >> 5); scr[kk * 33 + (lane & 31)] = __builtin_nontemporal_load(W + (size_t)(k0 + kk) * N + n0s + (lane & 31)); }
    const int c = lane & 7;
    f32x4 s0 = (f32x4){1.f, 1.f, 1.f, 1.f}, s1 = s0;
    if (ks0) { const float* ks = (k0 < ksplit) ? ks0 + k0 : ks1 + (k0 - ksplit); s0 = *(const f32x4*)(ks + 8 * c); s1 = *(const f32x4*)(ks + 8 * c + 4); }
    asm volatile("s_waitcnt lgkmcnt(0)" ::: "memory");
#pragma unroll
    for (int j = 0; j < 4; ++j) { const int n = (lane >> 3) + 8 * j; const LAS float* s = scr + (8 * c) * 33 + n;
        u32x4 o; o.x = pk2(s[0 * 33] * s0.x, s[1 * 33] * s0.y); o.y = pk2(s[2 * 33] * s0.z, s[3 * 33] * s0.w); o.z = pk2(s[4 * 33] * s1.x, s[5 * 33] * s1.y); o.w = pk2(s[6 * 33] * s1.z, s[7 * 33] * s1.w);
        *(u32x4*)(WT + (size_t)(n0 + n) * ldt + k0 + 8 * c) = o; }
    asm volatile("s_waitcnt lgkmcnt(0)" ::: "memory");
}

__device__ __forceinline__ void p0_prologue(Frame& F) {
    LAS float* scr = (LAS float*)(F.lds + F.wave * 16384);
    const int gw = F.bid * NWAVES + F.wave, NGW = F.G * NWAVES;
    const float* w_in = F.ap->in[3]; const float* w_out = F.ap->in[17]; const float* w_pe = F.ap->in[19]; const float* w_pg = F.ap->in[20];
    const float* w_a = F.ap->in[10]; const float* w_x = F.ap->in[12];
    bf16* WIN = (bf16*)(((uchar*)F.ap->ws) + WS_WIN); bf16* WOUT = (bf16*)(((uchar*)F.ap->ws) + WS_WOUT); bf16* B3 = (bf16*)(((uchar*)F.ap->ws) + WS_B3);
    bf16* WA = (bf16*)(((uchar*)F.ap->ws) + WS_WA); bf16* WX = (bf16*)(((uchar*)F.ap->ws) + WS_WX); bf16* WSM = (bf16*)(((uchar*)F.ap->ws) + WS_WSM);
    constexpr int I_IN = (DM / 64) * (NZ / 32), I_OUT = (DM / 64) * (DM / 32), I_PG = I_OUT, I_PE = (DP / 64) * (DM / 32), I_SM = 16 * 8;
    constexpr int NITEMS = I_IN + I_OUT + I_PG + I_PE + I_SM;
    for (int it = gw; it < NITEMS; it += NGW) {
        int r = it;
        if (r < I_IN) { p0_transpose_item(w_in, DM, NZ, WIN, scr, r, F.lane, F.ap->in[2], F.ap->in[2], DM, 0, true); continue; } r -= I_IN;
        if (r < I_OUT) { p0_transpose_item(w_out, DM, DM, WOUT, scr, r, F.lane, F.ap->in[15], F.ap->in[16], DG); continue; } r -= I_OUT;
        if (r < I_PG) { p0_transpose_item(w_pg, DM, DM, B3, scr, r, F.lane, nullptr, nullptr, 0, K3); continue; } r -= I_PG;
        if (r < I_PE) { p0_transpose_item(w_pe, DP, DM, B3 + DM, scr, r, F.lane, nullptr, nullptr, 0, K3); continue; } r -= I_PE;
        { const int mat = r >> 3, sub = r & 7;
          const float* src = (mat < 8 ? w_a : w_x) + (size_t)(mat & 7) * 16384; bf16* dst = (mat < 8 ? WA : WX) + (size_t)(mat & 7) * 16384;
          p0_transpose_item(src, 128, 128, dst, scr, sub, F.lane, nullptr, nullptr, 0); }
    }
    { unsigned long long* AGGz = (unsigned long long*)(((uchar*)F.ap->ws) + WS_AGG); const int gt = F.bid * NTHR + F.tid, NGT = F.G * NTHR;
      for (int i = gt; i < 256 * DL; i += NGT) __hip_atomic_store(AGGz + i, 0ull, __ATOMIC_RELAXED, __HIP_MEMORY_SCOPE_AGENT); }
    if (F.bid == 1) { float* spt = (float*)(((uchar*)F.ap->ws) + WS_SPT); const float* lam = F.ap->in[14];
      for (int i = F.tid; i < DL; i += NTHR) { const float xx = -lam[i]; const float spl = (xx > 0.f ? xx : 0.f) + log1pf(__expf(-fabsf(xx)));
          spt[i] = -8.0f * 1.44269504f * spl; } }
    { unsigned long long* Xz = (unsigned long long*)(((uchar*)F.ap->ws) + WS_SSO); const int gt = F.bid * NTHR + F.tid, NGT = F.G * NTHR;
      for (int i = gt; i < M * 4; i += NGT) __hip_atomic_store(Xz + i, 0ull, __ATOMIC_RELAXED, __HIP_MEMORY_SCOPE_AGENT); }
    { const float* ws_ = F.ap->in[6]; const int gt = F.bid * NTHR + F.tid, NGT = F.G * NTHR;
      for (int i = gt; i < NH * CHK * CHK / 2; i += NGT) { const int e = 2 * i, s = e & 127, t = (e >> 7) & 127; const f32x2 v = *(const f32x2*)(ws_ + e);
          ((unsigned*)WSM)[i] = pk2(s <= t ? v.x : 0.f, (s + 1) <= t ? v.y : 0.f); } }
    { const float* x = F.ap->in[0]; bf16* A1 = (bf16*)((uchar*)F.ap->ws + WS_A1); float* SX = (float*)((uchar*)F.ap->ws + WS_SX);
      f32x4 v[8], nx[8];
      int m = gw;
      if (m < M) { const f32x4* xr = (const f32x4*)(x + (size_t)m * DM) + 2 * F.lane;
#pragma unroll
          for (int j = 0; j < 4; ++j) { v[2 * j] = __builtin_nontemporal_load(xr + 128 * j); v[2 * j + 1] = __builtin_nontemporal_load(xr + 128 * j + 1); } }
      for (; m < M; m += NGW) {
          const int mn = m + NGW;
          if (mn < M) { const f32x4* xr = (const f32x4*)(x + (size_t)mn * DM) + 2 * F.lane;
#pragma unroll
              for (int j = 0; j < 4; ++j) { nx[2 * j] = __builtin_nontemporal_load(xr + 128 * j); nx[2 * j + 1] = __builtin_nontemporal_load(xr + 128 * j + 1); } }
          float ss = 0.f;
#pragma unroll
          for (int j = 0; j < 8; ++j) ss += (v[j].x * v[j].x + v[j].y * v[j].y) + (v[j].z * v[j].z + v[j].w * v[j].w);
          const float sx = sqrtf(wave_sum(ss) * (1.0f / DM) + EPS), rstd = 1.0f / sx;
          if (F.lane == 0) SX[m] = sx;
          u32x4* o16 = (u32x4*)(A1 + (size_t)m * DM) + F.lane;
#pragma unroll
          for (int j = 0; j < 4; ++j) { const f32x4 a = v[2 * j], b = v[2 * j + 1];
              u32x4 o; o.x = pk2(a.x * rstd, a.y * rstd); o.y = pk2(a.z * rstd, a.w * rstd); o.z = pk2(b.x * rstd, b.y * rstd); o.w = pk2(b.z * rstd, b.w * rstd); o16[64 * j] = o; }
#pragma unroll
          for (int j = 0; j < 8; ++j) v[j] = nx[j];
      } }
    { const float* p = F.ap->in[1]; bf16* A3 = (bf16*)(((uchar*)F.ap->ws) + WS_A3); const size_t gt = (size_t)F.bid * NTHR + F.tid, NGT = (size_t)F.G * NTHR;
      for (size_t i = gt; i < (size_t)M * DP / 8; i += NGT) { const f32x4 a = __builtin_nontemporal_load((const f32x4*)p + 2 * i), b = __builtin_nontemporal_load((const f32x4*)p + 2 * i + 1); const size_t row = i >> 5, c8 = i & 31;
          u32x4 o; o.x = pk2(a.x, a.y); o.y = pk2(a.z, a.w); o.z = pk2(b.x, b.y); o.w = pk2(b.z, b.w); *(u32x4*)(A3 + row * K3 + DM + c8 * 8) = o; } }
}

__device__ __forceinline__ int sw16(int row) { return (row ^ (row >> 3)) & 15; }
__device__ __forceinline__ int img_off(int row, int chunk) { return row * 256 + ((chunk ^ sw16(row)) << 4); }
__device__ __forceinline__ int img_xt(int b0, int T) { return (b0 ^ (T << 5)) + (T << 12); }
__device__ __forceinline__ void load_img(LAS uchar* img, const bf16* src, int tid) {
#pragma unroll
    for (int i = 0; i < 4; ++i) { const int q = tid + NTHR * i, row = q >> 4, ch = q & 15; const u32x4 v = *(const u32x4*)(src + row * 128 + ch * 8); *(LAS u32x4*)(img + img_off(row, ch)) = v; }
}
#define DPP_F(oldv, srcv, ctrl) __builtin_bit_cast(float, __builtin_amdgcn_update_dpp(__builtin_bit_cast(int, (float)(oldv)), __builtin_bit_cast(int, (float)(srcv)), (ctrl), 0xf, 0xf, false))
constexpr int CW_FLAG = 4096;
constexpr int CW_TMO2 = 6400;
constexpr int CW_PCNT = 6464;
constexpr int CTL_WORDS = 9216;

struct GmlpPref { u32x4 gv[4], uu[4]; f32x4 st[8]; };
__device__ __forceinline__ void gmlp_prefetch(Frame& F, int tid, int c, int h, GmlpPref& R) {
    const int tg4 = tid >> 4, cg = tid & 15, t0 = c * CHK;
    const bf16* Z = (const bf16*)((uchar*)F.ap->ws + WS_Z);
#pragma unroll
    for (int j = 0; j < 4; ++j) { const bf16* zr = Z + (size_t)(t0 + 4 * tg4 + j) * NZO + 128 * h + 8 * cg;
        R.uu[j] = __builtin_nontemporal_load((const u32x4*)zr); R.gv[j] = __builtin_nontemporal_load((const u32x4*)(zr + DG)); }
    if (tid < 128) { const f32x4* vp = (const f32x4*)((uchar*)F.ap->ws + WS_VST) + (size_t)(t0 + tid) * 8;
#pragma unroll
        for (int k = 0; k < 8; ++k) R.st[k] = vp[k]; }
}
__device__ __forceinline__ void gmlp_phase(Frame& F) {
    const int tid0 = F.tid, w = F.wave;
    bf16* Y = (bf16*)((uchar*)F.ap->ws + WS_Y); float* SSA = (float*)((uchar*)F.ap->ws + WS_SSA);
    LAS f32x2* stat = (LAS f32x2*)(F.lds + MISC_STAT); LAS float* part = (LAS float*)(F.lds + MISC_PART);
    int cur = -1; float gsc[8], bsc[8], bsv[8];
    GmlpPref R;
    int u = F.bid;
    if (u < 2048) gmlp_prefetch(F, tid0, u >> 3, u & 7, R);
    for (; u < 2048; u += F.G) { const int h = u & 7, c = u >> 3, t0 = c * CHK;
        int tid = tid0; asm volatile("" : "+v"(tid));
        const int lane = tid & 63, fr = lane & 15, fq = lane >> 4, tg4 = tid >> 4, cg = tid & 15;
        if (h != cur) {
            __syncthreads(); load_img(F.lds + IMG1, (const bf16*)((uchar*)F.ap->ws + WS_WSM) + (size_t)h * 16384, tid); cur = h;
            const float* lg = F.ap->in[4] + 128 * h + 8 * cg; const float* lb = F.ap->in[5] + 128 * h + 8 * cg;
            const f32x4 g0 = *(const f32x4*)lg, g1 = *(const f32x4*)(lg + 4), b0 = *(const f32x4*)lb, b1 = *(const f32x4*)(lb + 4);
            gsc[0] = g0.x; gsc[1] = g0.y; gsc[2] = g0.z; gsc[3] = g0.w; gsc[4] = g1.x; gsc[5] = g1.y; gsc[6] = g1.z; gsc[7] = g1.w;
            bsc[0] = b0.x; bsc[1] = b0.y; bsc[2] = b0.z; bsc[3] = b0.w; bsc[4] = b1.x; bsc[5] = b1.y; bsc[6] = b1.z; bsc[7] = b1.w;
            const float* bs = F.ap->in[7] + h * CHK;
#pragma unroll
            for (int T = 0; T < 8; ++T) bsv[T] = bs[16 * T + fr];
        }
        if (tid < 128) { float s = 0.f, q = 0.f;
#pragma unroll
            for (int k = 0; k < 8; ++k) { s += R.st[k].x + R.st[k].z; q += R.st[k].y + R.st[k].w; }
            const float mean = s * (1.0f / DG); float var = q * (1.0f / DG) - mean * mean; var = var > 0.f ? var : 0.f;
            stat[tid] = (f32x2){mean, __builtin_amdgcn_rsqf(var + EPS)}; }
        __syncthreads();
        {
            float nv[4][8];
#pragma unroll
            for (int j = 0; j < 4; ++j) { const f32x2 st = stat[4 * tg4 + j]; const unsigned wv[4] = {R.gv[j].x, R.gv[j].y, R.gv[j].z, R.gv[j].w};
#pragma unroll
                for (int k = 0; k < 4; ++k) { nv[j][2 * k] = (bflo(wv[k]) - st.x) * st.y * gsc[2 * k] + bsc[2 * k]; nv[j][2 * k + 1] = (bfhi(wv[k]) - st.x) * st.y * gsc[2 * k + 1] + bsc[2 * k + 1]; } }
#pragma unroll
            for (int cc = 0; cc < 8; ++cc) { const int d = 8 * cg + cc; u32x2 o; o.x = pk2(nv[0][cc], nv[1][cc]); o.y = pk2(nv[2][cc], nv[3][cc]);
                *(LAS u32x2*)(F.lds + IMG0 + d * 256 + (((tg4 >> 1) ^ sw16(d)) << 4) + (tg4 & 1) * 8) = o; }
#pragma unroll
            for (int j = 0; j < 4; ++j) *(LAS u32x4*)(F.lds + IMG2 + img_off(4 * tg4 + j, cg)) = R.uu[j];
        }
        __syncthreads();
        { const int un = u + F.G; if (un < 2048) gmlp_prefetch(F, tid, un >> 3, un & 7, R); }
        f32x4 acc[8];
#pragma unroll
        for (int T = 0; T < 8; ++T) acc[T] = (f32x4){0.f, 0.f, 0.f, 0.f};
        bf16x8 af[4];
        int bk[4];
#pragma unroll
        for (int kk = 0; kk < 4; ++kk) bk[kk] = img_off(fr, 4 * kk + fq);
#pragma unroll
        for (int kk = 0; kk < 4; ++kk) af[kk] = *(const LAS bf16x8*)(F.lds + IMG0 + img_xt(bk[kk], w));
#pragma unroll
        for (int T = 0; T < 8; T += 2) {
#pragma unroll
            for (int TT = T; TT < T + 2; ++TT)
#pragma unroll
                for (int kk = 0; kk <= (TT >> 1); ++kk) { const bf16x8 bfr = *(const LAS bf16x8*)(F.lds + IMG1 + img_xt(bk[kk], TT));
                    acc[TT] = __builtin_amdgcn_mfma_f32_16x16x32_bf16(af[kk], bfr, acc[TT], 0, 0, 0); }
            __builtin_amdgcn_sched_barrier(0); }
        u32x2 ow[8];
        const int o0 = img_off(fr, 2 * w + (fq >> 1)) + (fq & 1) * 8;
#pragma unroll
        for (int T = 0; T < 8; ++T) { const int t = 16 * T + fr;
            const int o = img_xt(o0, T);
            const u32x2 uw = *(const LAS u32x2*)(F.lds + IMG2 + o);
            const float y0 = bflo(uw.x) * (acc[T][0] + bsv[T]), y1 = bfhi(uw.x) * (acc[T][1] + bsv[T]);
            const float y2 = bflo(uw.y) * (acc[T][2] + bsv[T]), y3 = bfhi(uw.y) * (acc[T][3] + bsv[T]);
            float q = (y0 * y0 + y1 * y1) + (y2 * y2 + y3 * y3);
            ow[T].x = pk2(y0, y1); ow[T].y = pk2(y2, y3);
            q += __shfl_xor(q, 16); q += __shfl_xor(q, 32);
            if (fq == 0) part[w * 128 + t] = q; }
#pragma unroll
        for (int T = 0; T < 8; T += 2) { u32x2 a = ow[T], b = ow[T + 1];
            { const auto r = __builtin_amdgcn_permlane16_swap(a.x, b.x, false, false); a.x = r[0]; b.x = r[1]; }
            { const auto r = __builtin_amdgcn_permlane16_swap(a.y, b.y, false, false); a.y = r[0]; b.y = r[1]; }
            const int t = 16 * (T + (fq & 1)) + fr;
            *(u32x4*)(Y + (size_t)(t0 + t) * DM + 128 * h + 16 * w + 8 * (fq >> 1)) = (u32x4){a.x, a.y, b.x, b.y}; }
        __syncthreads();
        if (tid < 128) { float s = 0.f;
#pragma unroll
            for (int k = 0; k < 8; ++k) s += part[k * 128 + tid];
            SSA[(size_t)(t0 + tid) * 8 + h] = s; }
    }
    __syncthreads();
}

struct LruPref { u32x4 xb[7], gg[4]; };
constexpr int MISC_CW = MISC + 9728;
__device__ __forceinline__ void lru_prefetch(Frame& F, int tid, int c, int h, LruPref& R) {
    const int tg4 = tid >> 4, cg = tid & 15, t0 = c * CHK;
    typedef const __attribute__((address_space(1))) char* gcp; typedef const __attribute__((address_space(1))) u32x4* gvp;
    gcp zb = (gcp)((uchar*)F.ap->ws + WS_Z) + ((long)(t0 - 3) * NZO + 2 * DG + 128 * h) * 2; asm volatile("" : "+s"(zb));
    const unsigned lo = (unsigned)((4 * tg4) * NZO + 8 * cg) * 2u;
#pragma unroll
    for (int k = 0; k < 7; ++k) R.xb[k] = __builtin_nontemporal_load((gvp)(zb + (lo + (unsigned)(k * NZO * 2))));
#pragma unroll
    for (int j = 0; j < 4; ++j) R.gg[j] = __builtin_nontemporal_load((gvp)(zb + (lo + (unsigned)(((3 + j) * NZO + DG) * 2))));
}
__device__ __forceinline__ void lru_phase(Frame& F) {
    const int tid0 = F.tid, w = F.wave;
    bf16* Y = (bf16*)((uchar*)F.ap->ws + WS_Y); float* SSB = (float*)((uchar*)F.ap->ws + WS_SSB);
    unsigned long long* AGG = (unsigned long long*)((uchar*)F.ap->ws + WS_AGG);
    unsigned* ctl = (unsigned*)F.ap->ws;
    LAS float* part = (LAS float*)(F.lds + MISC_PART); LAS f32x2* cpart = (LAS f32x2*)(F.lds + MISC_CPART);
    int cur = -1;
    LruPref R;
    unsigned pk[8][4];
    int pc = -1, ph = 0;
    int u = F.bid;
    if (u < 2048) lru_prefetch(F, tid0, u >> 3, u & 7, R);
    for (;; u += F.G) {
        const bool live = u < 2048;
        if (!live && pc < 0) break;
        const int h = u & 7, c = u >> 3, t0 = c * CHK, tseq0 = t0 & (SEQ - 1);
        int tid = tid0; asm volatile("" : "+v"(tid));
        const int lane = tid & 63, fr = lane & 15, fq = lane >> 4, tg4 = tid >> 4, cg = tid & 15;
        const int chl = 16 * w + 4 * fq;
        const int pcs = pc & 63, pcb0 = pc - pcs;
        asm volatile("" : "+v"(R.xb[0]), "+v"(R.xb[1]), "+v"(R.xb[2]), "+v"(R.xb[3]), "+v"(R.xb[4]), "+v"(R.xb[5]), "+v"(R.xb[6]), "+v"(R.gg[0]), "+v"(R.gg[1]), "+v"(R.gg[2]), "+v"(R.gg[3]));
        f32x4 pba, pbx, plm;
        if (live) {
            if (h != cur) {
                __syncthreads(); load_img(F.lds + IMG1, (const bf16*)((uchar*)F.ap->ws + WS_WA) + (size_t)h * 16384, tid); load_img(F.lds + IMG2, (const bf16*)((uchar*)F.ap->ws + WS_WX) + (size_t)h * 16384, tid); cur = h;
                for (int i = tid; i < 640; i += NTHR) { const int k = i >> 7, chn = i & 127; ((LAS float*)(F.lds + MISC_CW))[i] = (k < 4) ? F.ap->in[8][k * DL + 128 * h + chn] : F.ap->in[9][128 * h + chn]; }
                __syncthreads(); }
            pba = *(const f32x4*)(F.ap->in[11] + 128 * h + chl); pbx = *(const f32x4*)(F.ap->in[13] + 128 * h + chl); plm = *(const f32x4*)((const float*)((uchar*)F.ap->ws + WS_SPT) + 128 * h + chl);
        }
        unsigned long long ab[16]; int nv = 0;
        asm volatile("" ::: "memory");
        if (pc >= 0) {
            const int ch = tid & 127, pt = __builtin_amdgcn_readfirstlane(tid >> 7);
            nv = pcs - 16 * pt; nv = nv < 0 ? 0 : (nv > 16 ? 16 : nv);
            const unsigned long long* ab0 = AGG + (size_t)(pcb0 + 16 * pt) * DL + 128 * ph + ch;
#pragma unroll
            for (int i = 0; i < 16; ++i) if (__builtin_expect(i < nv, 1)) ab[i] = __hip_atomic_load(ab0 + (size_t)i * DL, __ATOMIC_RELAXED, __HIP_MEMORY_SCOPE_AGENT);
        }
        asm volatile("" ::: "memory");
        if (live) {
            {
                float xc[4][8], wk[4][8], cbv[8];
                { const LAS f32x4* cwt = (const LAS f32x4*)(F.lds + MISC_CW) + 2 * cg;
#pragma unroll
                  for (int k = 0; k < 4; ++k) { const f32x4 a = cwt[k * 32], b = cwt[k * 32 + 1]; wk[k][0] = a.x; wk[k][1] = a.y; wk[k][2] = a.z; wk[k][3] = a.w; wk[k][4] = b.x; wk[k][5] = b.y; wk[k][6] = b.z; wk[k][7] = b.w; }
                  const f32x4 a = cwt[4 * 32], b = cwt[4 * 32 + 1]; cbv[0] = a.x; cbv[1] = a.y; cbv[2] = a.z; cbv[3] = a.w; cbv[4] = b.x; cbv[5] = b.y; cbv[6] = b.z; cbv[7] = b.w; }
#pragma unroll
                for (int j = 0; j < 4; ++j)
#pragma unroll
                    for (int e = 0; e < 8; ++e) xc[j][e] = cbv[e];
                if (tseq0 == 0) {
#pragma unroll
                    for (int k = 0; k < 3; ++k) if (4 * tg4 - 3 + k < 0) R.xb[k] = (u32x4){0u, 0u, 0u, 0u}; }
#pragma unroll
                for (int k = 0; k < 7; ++k) { const unsigned wv[4] = {R.xb[k].x, R.xb[k].y, R.xb[k].z, R.xb[k].w};
#pragma unroll
                    for (int e2 = 0; e2 < 4; ++e2) { const float lo_ = bflo(wv[e2]), hi_ = bfhi(wv[e2]);
#pragma unroll
                        for (int j = 0; j < 4; ++j) { const int kw = k - j; if (kw >= 0 && kw < 4) { xc[j][2 * e2] += wk[kw][2 * e2] * lo_; xc[j][2 * e2 + 1] += wk[kw][2 * e2 + 1] * hi_; } } } }
#pragma unroll
                for (int j = 0; j < 4; ++j) { u32x4 o; o.x = pk2(xc[j][0], xc[j][1]); o.y = pk2(xc[j][2], xc[j][3]); o.z = pk2(xc[j][4], xc[j][5]); o.w = pk2(xc[j][6], xc[j][7]);
                    *(LAS u32x4*)(F.lds + IMG0 + img_off(4 * tg4 + j, cg)) = o;
                    *(LAS u32x4*)(F.lds + IMG3 + img_off(4 * tg4 + j, cg)) = R.gg[j]; }
            }
        }
        asm volatile("" : "+v"(pba), "+v"(pbx), "+v"(plm));
        if (pc >= 0) {
            { const int ch = tid & 127, pt = __builtin_amdgcn_readfirstlane(tid >> 7);
              const unsigned long long* ab0 = AGG + (size_t)(pcb0 + 16 * pt) * DL + 128 * ph + ch;
              for (unsigned spins = 0;; ++spins) {
                  bool ok = true;
#pragma unroll
                  for (int i = 0; i < 16; ++i) if (i < nv) ok = ok && ((unsigned)ab[i] != 0u);
                  if (__all(ok)) break;
                  if (spins > (1u << 17)) { if (lane == 0) __hip_atomic_store(ctl + CW_TMO2, 1u, __ATOMIC_RELAXED, __HIP_MEMORY_SCOPE_AGENT); break; }
                  __builtin_amdgcn_s_sleep(1);
#pragma unroll
                  for (int i = 0; i < 16; ++i) if (i < nv) { if ((unsigned)ab[i] == 0u) ab[i] = __hip_atomic_load(ab0 + (size_t)i * DL, __ATOMIC_RELAXED, __HIP_MEMORY_SCOPE_AGENT); }
              }
              float A = 1.f, B = 0.f;
#pragma unroll
              for (int i = 0; i < 16; ++i) if (i < nv) { const float ax = __uint_as_float((unsigned)ab[i]), bxv = __uint_as_float((unsigned)(ab[i] >> 32)); B = ax * B + bxv; A = ax * A; }
              cpart[pt * 128 + ch] = (f32x2){A, B}; }
            __syncthreads();
            float H[4];
#pragma unroll
            for (int r = 0; r < 4; ++r) { float hh = 0.f;
#pragma unroll
                for (int p = 0; p < 4; ++p) { const f32x2 abp = cpart[p * 128 + chl + r]; hh = abp.x * hh + abp.y; }
                H[r] = hh; }
            const int pt0 = pc * CHK;
            u32x2 ow[8];
#pragma unroll
            for (int T = 0; T < 8; ++T) { const int t = 16 * T + fr;
                const float y0 = bflo(pk[T][0]) * H[0] + bfhi(pk[T][0]), y1 = bflo(pk[T][1]) * H[1] + bfhi(pk[T][1]);
                const float y2 = bflo(pk[T][2]) * H[2] + bfhi(pk[T][2]), y3 = bflo(pk[T][3]) * H[3] + bfhi(pk[T][3]);
                float q = (y0 * y0 + y1 * y1) + (y2 * y2 + y3 * y3);
                ow[T].x = pk2(y0, y1); ow[T].y = pk2(y2, y3);
                q += __shfl_xor(q, 16); q += __shfl_xor(q, 32);
                if (fq == 0) part[w * 128 + t] = q; }
#pragma unroll
            for (int T = 0; T < 8; T += 2) { u32x2 a = ow[T], b = ow[T + 1];
                { const auto r = __builtin_amdgcn_permlane16_swap(a.x, b.x, false, false); a.x = r[0]; b.x = r[1]; }
                { const auto r = __builtin_amdgcn_permlane16_swap(a.y, b.y, false, false); a.y = r[0]; b.y = r[1]; }
                const int t = 16 * (T + (fq & 1)) + fr;
                *(u32x4*)(Y + (size_t)(pt0 + t) * DM + DG + 128 * ph + 16 * w + 8 * (fq >> 1)) = (u32x4){a.x, a.y, b.x, b.y}; }
        }
        __syncthreads();
        if (pc >= 0) { if (tid < 128) { float s = 0.f;
#pragma unroll
            for (int k = 0; k < 8; ++k) s += part[k * 128 + tid];
            SSB[(size_t)(pc * CHK + tid) * 8 + ph] = s; } }
        pc = -1;
        if (!live) break;
        { const int un = u + F.G; if (un < 2048) lru_prefetch(F, tid, un >> 3, un & 7, R); }
        f32x4 accA[8], accX[8];
#pragma unroll
        for (int T = 0; T < 8; ++T) { accA[T] = (f32x4){0.f, 0.f, 0.f, 0.f}; accX[T] = (f32x4){0.f, 0.f, 0.f, 0.f}; }
        {
            bf16x8 afa[4], afx[4], b0[4], b1[4];
            int bk[4];
#pragma unroll
            for (int kk = 0; kk < 4; ++kk) bk[kk] = img_off(fr, 4 * kk + fq);
#pragma unroll
            for (int kk = 0; kk < 4; ++kk) { afa[kk] = *(const LAS bf16x8*)(F.lds + IMG1 + img_xt(bk[kk], w)); afx[kk] = *(const LAS bf16x8*)(F.lds + IMG2 + img_xt(bk[kk], w)); }
#define LRU_LDB(dst, T) do { _Pragma("unroll") for (int kk = 0; kk < 4; ++kk) dst[kk] = *(const LAS bf16x8*)(F.lds + IMG0 + img_xt(bk[kk], (T))); } while (0)
#define LRU_MMA(src, T) do { _Pragma("unroll") for (int kk = 0; kk < 4; ++kk) { accA[T] = __builtin_amdgcn_mfma_f32_16x16x32_bf16(afa[kk], src[kk], accA[T], 0, 0, 0); \
                accX[T] = __builtin_amdgcn_mfma_f32_16x16x32_bf16(afx[kk], src[kk], accX[T], 0, 0, 0); } } while (0)
            LRU_LDB(b0, 0);
#pragma unroll
            for (int T = 0; T < 8; T += 2) {
                LRU_LDB(b1, T + 1); __builtin_amdgcn_sched_barrier(0); LRU_MMA(b0, T); __builtin_amdgcn_sched_barrier(0);
                if (T + 2 < 8) LRU_LDB(b0, T + 2);
                __builtin_amdgcn_sched_barrier(0); LRU_MMA(b1, T + 1); __builtin_amdgcn_sched_barrier(0); }
#undef LRU_LDB
#undef LRU_MMA
        }
        {
            float P[4], Q[4], ba[4], bx[4], sp[4];
            { const float av[4] = {pba.x, pba.y, pba.z, pba.w}, bv[4] = {pbx.x, pbx.y, pbx.z, pbx.w}, lmv[4] = {plm.x, plm.y, plm.z, plm.w};
#pragma unroll
              for (int r = 0; r < 4; ++r) { sp[r] = lmv[r];
                  ba[r] = av[r] * -1.44269504f; bx[r] = bv[r] * -1.44269504f; P[r] = 1.f; Q[r] = 0.f; } }
            const int o0 = img_off(fr, 2 * w + (fq >> 1)) + (fq & 1) * 8;
#pragma unroll
            for (int T = 0; T < 8; ++T) { const int t = 16 * T + fr; const bool first = (tseq0 + t) == 0;
                const int o = img_xt(o0, T);
                const u32x2 xw = *(const LAS u32x2*)(F.lds + IMG0 + o), gw = *(const LAS u32x2*)(F.lds + IMG3 + o);
                const f32x2 g01 = (f32x2){bflo(gw.x), bfhi(gw.x)}, g23 = (f32x2){bflo(gw.y), bfhi(gw.y)};
                const float xcv[4] = {bflo(xw.x), bfhi(xw.x), bflo(xw.y), bfhi(xw.y)}, gvv[4] = {g01.x, g01.y, g23.x, g23.y};
                float A[4], B[4], At[4], Bt[4];
                {
#pragma unroll
                    for (int hp = 0; hp < 2; ++hp) { const int r0 = 2 * hp, r1 = 2 * hp + 1;
                        const f32x2 ta = (f32x2){accA[T][r0], accA[T][r1]} * (-1.44269504f) + (f32x2){ba[r0], ba[r1]}, tx = (f32x2){accX[T][r0], accX[T][r1]} * (-1.44269504f) + (f32x2){bx[r0], bx[r1]};
                        f32x2 ea, ex; ea.x = __builtin_amdgcn_exp2f(ta.x); ea.y = __builtin_amdgcn_exp2f(ta.y); ex.x = __builtin_amdgcn_exp2f(tx.x); ex.y = __builtin_amdgcn_exp2f(tx.y);
                        const f32x2 da = ea + 1.0f, dx = ex + 1.0f;
                        f32x2 rg, ig; rg.x = __builtin_amdgcn_rcpf(da.x); rg.y = __builtin_amdgcn_rcpf(da.y); ig.x = __builtin_amdgcn_rcpf(dx.x); ig.y = __builtin_amdgcn_rcpf(dx.y);
                        const f32x2 la = (f32x2){sp[r0], sp[r1]} * rg;
                        f32x2 a; a.x = __builtin_amdgcn_exp2f(la.x); a.y = __builtin_amdgcn_exp2f(la.y);
                        const f32x2 m2 = 1.0f - a * a;
                        f32x2 mult; mult.x = __builtin_amdgcn_sqrtf(m2.x); mult.y = __builtin_amdgcn_sqrtf(m2.y);
                        if (first) mult = (f32x2){1.0f, 1.0f};
                        const f32x2 b = mult * (ig * (f32x2){xcv[r0], xcv[r1]});
                        A[r0] = a.x; A[r1] = a.y; B[r0] = b.x; B[r1] = b.y; }
                }
#define LRU_SCAN_STEP(K) \
                    "v_fmac_f32_dpp %4, %4, %0 row_shr:" #K " row_mask:0xf bank_mask:0xf\n\t" "v_fmac_f32_dpp %5, %5, %1 row_shr:" #K " row_mask:0xf bank_mask:0xf\n\t" \
                    "v_fmac_f32_dpp %6, %6, %2 row_shr:" #K " row_mask:0xf bank_mask:0xf\n\t" "v_fmac_f32_dpp %7, %7, %3 row_shr:" #K " row_mask:0xf bank_mask:0xf\n\t" \
                    "v_mul_f32_dpp %0, %0, %0 row_shr:" #K " row_mask:0xf bank_mask:0xf\n\t" "v_mul_f32_dpp %1, %1, %1 row_shr:" #K " row_mask:0xf bank_mask:0xf\n\t" \
                    "v_mul_f32_dpp %2, %2, %2 row_shr:" #K " row_mask:0xf bank_mask:0xf\n\t" "v_mul_f32_dpp %3, %3, %3 row_shr:" #K " row_mask:0xf bank_mask:0xf\n\t"
                asm volatile("s_nop 1\n\t"
                    LRU_SCAN_STEP(1) LRU_SCAN_STEP(2) LRU_SCAN_STEP(4) LRU_SCAN_STEP(8)
                    "v_mov_b32_dpp %8, %0 row_newbcast:15 row_mask:0xf bank_mask:0xf\n\t" "v_mov_b32_dpp %9, %1 row_newbcast:15 row_mask:0xf bank_mask:0xf\n\t"
                    "v_mov_b32_dpp %10, %2 row_newbcast:15 row_mask:0xf bank_mask:0xf\n\t" "v_mov_b32_dpp %11, %3 row_newbcast:15 row_mask:0xf bank_mask:0xf\n\t"
                    "v_mov_b32_dpp %12, %4 row_newbcast:15 row_mask:0xf bank_mask:0xf\n\t" "v_mov_b32_dpp %13, %5 row_newbcast:15 row_mask:0xf bank_mask:0xf\n\t"
                    "v_mov_b32_dpp %14, %6 row_newbcast:15 row_mask:0xf bank_mask:0xf\n\t" "v_mov_b32_dpp %15, %7 row_newbcast:15 row_mask:0xf bank_mask:0xf\n\t"
                    "s_nop 0"
                    : "+v"(A[0]), "+v"(A[1]), "+v"(A[2]), "+v"(A[3]), "+v"(B[0]), "+v"(B[1]), "+v"(B[2]), "+v"(B[3]),
                      "=&v"(At[0]), "=&v"(At[1]), "=&v"(At[2]), "=&v"(At[3]), "=&v"(Bt[0]), "=&v"(Bt[1]), "=&v"(Bt[2]), "=&v"(Bt[3]));
#undef LRU_SCAN_STEP
#pragma unroll
                for (int hp = 0; hp < 2; ++hp) { const int r0 = 2 * hp, r1 = 2 * hp + 1;
                    const f32x2 Av = (f32x2){A[r0], A[r1]}, Bv = (f32x2){B[r0], B[r1]}, Pv = (f32x2){P[r0], P[r1]}, Qv = (f32x2){Q[r0], Q[r1]}, gv2 = (f32x2){gvv[r0], gvv[r1]}, Atv = (f32x2){At[r0], At[r1]}, Btv = (f32x2){Bt[r0], Bt[r1]};
                    const f32x2 acc_ = Av * Pv * gv2, bcc_ = (Av * Qv + Bv) * gv2;
                    pk[T][r0] = pk2(acc_.x, bcc_.x); pk[T][r1] = pk2(acc_.y, bcc_.y);
                    const f32x2 Qn = Atv * Qv + Btv, Pn = Atv * Pv; Q[r0] = Qn.x; Q[r1] = Qn.y; P[r0] = Pn.x; P[r1] = Pn.y; }
                if (T & 1) __builtin_amdgcn_sched_barrier(0);
            }
            if (fr == 0) {
#pragma unroll
                for (int r = 0; r < 4; ++r) __hip_atomic_store(AGG + (size_t)c * DL + 128 * h + chl + r, ((unsigned long long)__float_as_uint(Q[r]) << 32) | __float_as_uint(fmaxf(P[r], 1e-37f)), __ATOMIC_RELAXED, __HIP_MEMORY_SCOPE_AGENT); }
        }
        __syncthreads();
        pc = c; ph = h;
    }
    __syncthreads();
}

#define XB_TMO      128
#define XB_XCNT(j)  (256  + 64 * (j))
#define XB_XSUB(j)  (1280 + 64 * (j))
#define XB_XGEN(j)  (2304 + 64 * (j))
#define XB_TOP      3328
#define XB_TOPGEN   3392
#define XCD_BAR_WORDS 3456
#define XB_SPIN_CAP (1u << 18)
constexpr int LDS_BARST = MISC + 15 * 1024;
__device__ __forceinline__ unsigned xb_ld(unsigned* p)              { return __hip_atomic_load(p, __ATOMIC_RELAXED, __HIP_MEMORY_SCOPE_AGENT); }
__device__ __forceinline__ unsigned xb_add(unsigned* p, unsigned v) { return __hip_atomic_fetch_add(p, v, __ATOMIC_RELAXED, __HIP_MEMORY_SCOPE_AGENT); }
__device__ __forceinline__ unsigned xb_xcc_id() { return (unsigned)__builtin_amdgcn_s_getreg((3 << 11) | 20) & 0xFu; }
#define XB_SPIN(cond, bar) do { unsigned _sp = 0; while (cond) { __builtin_amdgcn_s_sleep(1); \
    if ((++_sp & 255u) == 0u) { if (xb_ld(&(bar)[XB_TMO])) break; if (_sp > XB_SPIN_CAP) { atomicAdd(&(bar)[XB_TMO], 1u); break; } } } } while (0)
__device__ __forceinline__ void xcd_barrier_complete(unsigned* bar, unsigned x, unsigned& nloc, unsigned& nx) {
    const unsigned G = gridDim.x;
    unsigned sum, cnt, mine, sp = 0u;
    for (;;) {
        sum = 0u; cnt = 0u; mine = 0u;
#pragma unroll
        for (unsigned j = 0; j < 16; ++j) { const unsigned c = xb_ld(&bar[XB_XCNT(j)]); sum += c; cnt += (c > 0u) ? 1u : 0u; mine = (j == x) ? c : mine; }
        if (sum == G) break;
        __builtin_amdgcn_s_sleep(1);
        if ((++sp & 255u) == 0u) { if (xb_ld(&bar[XB_TMO])) break; if (sp > XB_SPIN_CAP) { atomicAdd(&bar[XB_TMO], 1u); break; } }
    }
    nloc = mine > 0u ? mine : 1u; nx = cnt > 0u ? cnt : 1u;
}
__device__ __forceinline__ void xcd_barrier(unsigned* bar, volatile LAS unsigned* st, int tid) {
    asm volatile("s_waitcnt vmcnt(0)" ::: "memory");
    __syncthreads();
    if (tid == 0) {
        const unsigned x = xb_xcc_id();
        __builtin_amdgcn_s_waitcnt(0);
        unsigned nloc = st[0], nx = st[1];
        if (nloc == 0u) { xcd_barrier_complete(bar, x, nloc, nx); st[0] = nloc; st[1] = nx; }
        const unsigned old = xb_add(&bar[XB_XSUB(x)], 1u);
        const unsigned gen = old / nloc;
        if (old + 1u == (gen + 1u) * nloc) {
            __builtin_amdgcn_fence(__ATOMIC_RELEASE, "agent");
            asm volatile("s_waitcnt vmcnt(0)" ::: "memory");
            const unsigned og = xb_add(&bar[XB_TOP], 1u);
            const unsigned tg = og / nx;
            if (og + 1u == (tg + 1u) * nx) xb_add(&bar[XB_TOPGEN], 1u);
            else XB_SPIN(xb_ld(&bar[XB_TOPGEN]) == tg, bar);
            __builtin_amdgcn_fence(__ATOMIC_ACQUIRE, "agent");
            xb_add(&bar[XB_XGEN(x)], 1u);
            asm volatile("s_waitcnt vmcnt(0)" ::: "memory");
        } else {
            XB_SPIN(xb_ld(&bar[XB_XGEN(x)]) == gen, bar);
            __builtin_amdgcn_fence(__ATOMIC_ACQUIRE, "agent");
            asm volatile("s_waitcnt vmcnt(0)" ::: "memory");
        }
    }
    __syncthreads();
}

__global__ void __launch_bounds__(NTHR, 2) mk_fwd(Args args_unused) {
    extern __shared__ __attribute__((aligned(16))) unsigned char lds_raw[];
    Frame F;
    F.lds = (LAS uchar*)lds_raw; F.G = gridDim.x; F.bid = blockIdx.x; F.wv = __builtin_amdgcn_readfirstlane((int)threadIdx.x >> 6);
    PHASE_BEGIN(F);
    const int lo = F.ap->ph_lo, hi = F.ap->ph_hi;
#define IN(k) (lo <= (k) && (k) < hi)
#if MK_N_LAUNCHES == 1
#define SEAM(k) do { if (IN(k) && IN((k) + 1)) { PHASE_BEGIN(F); xcd_barrier((unsigned*)F.ap->ws, (volatile LAS unsigned*)(F.lds + LDS_BARST), F.tid); } } while (0)
#else
#define SEAM(k) do { } while (0)
#endif
#define WSB(off) ((bf16*)((uchar*)F.ap->ws + (off)))
#define WSF(off) ((float*)((uchar*)F.ap->ws + (off)))

    if (F.tid < 2) ((volatile LAS unsigned*)(F.lds + LDS_BARST))[F.tid] = 0u;
#if MK_N_LAUNCHES == 1 && !MK_CG_SYNC
    if (F.tid == 0) (void)xb_add((unsigned*)F.ap->ws + XB_XCNT(xb_xcc_id()), 1u);
#endif
    if (IN(0)) {
#if MK_N_LAUNCHES == 1 && MK_CG_SYNC
        if (F.bid == 0) { unsigned* bw = (unsigned*)F.ap->ws; for (int i = F.tid; i < CTL_WORDS; i += NTHR) __hip_atomic_store(bw + i, 0u, __ATOMIC_RELAXED, __HIP_MEMORY_SCOPE_AGENT); }
#endif
        REPS(0) { p0_prologue(F); __syncthreads(); } }
#if MK_N_LAUNCHES == 1 && MK_CG_SYNC
    cg::this_grid().sync();
    PHASE_BEGIN(F);
    if (F.tid == 0) (void)xb_add((unsigned*)F.ap->ws + XB_XCNT(xb_xcc_id()), 1u);
#else
    SEAM(0);
#endif
    if (IN(1)) REPS(1) {
        PHASE_BEGIN(F);
#if PROBE_KLOOP
        { pg8::Gemm g{WSB(WS_A1), WSB(WS_WIN), M, NZ, DM}; pg8::RepOrder S; S.init(M, NZ, F.G, F.bid);
          pg8::EpiZ E{WSB(WS_Z), NZO, (pg8::f32x2*)WSF(WS_VST), 0};
          pg8::gemm_phase<pg8::EpiZ, pg8::RepOrder, true, true>(F.lds, g, S, E, F.tid); }
#else
        { pg8::Gemm g{WSB(WS_A1), WSB(WS_WIN), M, NZ, DM}; pg8::StaticOrder S; S.init(M, NZ, F.G, F.bid);
          pg8::EpiZ E{WSB(WS_Z), NZO, (pg8::f32x2*)WSF(WS_VST), 0};
          pg8::gemm_phase<pg8::EpiZ, pg8::StaticOrder, true, true>(F.lds, g, S, E, F.tid); }
#endif
    }
    SEAM(1);
    if (IN(2)) {
        if ((F.bid & 7) < 4) { REPS(4) { PHASE_BEGIN(F); lru_phase(F); } REPS(2) { PHASE_BEGIN(F); gmlp_phase(F); } }
        else                 { REPS(2) { PHASE_BEGIN(F); gmlp_phase(F); } REPS(4) { PHASE_BEGIN(F); lru_phase(F); } }
    }
    SEAM(2);
    if (IN(5)) REPS(5) {
        PHASE_BEGIN(F);
        pg8::PanelOrder S; S.init(M, DM, F.G, F.bid);
        {
            const float* SSA = WSF(WS_SSA); const float* SSB = WSF(WS_SSB); LAS f32x2* rr = (LAS f32x2*)(F.lds + MISC);
            f32x4 a0[2], a1[2], b0[2], b1[2]; bool ok[2];
#pragma unroll
            for (int k = 0; k < 2; ++k) { pg8::Unit u; ok[k] = S.next((F.tid >> 8) + 2 * k, u); const size_t row = (size_t)(ok[k] ? u.pm : 0) * 256 + (F.tid & 255);
                a0[k] = *(const f32x4*)(SSA + row * 8); a1[k] = *(const f32x4*)(SSA + row * 8 + 4); b0[k] = *(const f32x4*)(SSB + row * 8); b1[k] = *(const f32x4*)(SSB + row * 8 + 4); }
#pragma unroll
            for (int k = 0; k < 2; ++k) {
                const float ra = 1.0f / sqrtf(((a0[k].x + a0[k].y) + (a0[k].z + a0[k].w) + (a1[k].x + a1[k].y) + (a1[k].z + a1[k].w)) * (1.0f / DG) + EPS);
                const float rb = 1.0f / sqrtf(((b0[k].x + b0[k].y) + (b0[k].z + b0[k].w) + (b1[k].x + b1[k].y) + (b1[k].z + b1[k].w)) * (1.0f / DL) + EPS);
                if (ok[k]) rr[((F.tid >> 8) + 2 * k) * 256 + (F.tid & 255)] = (f32x2){ra / rb, rb}; }
            __syncthreads();
        }
        pg8::Gemm g{WSB(WS_Y), WSB(WS_WOUT), M, DM, DM};
        pg8::EpiH E(WSB(WS_A3), K3, WSB(WS_A1), DM, WSF(WS_SX), F.ap->in[18], (const LAS pg8::f32x2*)(F.lds + MISC), (LAS float*)(F.lds + MISC + 8192), (LAS float*)(F.lds + MISC + 12288),
                    WSF(WS_SSO), (unsigned*)F.ap->ws + CW_PCNT, (unsigned*)F.ap->ws + CW_TMO2);
        pg8::gemm_phase<pg8::EpiH, pg8::PanelOrder, true, true>(F.lds, g, S, E, F.tid);
        __syncthreads();
    }
    SEAM(5);
    if (IN(7)) REPS(7) {
        PHASE_BEGIN(F);
#if SKEW7_TICKS > 0
        {
            const unsigned long long t0 = __builtin_amdgcn_s_memrealtime(); const unsigned long long dl = (unsigned long long)(F.bid & 7) * SKEW7_TICKS;
            while (__builtin_amdgcn_s_memrealtime() - t0 < dl) __builtin_amdgcn_s_sleep(8);
        }
#endif
        pg8::Gemm g{WSB(WS_A3), WSB(WS_B3), M, DM, K3}; pg8::StaticOrder S; S.init(M, DM, F.G, F.bid);
        pg8::EpiOut E((float*)F.ap->out, WSB(WS_A3), DM, K3);
        pg8::gemm_phase<pg8::EpiOut, pg8::StaticOrder, true, true>(F.lds, g, S, E, F.tid);
    }
#undef IN
#undef SEAM
}

extern "C" void kernel_launch(void* const* d_in, const int* in_sizes, int n_in, void* d_out, int out_size, void* d_ws, size_t ws_size, hipStream_t stream) {
    static int grid = 0;
    if (grid == 0) {
        if (n_in != 21 || in_sizes[0] != M * DM || out_size != M * DM || ws_size < WS_END) { fprintf(stderr, "kernel_launch: unexpected problem (n_in %d, in0 %d, out %d, ws %zu); nothing launched\n", n_in, n_in > 0 ? in_sizes[0] : -1, out_size, ws_size); grid = -1; return; }
        int dev = 0, cus = 0, per_cu = 0;
        if (hipGetDevice(&dev) != hipSuccess || hipDeviceGetAttribute(&cus, hipDeviceAttributeMultiprocessorCount, dev) != hipSuccess) { fprintf(stderr, "kernel_launch: device query failed\n"); grid = -1; return; }
        if (hipFuncSetAttribute((const void*)mk_fwd, hipFuncAttributeMaxDynamicSharedMemorySize, LDS_BYTES) != hipSuccess) { fprintf(stderr, "kernel_launch: hipFuncSetAttribute failed\n"); grid = -1; return; }
        if (hipOccupancyMaxActiveBlocksPerMultiprocessor(&per_cu, (const void*)mk_fwd, NTHR, LDS_BYTES) != hipSuccess || per_cu < 1) { fprintf(stderr, "kernel_launch: occupancy query says %d blocks per CU\n", per_cu); per_cu = 1; }
        (void)hipGetLastError();
        grid = cus * (per_cu < 1 ? 1 : per_cu);
    }
    if (grid < 0) return;
    Args a{};
    for (int i = 0; i < 21; ++i) a.in[i] = (const float*)d_in[i];
    a.out = (float*)d_out; a.ws = (unsigned char*)d_ws;
#if MK_N_LAUNCHES == 1
    a.ph_lo = 0; a.ph_hi = N_PHASES;
#if MK_CG_SYNC
    void* kargs[] = {&a};
    hipError_t e = hipLaunchCooperativeKernel((const void*)mk_fwd, dim3(grid), dim3(NTHR), kargs, LDS_BYTES, stream);
    if (e != hipSuccess) fprintf(stderr, "kernel_launch: cooperative launch failed: %s (grid %d)\n", hipGetErrorString(e), grid);
#else
    if (hipMemsetAsync(d_ws, 0, CTL_WORDS * 4, stream) != hipSuccess) { fprintf(stderr, "kernel_launch: hipMemsetAsync of the control words failed; nothing launched\n"); return; }
    hipLaunchKernelGGL(mk_fwd, dim3(grid), dim3(NTHR), LDS_BYTES, stream, a);
    { const hipError_t le = hipPeekAtLastError(); if (le != hipSuccess) fprintf(stderr, "kernel_launch: launch failed: %s (grid %d)\n", hipGetErrorName(le), grid); }
#endif
#else
    for (int li = 0; li < N_PHASES; ++li) { a.ph_lo = li; a.ph_hi = li + 1;
        hipLaunchKernelGGL(mk_fwd, dim3(grid), dim3(NTHR), LDS_BYTES, stream, a);
        const hipError_t le = hipPeekAtLastError(); if (le != hipSuccess) { fprintf(stderr, "kernel_launch: launch %d failed: %s\n", li, hipGetErrorName(le)); break; } }
#endif
}
```

```cpp
#define MK_N_LAUNCHES 1
#include <hip/hip_runtime.h>
#include <hip/hip_cooperative_groups.h>
#include <cstdio>
#include <cstdint>
namespace cg = cooperative_groups;
namespace pg8 {
#define PG8_LAS __attribute__((address_space(3)))
typedef unsigned short bf16_t;
typedef short bf16x8 __attribute__((ext_vector_type(8)));
typedef float f32x4 __attribute__((ext_vector_type(4)));
typedef unsigned u32x4 __attribute__((ext_vector_type(4)));
constexpr int BM = 256, BK = 64, HALF = 128, HTB = HALF * BK * 2  , STAGE_BYTES = 8 * HTB, NXCD = 8, WGM = 8;

__host__ __device__ __forceinline__ int lds_byte(int r, int c) { const int st = (r >> 4) * 2 + (c >> 5), rr = r & 15, cc = c & 31, ob = rr * 64 + cc * 2; return st * 1024 + (ob ^ (((ob >> 9) & 1) << 5)); }
__host__ __device__ __forceinline__ void stage_rc(int b, int& R, int& C) { const int st = b / 1024, sb = b % 1024, swz = sb ^ (((sb >> 9) & 1) << 5); R = (st >> 1) * 16 + swz / 64; C = (st & 1) * 32 + (swz % 64) / 2; }
__host__ __device__ __forceinline__ int perm32(int rho) { const int n = rho >> 4, i = rho & 15; return 8 * (i >> 2) + 4 * n + (i & 3); }

struct Unit { int pm, pn; };
struct Gemm { const bf16_t* A; const bf16_t* Bt; int M, N, K; };

struct StaticOrder {
    int nM, nN, nwg, G, c;
    __host__ __device__ void init(int M, int N, int G_, int c_) { nM = M / BM; nN = N / BM; nwg = nM * nN; G = G_; c = c_; }
    __host__ __device__ bool next(int i, Unit& u) const {
        const long L = (long)i * G + c; if (L >= nwg) return false;
        int wgid = (int)L; { const int q = nwg / NXCD, r = nwg % NXCD, xcd = wgid % NXCD, off = wgid / NXCD; wgid = (xcd < r ? xcd * (q + 1) : r * (q + 1) + (xcd - r) * q) + off; }
        const int nig = WGM * nN, gid = wgid / nig, fm = gid * WGM, gsz = (nM - fm) < WGM ? (nM - fm) : WGM;
        u.pm = fm + ((wgid % nig) % gsz); u.pn = (wgid % nig) / gsz; return true;
    }
    __device__ __forceinline__ void a_ready(const Unit&) const {}
    __device__ __forceinline__ void done(const Unit&) const {}
};

__device__ __forceinline__ unsigned cvt_pk_bf16(float lo, float hi) { unsigned r; asm volatile("v_cvt_pk_bf16_f32 %0, %1, %2" : "=v"(r) : "v"(lo), "v"(hi)); return r; }
typedef float f32x2 __attribute__((ext_vector_type(2)));
typedef unsigned u32x2 __attribute__((ext_vector_type(2)));
__device__ __forceinline__ float fast_sigmoid(float x) { return __builtin_amdgcn_rcpf(1.0f + __expf(-x)); }

__device__ __forceinline__ f32x2 gelu2(f32x2 x) { const f32x2 t = x * x; const f32x2 uu = t * (-0.10294323f) + (-2.30220819f); const f32x2 wv = x * uu;
    f32x2 ev; ev.x = __builtin_amdgcn_exp2f(wv.x); ev.y = __builtin_amdgcn_exp2f(wv.y); const f32x2 d = ev + 1.0f; f32x2 r; r.x = __builtin_amdgcn_rcpf(d.x); r.y = __builtin_amdgcn_rcpf(d.y); return x * r; }
__device__ __forceinline__ f32x2 gelu_silu2(f32x2 u, f32x2 g) { const f32x2 t = u * u; const f32x2 uu = t * (-0.10294323f) + (-2.30220819f); const f32x2 wu = u * uu, wg = g * (-1.44269504f);
    f32x2 eu, eg; eu.x = __builtin_amdgcn_exp2f(wu.x); eu.y = __builtin_amdgcn_exp2f(wu.y); eg.x = __builtin_amdgcn_exp2f(wg.x); eg.y = __builtin_amdgcn_exp2f(wg.y);
    const f32x2 d = (eu + 1.0f) * (eg + 1.0f); f32x2 r; r.x = __builtin_amdgcn_rcpf(d.x); r.y = __builtin_amdgcn_rcpf(d.y); return (u * g) * r; }
__device__ __forceinline__ f32x2 silu2(f32x2 x) { const f32x2 wv = x * (-1.44269504f);
    f32x2 ev; ev.x = __builtin_amdgcn_exp2f(wv.x); ev.y = __builtin_amdgcn_exp2f(wv.y); const f32x2 d = ev + 1.0f; f32x2 r; r.x = __builtin_amdgcn_rcpf(d.x); r.y = __builtin_amdgcn_rcpf(d.y); return x * r; }

#ifndef PROBE_KLOOP
#define PROBE_KLOOP 0
#endif
#ifndef PROBE_EPI2
#define PROBE_EPI2 0
#endif
struct RepOrder : StaticOrder { __host__ __device__ bool next(int i, Unit& u) const { return StaticOrder::next(i >> 1, u); } };
struct EpiZ {
    static constexpr bool PERM = true, AFTER_DRAIN = false, MIDSCALE = false, PREFETCH = false, PROBE2 = true;
    bf16_t* Z; int ldc; f32x2* vst;
    mutable int cnt;
    __device__ __forceinline__ void operator()(const f32x4 (&acc)[2][2][4][2], const Unit& u, int wr, int wc, int fr, int fq) const {
#if PROBE_KLOOP
        if ((cnt++ & 1) == 0) return;
#endif
        const int row0 = u.pm * BM + wr * 64 + fr;
        if (u.pn < 8) {
            const int col0 = u.pn * HALF + wc * 32 + 8 * fq;
#pragma unroll
            for (int ai = 0; ai < 2; ++ai)
#pragma unroll
                for (int m = 0; m < 4; ++m) { const int row = row0 + ai * HALF + m * 16; f32x2 p[4];
#pragma unroll
                    for (int n = 0; n < 2; ++n) { const f32x4 a = acc[ai][0][m][n], g = acc[ai][1][m][n];
                        p[2 * n] = gelu_silu2((f32x2){a[0], a[1]}, (f32x2){g[0], g[1]}); p[2 * n + 1] = gelu_silu2((f32x2){a[2], a[3]}, (f32x2){g[2], g[3]}); }
                    u32x4 w; w.x = cvt_pk_bf16(p[0].x, p[0].y); w.y = cvt_pk_bf16(p[1].x, p[1].y); w.z = cvt_pk_bf16(p[2].x, p[2].y); w.w = cvt_pk_bf16(p[3].x, p[3].y);
                    __builtin_nontemporal_store(w, (u32x4*)(Z + (size_t)row * ldc + col0)); }
            return; }
        const int col0 = 1024 + (u.pn - 8) * BM + wc * 32 + 8 * fq;
        const bool isv = (u.pn >> 2) == 2, isg = u.pn >= 16;
#pragma unroll
        for (int ai = 0; ai < 2; ++ai)
#pragma unroll
            for (int m = 0; m < 4; ++m) { const int row = row0 + ai * HALF + m * 16; bf16_t* rowp = Z + (size_t)row * ldc + col0;
                float s = 0.f, q = 0.f;
#pragma unroll
                for (int bj = 0; bj < 2; ++bj) { f32x4 v[2] = {acc[ai][bj][m][0], acc[ai][bj][m][1]};
                    if (isv) {
#pragma unroll
                        for (int n = 0; n < 2; ++n) { const f32x2 a = gelu2((f32x2){v[n][0], v[n][1]}), b = gelu2((f32x2){v[n][2], v[n][3]}); v[n] = (f32x4){a.x, a.y, b.x, b.y};
                            s += (a.x + a.y) + (b.x + b.y); q += (a.x * a.x + a.y * a.y) + (b.x * b.x + b.y * b.y); } }
                    if (isg) {
#pragma unroll
                        for (int n = 0; n < 2; ++n) { const f32x2 a = silu2((f32x2){v[n][0], v[n][1]}), b = silu2((f32x2){v[n][2], v[n][3]}); v[n] = (f32x4){a.x, a.y, b.x, b.y}; } }
                    u32x4 w; w.x = cvt_pk_bf16(v[0][0], v[0][1]); w.y = cvt_pk_bf16(v[0][2], v[0][3]); w.z = cvt_pk_bf16(v[1][0], v[1][1]); w.w = cvt_pk_bf16(v[1][2], v[1][3]);
                    __builtin_nontemporal_store(w, (u32x4*)(rowp + bj * HALF)); }
                if (isv) { s += __shfl_xor(s, 16); s += __shfl_xor(s, 32); q += __shfl_xor(q, 16); q += __shfl_xor(q, 32);
                    if (fq == 0) vst[(size_t)row * 16 + (u.pn - 8) * 4 + wc] = (f32x2){s, q}; }
            }
    }
};

struct PanelOrder {
    int c, G;
    __host__ __device__ void init(int, int, int G_, int c_) { G = G_; c = c_; }
    __host__ __device__ bool next(int i, Unit& u) const { if (i >= 4 || G != 256) return false; const int cls = c & 7, j = c >> 3; u.pm = 16 * cls + 4 * i + (j & 3); u.pn = j >> 2; return true; }
    __device__ __forceinline__ void a_ready(const Unit&) const {}
    __device__ __forceinline__ void done(const Unit&) const {}
};
struct EpiH {
    static constexpr bool PERM = true, AFTER_DRAIN = false, MIDSCALE = true, PROBE2 = false;
    bf16_t* H; int ldh; const bf16_t* xa; int ldx; const float* sx; const float* pg; const PG8_LAS f32x2* rr; PG8_LAS float* P; PG8_LAS float* S; float* X; unsigned* cnt; unsigned* tmo; mutable int ui; mutable u32x4 xp[2][2][2];
    __device__ __forceinline__ EpiH(bf16_t* H_, int ldh_, const bf16_t* xa_, int ldx_, const float* sx_, const float* pg_, const PG8_LAS f32x2* rr_, PG8_LAS float* P_, PG8_LAS float* S_, float* X_, unsigned* cnt_, unsigned* tmo_) : H(H_), ldh(ldh_), xa(xa_), ldx(ldx_), sx(sx_), pg(pg_), rr(rr_), P(P_), S(S_), X(X_), cnt(cnt_), tmo(tmo_), ui(0) {}
    __device__ __forceinline__ int hook_tile(int nt) const { return nt / 2; }
    __device__ __forceinline__ void midscale(f32x4 (&acc)[2][2][4][2], const Unit& u, int wr, int wc, int fr, int fq) const {
#pragma unroll
        for (int ai = 0; ai < 2; ++ai)
#pragma unroll
            for (int m = 0; m < 4; ++m) { const float s = rr[ui * 256 + ai * HALF + wr * 64 + m * 16 + fr].x;
#pragma unroll
                for (int bj = 0; bj < 2; ++bj)
#pragma unroll
                    for (int n = 0; n < 2; ++n) acc[ai][bj][m][n] *= s; }
        int fr2 = fr, fq2 = fq; asm volatile("" : "+v"(fr2), "+v"(fq2));
        const int row0 = u.pm * BM + wr * 64 + fr2, col0 = u.pn * BM + wc * 32 + 8 * fq2;
#pragma unroll
        for (int gi = 0; gi < 2; ++gi)
#pragma unroll
            for (int mm = 0; mm < 2; ++mm) { const bf16_t* xr = xa + (size_t)(row0 + (2 * gi + mm) * 16) * ldx + col0;
#pragma unroll
                for (int bj = 0; bj < 2; ++bj) xp[gi][mm][bj] = __builtin_nontemporal_load((const u32x4*)(xr + bj * HALF)); }
    }
    __device__ __forceinline__ void operator()(f32x4 (&acc)[2][2][4][2], const Unit& u, int wr, int wc, int fr_in, int fq_in) const {
        int fr = fr_in, fq = fq_in; asm volatile("" : "+v"(fr), "+v"(fq));
        const int wid = wr * 4 + wc, lane = fq * 16 + fr, tid = wid * 64 + lane;
        const int row0 = u.pm * BM + wr * 64 + fr, col0 = u.pn * BM + wc * 32 + 8 * fq;
        u32x4 xw2[2][2], xw3[2][2]; float xs[4][2]; f32x4 gv[2][2];
#define XLOADG(DST, GI) do { _Pragma("unroll") for (int mm = 0; mm < 2; ++mm) { const int row = row0 + ((GI) >> 1) * HALF + (2 * ((GI) & 1) + mm) * 16; const bf16_t* xr = xa + (size_t)row * ldx + col0; xs[GI][mm] = sx[row]; \
            _Pragma("unroll") for (int bj = 0; bj < 2; ++bj) DST[mm][bj] = __builtin_nontemporal_load((const u32x4*)(xr + bj * HALF)); } } while (0)
#define XLOADS() do { _Pragma("unroll") for (int bj = 0; bj < 2; ++bj) { gv[bj][0] = *(const f32x4*)(pg + col0 + bj * HALF); gv[bj][1] = *(const f32x4*)(pg + col0 + bj * HALF + 4); } \
        _Pragma("unroll") for (int gi = 0; gi < 2; ++gi) _Pragma("unroll") for (int mm = 0; mm < 2; ++mm) xs[gi][mm] = sx[row0 + (2 * gi + mm) * 16]; \
        XLOADG(xw2, 2); } while (0)
#define XSTORE(XV, GI) do { _Pragma("unroll") for (int mm = 0; mm < 2; ++mm) { const int ai = (GI) >> 1, m = 2 * ((GI) & 1) + mm; const int rl = ai * HALF + wr * 64 + m * 16 + fr; const float rs = S[rl], xsc = xs[GI][mm]; bf16_t* hr = H + (size_t)(u.pm * BM + rl) * ldh + col0; \
            _Pragma("unroll") for (int bj = 0; bj < 2; ++bj) { const u32x4 xv_ = XV[mm][bj]; \
                const f32x4 x0 = (f32x4){__uint_as_float(xv_.x << 16), __uint_as_float(xv_.x & 0xffff0000u), __uint_as_float(xv_.y << 16), __uint_as_float(xv_.y & 0xffff0000u)} * xsc; \
                const f32x4 x1 = (f32x4){__uint_as_float(xv_.z << 16), __uint_as_float(xv_.z & 0xffff0000u), __uint_as_float(xv_.w << 16), __uint_as_float(xv_.w & 0xffff0000u)} * xsc; \
                const f32x4 v0 = x0 + acc[ai][bj][m][0] * rs * gv[bj][0], v1 = x1 + acc[ai][bj][m][1] * rs * gv[bj][1]; \
                u32x4 w; w.x = cvt_pk_bf16(v0[0], v0[1]); w.y = cvt_pk_bf16(v0[2], v0[3]); w.z = cvt_pk_bf16(v1[0], v1[1]); w.w = cvt_pk_bf16(v1[2], v1[3]); \
                *(u32x4*)(hr + bj * HALF) = w; } } } while (0)
#pragma unroll
        for (int ai = 0; ai < 2; ++ai)
#pragma unroll
            for (int m = 0; m < 4; ++m) { const int rl = ai * HALF + wr * 64 + m * 16 + fr; const float s = rr[ui * 256 + rl].y; float q = 0.f;
#pragma unroll
                for (int bj = 0; bj < 2; ++bj)
#pragma unroll
                    for (int n = 0; n < 2; ++n) { acc[ai][bj][m][n] *= s; const f32x4 v = acc[ai][bj][m][n]; q += (v[0] * v[0] + v[1] * v[1]) + (v[2] * v[2] + v[3] * v[3]); }
                q += __shfl_xor(q, 16); q += __shfl_xor(q, 32);
                if (fq == 0) P[rl * 4 + wc] = q; }
        asm volatile("s_waitcnt lgkmcnt(0)" ::: "memory"); __builtin_amdgcn_s_barrier(); asm volatile("" ::: "memory");
        if (tid < 256) { const float t = (P[tid * 4 + 0] + P[tid * 4 + 1]) + (P[tid * 4 + 2] + P[tid * 4 + 3]);
            __hip_atomic_store(X + ((size_t)u.pm * 256 + tid) * 8 + u.pn, -t, __ATOMIC_RELAXED, __HIP_MEMORY_SCOPE_AGENT);
            if (lane == 0) __hip_atomic_fetch_add(cnt + 16 * u.pm, 1u, __ATOMIC_RELAXED, __HIP_MEMORY_SCOPE_AGENT);
        } else { XLOADS(); }
        if (wid == 0) { unsigned spins = 0;
            while ((unsigned)__builtin_amdgcn_readfirstlane(__hip_atomic_load(cnt + 16 * u.pm, __ATOMIC_RELAXED, __HIP_MEMORY_SCOPE_AGENT)) < 32u) {
                __builtin_amdgcn_s_sleep(1);
                if (++spins > (1u << 17)) { if (lane == 0) __hip_atomic_store(tmo, 1u, __ATOMIC_RELAXED, __HIP_MEMORY_SCOPE_AGENT); break; } } }
        asm volatile("s_waitcnt lgkmcnt(0)" ::: "memory"); __builtin_amdgcn_s_barrier(); asm volatile("" ::: "memory");
        if (tid < 256) { const unsigned long long* xq = (const unsigned long long*)(X + ((size_t)u.pm * 256 + tid) * 8); unsigned long long w4[4];
#pragma unroll
            for (int k = 0; k < 4; ++k) w4[k] = __hip_atomic_load(xq + k, __ATOMIC_RELAXED, __HIP_MEMORY_SCOPE_AGENT);
            for (unsigned spins = 0;; ++spins) {
                bool ok = true;
#pragma unroll
                for (int k = 0; k < 4; ++k) ok = ok && ((w4[k] & 0x8000000080000000ull) == 0x8000000080000000ull);
                if (__all(ok)) break;
                if (spins > (1u << 17)) { if (lane == 0) __hip_atomic_store(tmo, 1u, __ATOMIC_RELAXED, __HIP_MEMORY_SCOPE_AGENT); break; }
                __builtin_amdgcn_s_sleep(2);
#pragma unroll
                for (int k = 0; k < 4; ++k) if ((w4[k] & 0x8000000080000000ull) != 0x8000000080000000ull) w4[k] = __hip_atomic_load(xq + k, __ATOMIC_RELAXED, __HIP_MEMORY_SCOPE_AGENT);
            }
            asm volatile("" ::: "memory");
            XLOADS();
            asm volatile("" ::: "memory");
            float t = 0.f;
#pragma unroll
            for (int k = 0; k < 4; ++k) t -= __uint_as_float((unsigned)w4[k]) + __uint_as_float((unsigned)(w4[k] >> 32));
            S[tid] = __builtin_amdgcn_rsqf(t * (1.0f / 2048.0f) + 1e-6f); }
        asm volatile("s_waitcnt lgkmcnt(0)" ::: "memory"); __builtin_amdgcn_s_barrier(); asm volatile("" ::: "memory");
        XLOADG(xw3, 3); asm volatile("" ::: "memory"); XSTORE(xp[0], 0); asm volatile("" ::: "memory");
        XSTORE(xp[1], 1); asm volatile("" ::: "memory"); XSTORE(xw2, 2); asm volatile("" ::: "memory"); XSTORE(xw3, 3);
#undef XLOADS
#undef XLOADG
#undef XSTORE
        ++ui;
    }
};

struct EpiOut {
    static constexpr bool PERM = false, AFTER_DRAIN = false, MIDSCALE = true, PROBE2 = false;
    float* out; const bf16_t* h1; int ldc, lda; mutable unsigned g8[2][2][4][2]; mutable u32x2 hp[2][2][2];
    __device__ __forceinline__ EpiOut(float* out_, const bf16_t* h1_, int ldc_, int lda_) : out(out_), h1(h1_), ldc(ldc_), lda(lda_) {}
    __device__ __forceinline__ int hook_tile(int nt) const { return nt - 4; }
    __device__ __forceinline__ void midscale(f32x4 (&acc)[2][2][4][2], const Unit& u, int wr, int wc, int fr, int fq) const {
#pragma unroll
        for (int ai = 0; ai < 2; ++ai)
#pragma unroll
            for (int bj = 0; bj < 2; ++bj)
#pragma unroll
                for (int m = 0; m < 4; ++m)
#pragma unroll
                    for (int n = 0; n < 2; ++n) { const f32x4 a = acc[ai][bj][m][n];
                        const f32x2 s0 = (f32x2){a[0], a[1]} * 16.0f + 128.0f, s1 = (f32x2){a[2], a[3]} * 16.0f + 128.0f;
                        unsigned w = __builtin_amdgcn_cvt_pk_u8_f32(s0.x, 0u, 0u); w = __builtin_amdgcn_cvt_pk_u8_f32(s0.y, 1u, w); w = __builtin_amdgcn_cvt_pk_u8_f32(s1.x, 2u, w); w = __builtin_amdgcn_cvt_pk_u8_f32(s1.y, 3u, w);
                        g8[ai][bj][m][n] = w; acc[ai][bj][m][n] = (f32x4){0.f, 0.f, 0.f, 0.f}; }
        int fr2 = fr, fq2 = fq; asm volatile("" : "+v"(fr2), "+v"(fq2));
        const int row0 = u.pm * BM + wr * 64 + fr2, col0 = u.pn * BM + wc * 32 + 4 * fq2;
#pragma unroll
        for (int mm = 0; mm < 2; ++mm) { const size_t offa = (size_t)(row0 + mm * 16) * lda + col0;
#pragma unroll
            for (int bj = 0; bj < 2; ++bj)
#pragma unroll
                for (int n = 0; n < 2; ++n) hp[mm][bj][n] = *(const u32x2*)(h1 + offa + bj * HALF + n * 16); }
    }
    __device__ __forceinline__ void operator()(const f32x4 (&acc)[2][2][4][2], const Unit& u, int wr, int wc, int fr_in, int fq_in) const {
        int fr = fr_in, fq = fq_in; asm volatile("" : "+v"(fr), "+v"(fq));
        const int row0 = u.pm * BM + wr * 64 + fr, col0 = u.pn * BM + wc * 32 + 4 * fq;
        u32x2 hw[2][2][2][2];
#define HLOAD(B, GI) do { _Pragma("unroll") for (int mm = 0; mm < 2; ++mm) { const size_t offa = (size_t)(row0 + ((GI) >> 1) * HALF + (2 * ((GI) & 1) + mm) * 16) * lda + col0; \
            _Pragma("unroll") for (int bj = 0; bj < 2; ++bj) _Pragma("unroll") for (int n = 0; n < 2; ++n) hw[B][mm][bj][n] = *(const u32x2*)(h1 + offa + bj * HALF + n * 16); } } while (0)
#define HSTORE(B, GI) do { _Pragma("unroll") for (int mm = 0; mm < 2; ++mm) { const int ai = (GI) >> 1, m = 2 * ((GI) & 1) + mm; const size_t off = (size_t)(row0 + ai * HALF + m * 16) * ldc + col0; \
            _Pragma("unroll") for (int bj = 0; bj < 2; ++bj) _Pragma("unroll") for (int n = 0; n < 2; ++n) { const int cc = bj * HALF + n * 16; \
                const u32x2 hv = hw[B][mm][bj][n]; const f32x4 a = acc[ai][bj][m][n]; const unsigned w = g8[ai][bj][m][n]; f32x4 r; \
                const f32x2 z0 = (f32x2){(float)(w & 0xffu), (float)((w >> 8) & 0xffu)} * (-0.09016844f) + 11.5415603f, z1 = (f32x2){(float)((w >> 16) & 0xffu), (float)(w >> 24)} * (-0.09016844f) + 11.5415603f;        \
                f32x2 e0, e1; e0.x = __builtin_amdgcn_exp2f(z0.x); e0.y = __builtin_amdgcn_exp2f(z0.y); e1.x = __builtin_amdgcn_exp2f(z1.x); e1.y = __builtin_amdgcn_exp2f(z1.y); \
                const f32x2 d0 = e0 + 1.0f, d1 = e1 + 1.0f; \
                r[0] = __uint_as_float(hv.x << 16) + a[0] * __builtin_amdgcn_rcpf(d0.x); \
                r[1] = __uint_as_float(hv.x & 0xffff0000u) + a[1] * __builtin_amdgcn_rcpf(d0.y); \
                r[2] = __uint_as_float(hv.y << 16) + a[2] * __builtin_amdgcn_rcpf(d1.x); \
                r[3] = __uint_as_float(hv.y & 0xffff0000u) + a[3] * __builtin_amdgcn_rcpf(d1.y); \
                __builtin_nontemporal_store(r, (f32x4*)(out + off + cc)); } } } while (0)
#pragma unroll
        for (int mm = 0; mm < 2; ++mm)
#pragma unroll
            for (int bj = 0; bj < 2; ++bj)
#pragma unroll
                for (int n = 0; n < 2; ++n) hw[0][mm][bj][n] = hp[mm][bj][n];
        HLOAD(1, 1);
        asm volatile("" ::: "memory"); HSTORE(0, 0); asm volatile("" ::: "memory"); HLOAD(0, 2);
        asm volatile("" ::: "memory"); HSTORE(1, 1); asm volatile("" ::: "memory"); HLOAD(1, 3);
        asm volatile("" ::: "memory"); HSTORE(0, 2);
        asm volatile("" ::: "memory"); HSTORE(1, 3);
#undef HLOAD
#undef HSTORE
    }
};

template <class Epi, class Sched, bool ALIGN_EPI = false, bool SP2 = false>
__device__ __forceinline__ void gemm_phase(PG8_LAS unsigned char* lds, const Gemm g, const Sched& S, const Epi& E, int tid_in) {
    int tid_ = tid_in; asm volatile("" : "+v"(tid_));
    const int tid = tid_, wid = __builtin_amdgcn_readfirstlane(tid >> 6), lane = tid & 63, wr = wid >> 2, wc = wid & 3, fr = lane & 15, fq = lane >> 4;
    const int K = g.K, nt = K / BK;
    unsigned voffA[2], voffB[2];
#pragma unroll
    for (int i = 0; i < 2; ++i) { int R, C; stage_rc(tid * 16 + i * 8192, R, C); const int Rb = Epi::PERM ? ((R & ~31) + perm32(R & 31)) : R;
        voffA[i] = (unsigned)(R * K + C) * 2u; voffB[i] = (unsigned)(Rb * K + C) * 2u; }
    const size_t kstep = (size_t)(BK * 2);
    const size_t hstep = (size_t)HALF * K * 2;
    const size_t tstep = 2 * hstep;
    const unsigned ldsw = (unsigned)wid * 1024u;
    const int aoff = lds_byte(wr * 64 + fr, fq * 8), boff = lds_byte(wc * 32 + fr, fq * 8);
#define PG8_SA(b, h) (((b) * 2 + (h)) * HTB)
#define PG8_SB(b, h) ((4 + (b) * 2 + (h)) * HTB)
#define PG8_STAGE(bufoff, gbase, voff) do { const char* gb_ = (const char*)(gbase); asm volatile("" : "+s"(gb_)); _Pragma("unroll") for (int _i = 0; _i < 2; ++_i) { \
        unsigned vo_ = (voff)[_i]; asm volatile("" : "+v"(vo_));        \
        __builtin_amdgcn_global_load_lds((const unsigned*)(gb_ + vo_), (PG8_LAS unsigned*)(lds + (bufoff) + ldsw + _i * 8192), 16, 0, 0); } } while (0)
#define PG8_LDA(dst, b, h) do { _Pragma("unroll") for (int m = 0; m < 4; ++m) _Pragma("unroll") for (int k = 0; k < 2; ++k) dst[m][k] = *(const PG8_LAS bf16x8*)(lds + PG8_SA(b, h) + aoff + m * 2048 + k * 1024); } while (0)
#define PG8_LDB(dst, b, h) do { _Pragma("unroll") for (int n = 0; n < 2; ++n) _Pragma("unroll") for (int k = 0; k < 2; ++k) dst[n][k] = *(const PG8_LAS bf16x8*)(lds + PG8_SB(b, h) + boff + n * 2048 + k * 1024); } while (0)
#define PG8_MMA(ai, bj, At, Bt) do { __builtin_amdgcn_s_setprio(1); _Pragma("unroll") for (int m = 0; m < 4; ++m) _Pragma("unroll") for (int n = 0; n < 2; ++n) _Pragma("unroll") for (int k = 0; k < 2; ++k) \
        acc[ai][bj][m][n] = __builtin_amdgcn_mfma_f32_16x16x32_bf16(Bt[n][k], At[m][k], acc[ai][bj][m][n], 0, 0, 0); __builtin_amdgcn_s_setprio(0); } while (0)
#define PG8_WAIT_V(n) asm volatile("s_waitcnt vmcnt(" #n ")" ::: "memory")
#define PG8_WAIT_L(n) asm volatile("s_waitcnt lgkmcnt(" #n ")" ::: "memory")
#define PG8_BAR __builtin_amdgcn_s_barrier()
#define PG8_SCHED __builtin_amdgcn_sched_barrier(0)
    Unit cur, nxt; int ui = 0;
    if (!S.next(0, cur)) return;
    f32x4 acc[2][2][4][2];
#pragma unroll
    for (int a = 0; a < 2; ++a)
#pragma unroll
        for (int b = 0; b < 2; ++b)
#pragma unroll
            for (int m = 0; m < 4; ++m)
#pragma unroll
                for (int n = 0; n < 2; ++n) acc[a][b][m][n] = (f32x4){0.f, 0.f, 0.f, 0.f};
    bf16x8 At[4][2], B0[2][2], B1[2][2];
    const char* cA = (const char*)g.A + (size_t)cur.pm * tstep; const char* cB = (const char*)g.Bt + (size_t)cur.pn * tstep;
    S.a_ready(cur);
    if constexpr (SP2) {
        PG8_STAGE(PG8_SB(0, 0), cB, voffB); PG8_STAGE(PG8_SB(0, 1), cB + hstep, voffB); PG8_STAGE(PG8_SA(0, 0), cA, voffA); PG8_STAGE(PG8_SA(0, 1), cA + hstep, voffA);
        if (wr == 1) PG8_BAR;
        PG8_WAIT_V(2); PG8_BAR;
        PG8_STAGE(PG8_SB(1, 0), cB + kstep, voffB); PG8_STAGE(PG8_SA(1, 0), cA + kstep, voffA); PG8_STAGE(PG8_SB(1, 1), cB + hstep + kstep, voffB);
        PG8_WAIT_V(6); PG8_BAR;
    } else {
        PG8_STAGE(PG8_SB(0, 0), cB, voffB); PG8_STAGE(PG8_SA(0, 0), cA, voffA); PG8_STAGE(PG8_SB(0, 1), cB + hstep, voffB); PG8_STAGE(PG8_SA(0, 1), cA + hstep, voffA);
        if (wr == 1) PG8_BAR;
        PG8_WAIT_V(4); PG8_BAR;
        PG8_STAGE(PG8_SB(1, 0), cB + kstep, voffB); PG8_STAGE(PG8_SA(1, 0), cA + kstep, voffA); PG8_STAGE(PG8_SB(1, 1), cB + hstep + kstep, voffB);
        PG8_WAIT_V(6); PG8_BAR;
    }
    for (;;) {
        const bool has_next = S.next(ui + 1, nxt);
        const char* nA = has_next ? (const char*)g.A + (size_t)nxt.pm * tstep : cA; const char* nB = has_next ? (const char*)g.Bt + (size_t)nxt.pn * tstep : cB;
        for (int t = 0; t < nt; t += 2) {
            const bool last = (t == nt - 2);
            const char* a1 = cA + (size_t)(t + 1) * kstep;
            const char* a2 = last ? nA : cA + (size_t)(t + 2) * kstep; const char* b2 = last ? nB : cB + (size_t)(t + 2) * kstep;
            const char* a3 = a2 + kstep; const char* b3 = b2 + kstep;
            if (last && has_next) S.a_ready(nxt);
            if constexpr (Epi::MIDSCALE) { if (t == E.hook_tile(nt)) E.midscale(acc, cur, wr, wc, fr, fq); }
            if constexpr (SP2) {
            PG8_LDB(B0, 0, 0); PG8_LDB(B1, 0, 1); PG8_SCHED; PG8_LDA(At, 0, 0); PG8_STAGE(PG8_SA(1, 1), a1 + hstep, voffA);
            PG8_WAIT_V(8); PG8_WAIT_L(0); PG8_BAR; PG8_MMA(0, 0, At, B0); PG8_MMA(0, 1, At, B1); PG8_BAR; PG8_SCHED;
            PG8_LDA(At, 0, 1); PG8_STAGE(PG8_SB(0, 0), b2, voffB); PG8_STAGE(PG8_SB(0, 1), b2 + hstep, voffB); PG8_STAGE(PG8_SA(0, 0), a2, voffA);
            PG8_WAIT_V(8); PG8_WAIT_L(0); PG8_BAR; PG8_MMA(1, 0, At, B0); PG8_MMA(1, 1, At, B1); PG8_BAR; PG8_SCHED;
            PG8_LDB(B0, 1, 0); PG8_LDB(B1, 1, 1); PG8_SCHED; PG8_LDA(At, 1, 0); PG8_STAGE(PG8_SA(0, 1), a2 + hstep, voffA);
            PG8_WAIT_V(8); PG8_WAIT_L(0); PG8_BAR; PG8_MMA(0, 0, At, B0); PG8_MMA(0, 1, At, B1); PG8_BAR; PG8_SCHED;
            PG8_LDA(At, 1, 1); PG8_STAGE(PG8_SB(1, 0), b3, voffB); PG8_STAGE(PG8_SB(1, 1), b3 + hstep, voffB); PG8_STAGE(PG8_SA(1, 0), a3, voffA);
            PG8_WAIT_V(8); PG8_WAIT_L(0); PG8_BAR; PG8_MMA(1, 0, At, B0); PG8_MMA(1, 1, At, B1); PG8_BAR; PG8_SCHED;
            } else {
            PG8_LDB(B0, 0, 0); PG8_SCHED; PG8_LDA(At, 0, 0); PG8_STAGE(PG8_SA(1, 1), a1 + hstep, voffA);
            PG8_WAIT_L(8); PG8_BAR; PG8_WAIT_L(0); PG8_MMA(0, 0, At, B0); PG8_BAR; PG8_SCHED;
            PG8_LDB(B1, 0, 1); PG8_STAGE(PG8_SB(0, 0), b2, voffB);
            PG8_BAR; PG8_WAIT_L(0); PG8_MMA(0, 1, At, B1); PG8_BAR;
            PG8_LDA(At, 0, 1); PG8_STAGE(PG8_SA(0, 0), a2, voffA);
            PG8_BAR; PG8_WAIT_L(0); PG8_MMA(1, 0, At, B0); PG8_BAR; PG8_SCHED;
            PG8_STAGE(PG8_SB(0, 1), b2 + hstep, voffB);
            PG8_WAIT_V(6); PG8_BAR; PG8_MMA(1, 1, At, B1); PG8_BAR;
            PG8_LDB(B0, 1, 0); PG8_SCHED; PG8_LDA(At, 1, 0); PG8_STAGE(PG8_SA(0, 1), a2 + hstep, voffA);
            PG8_WAIT_L(8); PG8_BAR; PG8_WAIT_L(0); PG8_MMA(0, 0, At, B0); PG8_BAR; PG8_SCHED;
            PG8_LDB(B1, 1, 1); PG8_STAGE(PG8_SB(1, 0), b3, voffB);
            PG8_BAR; PG8_WAIT_L(0); PG8_MMA(0, 1, At, B1); PG8_BAR;
            PG8_LDA(At, 1, 1); PG8_STAGE(PG8_SA(1, 0), a3, voffA);
            PG8_BAR; PG8_WAIT_L(0); PG8_MMA(1, 0, At, B0); PG8_BAR; PG8_SCHED;
            PG8_STAGE(PG8_SB(1, 1), b3 + hstep, voffB);
            PG8_WAIT_V(6); PG8_BAR; PG8_MMA(1, 1, At, B1); PG8_BAR;
            }
        }
        if constexpr (ALIGN_EPI) { if (wr == 0) PG8_BAR; }
        if constexpr (!Epi::AFTER_DRAIN) { E(acc, cur, wr, wc, fr, fq);
#if PROBE_EPI2
            if constexpr (Epi::PROBE2) { asm volatile("" ::: "memory");
                _Pragma("unroll") for (int a = 0; a < 2; ++a) _Pragma("unroll") for (int b = 0; b < 2; ++b) _Pragma("unroll") for (int m = 0; m < 4; ++m) _Pragma("unroll") for (int n = 0; n < 2; ++n) asm volatile("" : "+v"(acc[a][b][m][n]));
                int fr2 = fr, fq2 = fq; asm volatile("" : "+v"(fr2), "+v"(fq2));
                E(acc, cur, wr, wc, fr2, fq2); }
#endif
            S.done(cur); }
        if (!has_next) break;
#pragma unroll
        for (int a = 0; a < 2; ++a)
#pragma unroll
            for (int b = 0; b < 2; ++b)
#pragma unroll
                for (int m = 0; m < 4; ++m)
#pragma unroll
                    for (int n = 0; n < 2; ++n) acc[a][b][m][n] = (f32x4){0.f, 0.f, 0.f, 0.f};
        cur = nxt; cA = nA; cB = nB; ++ui;
        if constexpr (ALIGN_EPI) { if (wr == 1) PG8_BAR; }
    }
    PG8_WAIT_V(0);
    if constexpr (!ALIGN_EPI) { if (wr == 0) PG8_BAR; }
    PG8_BAR;
    if constexpr (Epi::AFTER_DRAIN) { E.fused(acc, cur, wr, wc, fr, fq, lds, wid, lane); S.done(cur); }
#undef PG8_SA
#undef PG8_SB
#undef PG8_STAGE
#undef PG8_LDA
#undef PG8_LDB
#undef PG8_MMA
#undef PG8_WAIT_V
#undef PG8_WAIT_L
#undef PG8_BAR
#undef PG8_SCHED
}
}

constexpr int BATCH = 4, SEQ = 8192, DM = 2048, M = BATCH * SEQ, DG = 1024, DL = 1024, NZ = 5120, NZO = 4096, DP = 256, CHK = 128, NH = 8;
constexpr float EPS = 1e-6f;
constexpr int NWAVES = 8, NTHR = NWAVES * 64;
#ifndef MK_N_LAUNCHES
#define MK_N_LAUNCHES 1
#endif
constexpr int N_PHASES = 8;
#ifndef MK_CG_SYNC
#define MK_CG_SYNC 0
#endif
#ifndef SKEW7_TICKS
#define SKEW7_TICKS 0
#endif
#ifndef PROBE_DOUBLE
#define PROBE_DOUBLE 0
#endif
#define REPS(k) for (int rep_ = 0; rep_ < 1 + ((PROBE_DOUBLE >> (k)) & 1); ++rep_)

constexpr size_t MiB = 1u << 20;
constexpr size_t WS_WIN = 2 * MiB;
constexpr size_t WS_WOUT = 22 * MiB;
constexpr size_t WS_WA = 39 * MiB;
constexpr size_t WS_WX = WS_WA + 256 * 1024;
constexpr size_t WS_WSM = WS_WX + 256 * 1024;
constexpr size_t WS_VST = 40 * MiB;
constexpr size_t WS_SSA = 44 * MiB;
constexpr size_t WS_SSB = 45 * MiB;
constexpr size_t WS_SSO = 46 * MiB;
constexpr size_t WS_AGG = 50 * MiB;
constexpr size_t WS_SPT = 53 * MiB;
constexpr size_t WS_SX = 52 * MiB;
constexpr size_t WS_A1 = 64 * MiB;
constexpr int K3 = DM + DP;
constexpr size_t WS_A3 = 192 * MiB;
constexpr size_t WS_Z = 336 * MiB;
constexpr size_t WS_Y = 656 * MiB;
constexpr size_t WS_B3 = 912 * MiB;
constexpr size_t WS_END = 922 * MiB;

constexpr int LDS_BYTES = 147456;
constexpr int IMG0 = 0, IMG1 = 32768, IMG2 = 65536, IMG3 = 98304, MISC = 131072;
constexpr int MISC_STAT = MISC, MISC_PART = MISC + 1024, MISC_CPART = MISC + 5120;

#define LAS __attribute__((address_space(3)))
typedef unsigned short bf16;
typedef unsigned char uchar;
typedef float f32x4 __attribute__((ext_vector_type(4)));
typedef float f32x2 __attribute__((ext_vector_type(2)));
typedef unsigned u32x4 __attribute__((ext_vector_type(4)));
typedef unsigned u32x2 __attribute__((ext_vector_type(2)));
typedef short bf16x8 __attribute__((ext_vector_type(8)));

__device__ __forceinline__ unsigned f2bf(float f) { unsigned u = __builtin_bit_cast(unsigned, f); return (u + 0x7fffu + ((u >> 16) & 1u)) >> 16; }
__device__ __forceinline__ unsigned pk2(float lo, float hi) { unsigned r; asm("v_cvt_pk_bf16_f32 %0, %1, %2" : "=v"(r) : "v"(lo), "v"(hi)); return r; }
__device__ __forceinline__ float bflo(unsigned w) { return __uint_as_float(w << 16); }
__device__ __forceinline__ float bfhi(unsigned w) { return __uint_as_float(w & 0xffff0000u); }
__device__ __forceinline__ float wave_sum(float v) {
#pragma unroll
    for (int o = 1; o < 64; o <<= 1) v += __shfl_xor(v, o);
    return v;
}
__device__ __forceinline__ float sigmoidf_(float x) { return __builtin_amdgcn_rcpf(1.0f + __expf(-x)); }

__device__ __forceinline__ f32x2 gelu2(f32x2 x) { const f32x2 t = x * x; const f32x2 uu = t * (-0.10294323f) + (-2.30220819f); const f32x2 wv = x * uu;
    f32x2 ev; ev.x = __builtin_amdgcn_exp2f(wv.x); ev.y = __builtin_amdgcn_exp2f(wv.y); const f32x2 d = ev + 1.0f; f32x2 r; r.x = __builtin_amdgcn_rcpf(d.x); r.y = __builtin_amdgcn_rcpf(d.y); return x * r; }
__device__ __forceinline__ f32x2 silu2(f32x2 x) { const f32x2 wv = x * (-1.44269504f);
    f32x2 ev; ev.x = __builtin_amdgcn_exp2f(wv.x); ev.y = __builtin_amdgcn_exp2f(wv.y); const f32x2 d = ev + 1.0f; f32x2 r; r.x = __builtin_amdgcn_rcpf(d.x); r.y = __builtin_amdgcn_rcpf(d.y); return x * r; }

struct Args { const float* in[21]; float* out; unsigned char* ws; int ph_lo, ph_hi; };
typedef const __attribute__((address_space(4))) Args* ArgP;
struct Frame {
    LAS uchar* lds;
    int tid, lane, wave, G, bid;
    int wv;
    ArgP ap;
};
#define PHASE_BEGIN(F) do { int w_ = (F).wv; unsigned z_ = 0u; ArgP a_ = (ArgP)__builtin_amdgcn_kernarg_segment_ptr(); asm volatile("" : "+s"(w_), "+s"(a_), "+s"(z_)); \
    const int l_ = (int)__builtin_amdgcn_mbcnt_hi(~0u, __builtin_amdgcn_mbcnt_lo(~0u, z_));     \
    (F).lane = l_; (F).wave = w_; (F).tid = w_ * 64 + l_; (F).ap = a_; } while (0)

__device__ __forceinline__ void p0_transpose_item(const float* W, int K, int N, bf16* WT, LAS float* scr, int item, int lane, const float* ks0, const float* ks1, int ksplit, int ldt = 0, bool winperm = false) {
    if (ldt == 0) ldt = K;
    const int nblk = N / 32, kb = item / nblk, nb = item % nblk, k0 = 64 * kb, n0 = 32 * nb;
    int n0s = n0;
    if (winperm) { if (n0 < 2048) { const int k = n0 >> 8, r = n0 & 255; n0s = (r < 128) ? 128 * k + r : 2048 + 128 * k + (r - 128); } else if (n0 < 3072) n0s = n0 - 1024; }
#pragma unroll 8
    for (int i = 0; i < 32; ++i) { const int kk = 2 * i + (lane >> 5); scr[kk * 33 + (lane & 31)] = __builtin_nontemporal_load(W + (size_t)(k0 + kk) * N + n0s + (lane & 31)); }
    const int c = lane & 7;
    f32x4 s0 = (f32x4){1.f, 1.f, 1.f, 1.f}, s1 = s0;
    if (ks0) { const float* ks = (k0 < ksplit) ? ks0 + k0 : ks1 + (k0 - ksplit); s0 = *(const f32x4*)(ks + 8 * c); s1 = *(const f32x4*)(ks + 8 * c + 4); }
    asm volatile("s_waitcnt lgkmcnt(0)" ::: "memory");
#pragma unroll
    for (int j = 0; j < 4; ++j) { const int n = (lane >> 3) + 8 * j; const LAS float* s = scr + (8 * c) * 33 + n;
        u32x4 o; o.x = pk2(s[0 * 33] * s0.x, s[1 * 33] * s0.y); o.y = pk2(s[2 * 33] * s0.z, s[3 * 33] * s0.w); o.z = pk2(s[4 * 33] * s1.x, s[5 * 33] * s1.y); o.w = pk2(s[6 * 33] * s1.z, s[7 * 33] * s1.w);
        *(u32x4*)(WT + (size_t)(n0 + n) * ldt + k0 + 8 * c) = o; }
    asm volatile("s_waitcnt lgkmcnt(0)" ::: "memory");
}

__device__ __forceinline__ void p0_prologue(Frame& F) {
    LAS float* scr = (LAS float*)(F.lds + F.wave * 16384);
    const int gw = F.bid * NWAVES + F.wave, NGW = F.G * NWAVES;
    const float* w_in = F.ap->in[3]; const float* w_out = F.ap->in[17]; const float* w_pe = F.ap->in[19]; const float* w_pg = F.ap->in[20];
    const float* w_a = F.ap->in[10]; const float* w_x = F.ap->in[12];
    bf16* WIN = (bf16*)(((uchar*)F.ap->ws) + WS_WIN); bf16* WOUT = (bf16*)(((uchar*)F.ap->ws) + WS_WOUT); bf16* B3 = (bf16*)(((uchar*)F.ap->ws) + WS_B3);
    bf16* WA = (bf16*)(((uchar*)F.ap->ws) + WS_WA); bf16* WX = (bf16*)(((uchar*)F.ap->ws) + WS_WX); bf16* WSM = (bf16*)(((uchar*)F.ap->ws) + WS_WSM);
    constexpr int I_IN = (DM / 64) * (NZ / 32), I_OUT = (DM / 64) * (DM / 32), I_PG = I_OUT, I_PE = (DP / 64) * (DM / 32), I_SM = 16 * 8;
    constexpr int NITEMS = I_IN + I_OUT + I_PG + I_PE + I_SM;
    for (int it = gw; it < NITEMS; it += NGW) {
        int r = it;
        if (r < I_IN) { p0_transpose_item(w_in, DM, NZ, WIN, scr, r, F.lane, F.ap->in[2], F.ap->in[2], DM, 0, true); continue; } r -= I_IN;
        if (r < I_OUT) { p0_transpose_item(w_out, DM, DM, WOUT, scr, r, F.lane, F.ap->in[15], F.ap->in[16], DG); continue; } r -= I_OUT;
        if (r < I_PG) { p0_transpose_item(w_pg, DM, DM, B3, scr, r, F.lane, nullptr, nullptr, 0, K3); continue; } r -= I_PG;
        if (r < I_PE) { p0_transpose_item(w_pe, DP, DM, B3 + DM, scr, r, F.lane, nullptr, nullptr, 0, K3); continue; } r -= I_PE;
        { const int mat = r >> 3, sub = r & 7;
          const float* src = (mat < 8 ? w_a : w_x) + (size_t)(mat & 7) * 16384; bf16* dst = (mat < 8 ? WA : WX) + (size_t)(mat & 7) * 16384;
          p0_transpose_item(src, 128, 128, dst, scr, sub, F.lane, nullptr, nullptr, 0); }
    }
    { unsigned long long* AGGz = (unsigned long long*)(((uchar*)F.ap->ws) + WS_AGG); const int gt = F.bid * NTHR + F.tid, NGT = F.G * NTHR;
      for (int i = gt; i < 256 * DL; i += NGT) __hip_atomic_store(AGGz + i, 0ull, __ATOMIC_RELAXED, __HIP_MEMORY_SCOPE_AGENT); }
    if (F.bid == 1) { float* spt = (float*)(((uchar*)F.ap->ws) + WS_SPT); const float* lam = F.ap->in[14];
      for (int i = F.tid; i < DL; i += NTHR) { const float xx = -lam[i]; const float spl = (xx > 0.f ? xx : 0.f) + log1pf(__expf(-fabsf(xx)));
          spt[i] = -8.0f * 1.44269504f * spl; } }
    { unsigned long long* Xz = (unsigned long long*)(((uchar*)F.ap->ws) + WS_SSO); const int gt = F.bid * NTHR + F.tid, NGT = F.G * NTHR;
      for (int i = gt; i < M * 4; i += NGT) __hip_atomic_store(Xz + i, 0ull, __ATOMIC_RELAXED, __HIP_MEMORY_SCOPE_AGENT); }
    { const float* ws_ = F.ap->in[6]; const int gt = F.bid * NTHR + F.tid, NGT = F.G * NTHR;
      for (int i = gt; i < NH * CHK * CHK / 2; i += NGT) { const int e = 2 * i, s = e & 127, t = (e >> 7) & 127; const f32x2 v = *(const f32x2*)(ws_ + e);
          ((unsigned*)WSM)[i] = pk2(s <= t ? v.x : 0.f, (s + 1) <= t ? v.y : 0.f); } }
    { const float* x = F.ap->in[0]; bf16* A1 = (bf16*)((uchar*)F.ap->ws + WS_A1); float* SX = (float*)((uchar*)F.ap->ws + WS_SX);
      f32x4 v[8], nx[8];
      int m = gw;
      if (m < M) { const f32x4* xr = (const f32x4*)(x + (size_t)m * DM) + 2 * F.lane;
#pragma unroll
          for (int j = 0; j < 4; ++j) { v[2 * j] = __builtin_nontemporal_load(xr + 128 * j); v[2 * j + 1] = __builtin_nontemporal_load(xr + 128 * j + 1); } }
      for (; m < M; m += NGW) {
          const int mn = m + NGW;
          if (mn < M) { const f32x4* xr = (const f32x4*)(x + (size_t)mn * DM) + 2 * F.lane;
#pragma unroll
              for (int j = 0; j < 4; ++j) { nx[2 * j] = __builtin_nontemporal_load(xr + 128 * j); nx[2 * j + 1] = __builtin_nontemporal_load(xr + 128 * j + 1); } }
          float ss = 0.f;
#pragma unroll
          for (int j = 0; j < 8; ++j) ss += (v[j].x * v[j].x + v[j].y * v[j].y) + (v[j].z * v[j].z + v[j].w * v[j].w);
          const float sx = sqrtf(wave_sum(ss) * (1.0f / DM) + EPS), rstd = 1.0f / sx;
          if (F.lane == 0) SX[m] = sx;
          u32x4* o16 = (u32x4*)(A1 + (size_t)m * DM) + F.lane;
#pragma unroll
          for (int j = 0; j < 4; ++j) { const f32x4 a = v[2 * j], b = v[2 * j + 1];
              u32x4 o; o.x = pk2(a.x * rstd, a.y * rstd); o.y = pk2(a.z * rstd, a.w * rstd); o.z = pk2(b.x * rstd, b.y * rstd); o.w = pk2(b.z * rstd, b.w * rstd); o16[64 * j] = o; }
#pragma unroll
          for (int j = 0; j < 8; ++j) v[j] = nx[j];
      } }
    { const float* p = F.ap->in[1]; bf16* A3 = (bf16*)(((uchar*)F.ap->ws) + WS_A3); const size_t gt = (size_t)F.bid * NTHR + F.tid, NGT = (size_t)F.G * NTHR; constexpr size_t NI = (size_t)M * DP / 8;
      size_t i0 = gt;
      for (; i0 + 3 * NGT < NI; i0 += 4 * NGT) { f32x4 a[4], b[4];
#pragma unroll
          for (int q = 0; q < 4; ++q) { const size_t i = i0 + q * NGT; a[q] = __builtin_nontemporal_load((const f32x4*)p + 2 * i); b[q] = __builtin_nontemporal_load((const f32x4*)p + 2 * i + 1); }
#pragma unroll
          for (int q = 0; q < 4; ++q) { const size_t i = i0 + q * NGT; const size_t row = i >> 5, c8 = i & 31;
              u32x4 o; o.x = pk2(a[q].x, a[q].y); o.y = pk2(a[q].z, a[q].w); o.z = pk2(b[q].x, b[q].y); o.w = pk2(b[q].z, b[q].w); *(u32x4*)(A3 + row * K3 + DM + c8 * 8) = o; } }
      for (; i0 < NI; i0 += NGT) { const f32x4 a = __builtin_nontemporal_load((const f32x4*)p + 2 * i0), b = __builtin_nontemporal_load((const f32x4*)p + 2 * i0 + 1); const size_t row = i0 >> 5, c8 = i0 & 31;
          u32x4 o; o.x = pk2(a.x, a.y); o.y = pk2(a.z, a.w); o.z = pk2(b.x, b.y); o.w = pk2(b.z, b.w); *(u32x4*)(A3 + row * K3 + DM + c8 * 8) = o; } }
}

__device__ __forceinline__ int sw16(int row) { return (row ^ (row >> 3)) & 15; }
__device__ __forceinline__ int img_off(int row, int chunk) { return row * 256 + ((chunk ^ sw16(row)) << 4); }
__device__ __forceinline__ int img_xt(int b0, int T) { return (b0 ^ (T << 5)) + (T << 12); }
__device__ __forceinline__ void load_img(LAS uchar* img, const bf16* src, int tid) {
#pragma unroll
    for (int i = 0; i < 4; ++i) { const int q = tid + NTHR * i, row = q >> 4, ch = q & 15; const u32x4 v = *(const u32x4*)(src + row * 128 + ch * 8); *(LAS u32x4*)(img + img_off(row, ch)) = v; }
}
#define DPP_F(oldv, srcv, ctrl) __builtin_bit_cast(float, __builtin_amdgcn_update_dpp(__builtin_bit_cast(int, (float)(oldv)), __builtin_bit_cast(int, (float)(srcv)), (ctrl), 0xf, 0xf, false))
constexpr int CW_FLAG = 4096;
constexpr int CW_TMO2 = 6400;
constexpr int CW_PCNT = 6464;
constexpr int CTL_WORDS = 9216;

struct GmlpPref { u32x4 gv[4], uu[4]; f32x4 st[8]; };
__device__ __forceinline__ void gmlp_prefetch(Frame& F, int tid, int c, int h, GmlpPref& R) {
    const int tg4 = tid >> 4, cg = tid & 15, t0 = c * CHK;
    const bf16* Z = (const bf16*)((uchar*)F.ap->ws + WS_Z);
#pragma unroll
    for (int j = 0; j < 4; ++j) { const bf16* zr = Z + (size_t)(t0 + 4 * tg4 + j) * NZO + 128 * h + 8 * cg;
        R.uu[j] = __builtin_nontemporal_load((const u32x4*)zr); R.gv[j] = __builtin_nontemporal_load((const u32x4*)(zr + DG)); }
    if (tid < 128) { const f32x4* vp = (const f32x4*)((uchar*)F.ap->ws + WS_VST) + (size_t)(t0 + tid) * 8;
#pragma unroll
        for (int k = 0; k < 8; ++k) R.st[k] = vp[k]; }
}
__device__ __forceinline__ void gmlp_phase(Frame& F) {
    const int tid0 = F.tid, w = F.wave;
    bf16* Y = (bf16*)((uchar*)F.ap->ws + WS_Y); float* SSA = (float*)((uchar*)F.ap->ws + WS_SSA);
    LAS f32x2* stat = (LAS f32x2*)(F.lds + MISC_STAT); LAS float* part = (LAS float*)(F.lds + MISC_PART);
    int cur = -1; float gsc[8], bsc[8], bsv[8];
    GmlpPref R;
    int u = F.bid;
    if (u < 2048) gmlp_prefetch(F, tid0, u >> 3, u & 7, R);
    for (; u < 2048; u += F.G) { const int h = u & 7, c = u >> 3, t0 = c * CHK;
        int tid = tid0; asm volatile("" : "+v"(tid));
        const int lane = tid & 63, fr = lane & 15, fq = lane >> 4, tg4 = tid >> 4, cg = tid & 15;
        if (h != cur) {
            __syncthreads(); load_img(F.lds + IMG1, (const bf16*)((uchar*)F.ap->ws + WS_WSM) + (size_t)h * 16384, tid); cur = h;
            const float* lg = F.ap->in[4] + 128 * h + 8 * cg; const float* lb = F.ap->in[5] + 128 * h + 8 * cg;
            const f32x4 g0 = *(const f32x4*)lg, g1 = *(const f32x4*)(lg + 4), b0 = *(const f32x4*)lb, b1 = *(const f32x4*)(lb + 4);
            gsc[0] = g0.x; gsc[1] = g0.y; gsc[2] = g0.z; gsc[3] = g0.w; gsc[4] = g1.x; gsc[5] = g1.y; gsc[6] = g1.z; gsc[7] = g1.w;
            bsc[0] = b0.x; bsc[1] = b0.y; bsc[2] = b0.z; bsc[3] = b0.w; bsc[4] = b1.x; bsc[5] = b1.y; bsc[6] = b1.z; bsc[7] = b1.w;
            const float* bs = F.ap->in[7] + h * CHK;
#pragma unroll
            for (int T = 0; T < 8; ++T) bsv[T] = bs[16 * T + fr];
        }
        if (tid < 128) { float s = 0.f, q = 0.f;
#pragma unroll
            for (int k = 0; k < 8; ++k) { s += R.st[k].x + R.st[k].z; q += R.st[k].y + R.st[k].w; }
            const float mean = s * (1.0f / DG); float var = q * (1.0f / DG) - mean * mean; var = var > 0.f ? var : 0.f;
            stat[tid] = (f32x2){mean, __builtin_amdgcn_rsqf(var + EPS)}; }
        __syncthreads();
        {
            float nv[4][8];
#pragma unroll
            for (int j = 0; j < 4; ++j) { const f32x2 st = stat[4 * tg4 + j]; const unsigned wv[4] = {R.gv[j].x, R.gv[j].y, R.gv[j].z, R.gv[j].w};
#pragma unroll
                for (int k = 0; k < 4; ++k) { nv[j][2 * k] = (bflo(wv[k]) - st.x) * st.y * gsc[2 * k] + bsc[2 * k]; nv[j][2 * k + 1] = (bfhi(wv[k]) - st.x) * st.y * gsc[2 * k + 1] + bsc[2 * k + 1]; } }
#pragma unroll
            for (int cc = 0; cc < 8; ++cc) { const int d = 8 * cg + cc; u32x2 o; o.x = pk2(nv[0][cc], nv[1][cc]); o.y = pk2(nv[2][cc], nv[3][cc]);
                *(LAS u32x2*)(F.lds + IMG0 + d * 256 + (((tg4 >> 1) ^ sw16(d)) << 4) + (tg4 & 1) * 8) = o; }
#pragma unroll
            for (int j = 0; j < 4; ++j) *(LAS u32x4*)(F.lds + IMG2 + img_off(4 * tg4 + j, cg)) = R.uu[j];
        }
        __syncthreads();
        { const int un = u + F.G; if (un < 2048) gmlp_prefetch(F, tid, un >> 3, un & 7, R); }
        f32x4 acc[8];
#pragma unroll
        for (int T = 0; T < 8; ++T) acc[T] = (f32x4){0.f, 0.f, 0.f, 0.f};
        bf16x8 af[4];
        int bk[4];
#pragma unroll
        for (int kk = 0; kk < 4; ++kk) bk[kk] = img_off(fr, 4 * kk + fq);
#pragma unroll
        for (int kk = 0; kk < 4; ++kk) af[kk] = *(const LAS bf16x8*)(F.lds + IMG0 + img_xt(bk[kk], w));
#pragma unroll
        for (int T = 0; T < 8; T += 2) {
#pragma unroll
            for (int TT = T; TT < T + 2; ++TT)
#pragma unroll
                for (int kk = 0; kk <= (TT >> 1); ++kk) { const bf16x8 bfr = *(const LAS bf16x8*)(F.lds + IMG1 + img_xt(bk[kk], TT));
                    acc[TT] = __builtin_amdgcn_mfma_f32_16x16x32_bf16(af[kk], bfr, acc[TT], 0, 0, 0); }
            __builtin_amdgcn_sched_barrier(0); }
        u32x2 ow[8];
        const int o0 = img_off(fr, 2 * w + (fq >> 1)) + (fq & 1) * 8;
#pragma unroll
        for (int T = 0; T < 8; ++T) { const int t = 16 * T + fr;
            const int o = img_xt(o0, T);
            const u32x2 uw = *(const LAS u32x2*)(F.lds + IMG2 + o);
            const float y0 = bflo(uw.x) * (acc[T][0] + bsv[T]), y1 = bfhi(uw.x) * (acc[T][1] + bsv[T]);
            const float y2 = bflo(uw.y) * (acc[T][2] + bsv[T]), y3 = bfhi(uw.y) * (acc[T][3] + bsv[T]);
            float q = (y0 * y0 + y1 * y1) + (y2 * y2 + y3 * y3);
            ow[T].x = pk2(y0, y1); ow[T].y = pk2(y2, y3);
            q += __shfl_xor(q, 16); q += __shfl_xor(q, 32);
            if (fq == 0) part[w * 128 + t] = q; }
#pragma unroll
        for (int T = 0; T < 8; T += 2) { u32x2 a = ow[T], b = ow[T + 1];
            { const auto r = __builtin_amdgcn_permlane16_swap(a.x, b.x, false, false); a.x = r[0]; b.x = r[1]; }
            { const auto r = __builtin_amdgcn_permlane16_swap(a.y, b.y, false, false); a.y = r[0]; b.y = r[1]; }
            const int t = 16 * (T + (fq & 1)) + fr;
            *(u32x4*)(Y + (size_t)(t0 + t) * DM + 128 * h + 16 * w + 8 * (fq >> 1)) = (u32x4){a.x, a.y, b.x, b.y}; }
        __syncthreads();
        if (tid < 128) { float s = 0.f;
#pragma unroll
            for (int k = 0; k < 8; ++k) s += part[k * 128 + tid];
            SSA[(size_t)(t0 + tid) * 8 + h] = s; }
    }
    __syncthreads();
}

struct LruPref { u32x4 xb[7], gg[4]; };
constexpr int MISC_CW = MISC + 9728;
__device__ __forceinline__ void lru_prefetch(Frame& F, int tid, int c, int h, LruPref& R) {
    const int tg4 = tid >> 4, cg = tid & 15, t0 = c * CHK;
    typedef const __attribute__((address_space(1))) char* gcp; typedef const __attribute__((address_space(1))) u32x4* gvp;
    gcp zb = (gcp)((uchar*)F.ap->ws + WS_Z) + ((long)(t0 - 3) * NZO + 2 * DG + 128 * h) * 2; asm volatile("" : "+s"(zb));
    const unsigned lo = (unsigned)((4 * tg4) * NZO + 8 * cg) * 2u;
#pragma unroll
    for (int k = 0; k < 7; ++k) R.xb[k] = __builtin_nontemporal_load((gvp)(zb + (lo + (unsigned)(k * NZO * 2))));
#pragma unroll
    for (int j = 0; j < 4; ++j) R.gg[j] = __builtin_nontemporal_load((gvp)(zb + (lo + (unsigned)(((3 + j) * NZO + DG) * 2))));
}
__device__ __forceinline__ void lru_phase(Frame& F) {
    const int tid0 = F.tid, w = F.wave;
    bf16* Y = (bf16*)((uchar*)F.ap->ws + WS_Y); float* SSB = (float*)((uchar*)F.ap->ws + WS_SSB);
    unsigned long long* AGG = (unsigned long long*)((uchar*)F.ap->ws + WS_AGG);
    unsigned* ctl = (unsigned*)F.ap->ws;
    LAS float* part = (LAS float*)(F.lds + MISC_PART); LAS f32x2* cpart = (LAS f32x2*)(F.lds + MISC_CPART);
    int cur = -1;
    LruPref R;
    unsigned pk[8][4];
    int pc = -1, ph = 0;
    int u = F.bid;
    if (u < 2048) lru_prefetch(F, tid0, u >> 3, u & 7, R);
    for (;; u += F.G) {
        const bool live = u < 2048;
        if (!live && pc < 0) break;
        const int h = u & 7, c = u >> 3, t0 = c * CHK, tseq0 = t0 & (SEQ - 1);
        int tid = tid0; asm volatile("" : "+v"(tid));
        const int lane = tid & 63, fr = lane & 15, fq = lane >> 4, tg4 = tid >> 4, cg = tid & 15;
        const int chl = 16 * w + 4 * fq;
        const int pcs = pc & 63, pcb0 = pc - pcs;
        asm volatile("" : "+v"(R.xb[0]), "+v"(R.xb[1]), "+v"(R.xb[2]), "+v"(R.xb[3]), "+v"(R.xb[4]), "+v"(R.xb[5]), "+v"(R.xb[6]), "+v"(R.gg[0]), "+v"(R.gg[1]), "+v"(R.gg[2]), "+v"(R.gg[3]));
        f32x4 pba, pbx, plm;
        if (live) {
            if (h != cur) {
                __syncthreads(); load_img(F.lds + IMG1, (const bf16*)((uchar*)F.ap->ws + WS_WA) + (size_t)h * 16384, tid); load_img(F.lds + IMG2, (const bf16*)((uchar*)F.ap->ws + WS_WX) + (size_t)h * 16384, tid); cur = h;
                for (int i = tid; i < 640; i += NTHR) { const int k = i >> 7, chn = i & 127; ((LAS float*)(F.lds + MISC_CW))[i] = (k < 4) ? F.ap->in[8][k * DL + 128 * h + chn] : F.ap->in[9][128 * h + chn]; }
                __syncthreads(); }
            pba = *(const f32x4*)(F.ap->in[11] + 128 * h + chl); pbx = *(const f32x4*)(F.ap->in[13] + 128 * h + chl); plm = *(const f32x4*)((const float*)((uchar*)F.ap->ws + WS_SPT) + 128 * h + chl);
        }
        unsigned long long ab[16]; int nv = 0;
        asm volatile("" ::: "memory");
        if (pc >= 0) {
            const int ch = tid & 127, pt = __builtin_amdgcn_readfirstlane(tid >> 7);
            nv = pcs - 16 * pt; nv = nv < 0 ? 0 : (nv > 16 ? 16 : nv);
            const unsigned long long* ab0 = AGG + (size_t)(pcb0 + 16 * pt) * DL + 128 * ph + ch;
#pragma unroll
            for (int i = 0; i < 16; ++i) if (__builtin_expect(i < nv, 1)) ab[i] = __hip_atomic_load(ab0 + (size_t)i * DL, __ATOMIC_RELAXED, __HIP_MEMORY_SCOPE_AGENT);
        }
        asm volatile("" ::: "memory");
        if (live) {
            {
                float xc[4][8], wk[4][8], cbv[8];
                { const LAS f32x4* cwt = (const LAS f32x4*)(F.lds + MISC_CW) + 2 * cg;
#pragma unroll
                  for (int k = 0; k < 4; ++k) { const f32x4 a = cwt[k * 32], b = cwt[k * 32 + 1]; wk[k][0] = a.x; wk[k][1] = a.y; wk[k][2] = a.z; wk[k][3] = a.w; wk[k][4] = b.x; wk[k][5] = b.y; wk[k][6] = b.z; wk[k][7] = b.w; }
                  const f32x4 a = cwt[4 * 32], b = cwt[4 * 32 + 1]; cbv[0] = a.x; cbv[1] = a.y; cbv[2] = a.z; cbv[3] = a.w; cbv[4] = b.x; cbv[5] = b.y; cbv[6] = b.z; cbv[7] = b.w; }
#pragma unroll
                for (int j = 0; j < 4; ++j)
#pragma unroll
                    for (int e = 0; e < 8; ++e) xc[j][e] = cbv[e];
                if (tseq0 == 0) {
#pragma unroll
                    for (int k = 0; k < 3; ++k) if (4 * tg4 - 3 + k < 0) R.xb[k] = (u32x4){0u, 0u, 0u, 0u}; }
#pragma unroll
                for (int k = 0; k < 7; ++k) { const unsigned wv[4] = {R.xb[k].x, R.xb[k].y, R.xb[k].z, R.xb[k].w};
#pragma unroll
                    for (int e2 = 0; e2 < 4; ++e2) { const float lo_ = bflo(wv[e2]), hi_ = bfhi(wv[e2]);
#pragma unroll
                        for (int j = 0; j < 4; ++j) { const int kw = k - j; if (kw >= 0 && kw < 4) { xc[j][2 * e2] += wk[kw][2 * e2] * lo_; xc[j][2 * e2 + 1] += wk[kw][2 * e2 + 1] * hi_; } } } }
#pragma unroll
                for (int j = 0; j < 4; ++j) { u32x4 o; o.x = pk2(xc[j][0], xc[j][1]); o.y = pk2(xc[j][2], xc[j][3]); o.z = pk2(xc[j][4], xc[j][5]); o.w = pk2(xc[j][6], xc[j][7]);
                    *(LAS u32x4*)(F.lds + IMG0 + img_off(4 * tg4 + j, cg)) = o;
                    *(LAS u32x4*)(F.lds + IMG3 + img_off(4 * tg4 + j, cg)) = R.gg[j]; }
            }
        }
        asm volatile("" : "+v"(pba), "+v"(pbx), "+v"(plm));
        if (pc >= 0) {
            { const int ch = tid & 127, pt = __builtin_amdgcn_readfirstlane(tid >> 7);
              const unsigned long long* ab0 = AGG + (size_t)(pcb0 + 16 * pt) * DL + 128 * ph + ch;
              for (unsigned spins = 0;; ++spins) {
                  bool ok = true;
#pragma unroll
                  for (int i = 0; i < 16; ++i) if (i < nv) ok = ok && ((unsigned)ab[i] != 0u);
                  if (__all(ok)) break;
                  if (spins > (1u << 17)) { if (lane == 0) __hip_atomic_store(ctl + CW_TMO2, 1u, __ATOMIC_RELAXED, __HIP_MEMORY_SCOPE_AGENT); break; }
                  __builtin_amdgcn_s_sleep(1);
#pragma unroll
                  for (int i = 0; i < 16; ++i) if (i < nv) { if ((unsigned)ab[i] == 0u) ab[i] = __hip_atomic_load(ab0 + (size_t)i * DL, __ATOMIC_RELAXED, __HIP_MEMORY_SCOPE_AGENT); }
              }
              float A = 1.f, B = 0.f;
#pragma unroll
              for (int i = 0; i < 16; ++i) if (i < nv) { const float ax = __uint_as_float((unsigned)ab[i]), bxv = __uint_as_float((unsigned)(ab[i] >> 32)); B = ax * B + bxv; A = ax * A; }
              cpart[pt * 128 + ch] = (f32x2){A, B}; }
            __syncthreads();
            float H[4];
#pragma unroll
            for (int r = 0; r < 4; ++r) { float hh = 0.f;
#pragma unroll
                for (int p = 0; p < 4; ++p) { const f32x2 abp = cpart[p * 128 + chl + r]; hh = abp.x * hh + abp.y; }
                H[r] = hh; }
            const int pt0 = pc * CHK;
            u32x2 ow[8];
#pragma unroll
            for (int T = 0; T < 8; ++T) { const int t = 16 * T + fr;
                const float y0 = bflo(pk[T][0]) * H[0] + bfhi(pk[T][0]), y1 = bflo(pk[T][1]) * H[1] + bfhi(pk[T][1]);
                const float y2 = bflo(pk[T][2]) * H[2] + bfhi(pk[T][2]), y3 = bflo(pk[T][3]) * H[3] + bfhi(pk[T][3]);
                float q = (y0 * y0 + y1 * y1) + (y2 * y2 + y3 * y3);
                ow[T].x = pk2(y0, y1); ow[T].y = pk2(y2, y3);
                q += __shfl_xor(q, 16); q += __shfl_xor(q, 32);
                if (fq == 0) part[w * 128 + t] = q; }
#pragma unroll
            for (int T = 0; T < 8; T += 2) { u32x2 a = ow[T], b = ow[T + 1];
                { const auto r = __builtin_amdgcn_permlane16_swap(a.x, b.x, false, false); a.x = r[0]; b.x = r[1]; }
                { const auto r = __builtin_amdgcn_permlane16_swap(a.y, b.y, false, false); a.y = r[0]; b.y = r[1]; }
                const int t = 16 * (T + (fq & 1)) + fr;
                *(u32x4*)(Y + (size_t)(pt0 + t) * DM + DG + 128 * ph + 16 * w + 8 * (fq >> 1)) = (u32x4){a.x, a.y, b.x, b.y}; }
        }
        __syncthreads();
        if (pc >= 0) { if (tid < 128) { float s = 0.f;
#pragma unroll
            for (int k = 0; k < 8; ++k) s += part[k * 128 + tid];
            SSB[(size_t)(pc * CHK + tid) * 8 + ph] = s; } }
        pc = -1;
        if (!live) break;
        { const int un = u + F.G; if (un < 2048) lru_prefetch(F, tid, un >> 3, un & 7, R); }
        f32x4 accA[8], accX[8];
#pragma unroll
        for (int T = 0; T < 8; ++T) { accA[T] = (f32x4){0.f, 0.f, 0.f, 0.f}; accX[T] = (f32x4){0.f, 0.f, 0.f, 0.f}; }
        {
            bf16x8 afa[4], afx[4], b0[4], b1[4];
            int bk[4];
#pragma unroll
            for (int kk = 0; kk < 4; ++kk) bk[kk] = img_off(fr, 4 * kk + fq);
#pragma unroll
            for (int kk = 0; kk < 4; ++kk) { afa[kk] = *(const LAS bf16x8*)(F.lds + IMG1 + img_xt(bk[kk], w)); afx[kk] = *(const LAS bf16x8*)(F.lds + IMG2 + img_xt(bk[kk], w)); }
#define LRU_LDB(dst, T) do { _Pragma("unroll") for (int kk = 0; kk < 4; ++kk) dst[kk] = *(const LAS bf16x8*)(F.lds + IMG0 + img_xt(bk[kk], (T))); } while (0)
#define LRU_MMA(src, T) do { _Pragma("unroll") for (int kk = 0; kk < 4; ++kk) { accA[T] = __builtin_amdgcn_mfma_f32_16x16x32_bf16(afa[kk], src[kk], accA[T], 0, 0, 0); \
                accX[T] = __builtin_amdgcn_mfma_f32_16x16x32_bf16(afx[kk], src[kk], accX[T], 0, 0, 0); } } while (0)
            LRU_LDB(b0, 0);
#pragma unroll
            for (int T = 0; T < 8; T += 2) {
                LRU_LDB(b1, T + 1); __builtin_amdgcn_sched_barrier(0); LRU_MMA(b0, T); __builtin_amdgcn_sched_barrier(0);
                if (T + 2 < 8) LRU_LDB(b0, T + 2);
                __builtin_amdgcn_sched_barrier(0); LRU_MMA(b1, T + 1); __builtin_amdgcn_sched_barrier(0); }
#undef LRU_LDB
#undef LRU_MMA
        }
        {
            float P[4], Q[4], ba[4], bx[4], sp[4];
            { const float av[4] = {pba.x, pba.y, pba.z, pba.w}, bv[4] = {pbx.x, pbx.y, pbx.z, pbx.w}, lmv[4] = {plm.x, plm.y, plm.z, plm.w};
#pragma unroll
              for (int r = 0; r < 4; ++r) { sp[r] = lmv[r];
                  ba[r] = av[r] * -1.44269504f; bx[r] = bv[r] * -1.44269504f; P[r] = 1.f; Q[r] = 0.f; } }
            const int o0 = img_off(fr, 2 * w + (fq >> 1)) + (fq & 1) * 8;
#pragma unroll
            for (int T = 0; T < 8; ++T) { const int t = 16 * T + fr; const bool first = (tseq0 + t) == 0;
                const int o = img_xt(o0, T);
                const u32x2 xw = *(const LAS u32x2*)(F.lds + IMG0 + o), gw = *(const LAS u32x2*)(F.lds + IMG3 + o);
                const f32x2 g01 = (f32x2){bflo(gw.x), bfhi(gw.x)}, g23 = (f32x2){bflo(gw.y), bfhi(gw.y)};
                const float xcv[4] = {bflo(xw.x), bfhi(xw.x), bflo(xw.y), bfhi(xw.y)}, gvv[4] = {g01.x, g01.y, g23.x, g23.y};
                float A[4], B[4], At[4], Bt[4];
                {
#pragma unroll
                    for (int hp = 0; hp < 2; ++hp) { const int r0 = 2 * hp, r1 = 2 * hp + 1;
                        const f32x2 ta = (f32x2){accA[T][r0], accA[T][r1]} * (-1.44269504f) + (f32x2){ba[r0], ba[r1]}, tx = (f32x2){accX[T][r0], accX[T][r1]} * (-1.44269504f) + (f32x2){bx[r0], bx[r1]};
                        f32x2 ea, ex; ea.x = __builtin_amdgcn_exp2f(ta.x); ea.y = __builtin_amdgcn_exp2f(ta.y); ex.x = __builtin_amdgcn_exp2f(tx.x); ex.y = __builtin_amdgcn_exp2f(tx.y);
                        const f32x2 da = ea + 1.0f, dx = ex + 1.0f;
                        f32x2 rg, ig; rg.x = __builtin_amdgcn_rcpf(da.x); rg.y = __builtin_amdgcn_rcpf(da.y); ig.x = __builtin_amdgcn_rcpf(dx.x); ig.y = __builtin_amdgcn_rcpf(dx.y);
                        const f32x2 la = (f32x2){sp[r0], sp[r1]} * rg;
                        f32x2 a; a.x = __builtin_amdgcn_exp2f(la.x); a.y = __builtin_amdgcn_exp2f(la.y);
                        const f32x2 m2 = 1.0f - a * a;
                        f32x2 mult; mult.x = __builtin_amdgcn_sqrtf(m2.x); mult.y = __builtin_amdgcn_sqrtf(m2.y);
                        if (first) mult = (f32x2){1.0f, 1.0f};
                        const f32x2 b = mult * (ig * (f32x2){xcv[r0], xcv[r1]});
                        A[r0] = a.x; A[r1] = a.y; B[r0] = b.x; B[r1] = b.y; }
                }
#define LRU_SCAN_STEP(K) \
                    "v_fmac_f32_dpp %4, %4, %0 row_shr:" #K " row_mask:0xf bank_mask:0xf\n\t" "v_fmac_f32_dpp %5, %5, %1 row_shr:" #K " row_mask:0xf bank_mask:0xf\n\t" \
                    "v_fmac_f32_dpp %6, %6, %2 row_shr:" #K " row_mask:0xf bank_mask:0xf\n\t" "v_fmac_f32_dpp %7, %7, %3 row_shr:" #K " row_mask:0xf bank_mask:0xf\n\t" \
                    "v_mul_f32_dpp %0, %0, %0 row_shr:" #K " row_mask:0xf bank_mask:0xf\n\t" "v_mul_f32_dpp %1, %1, %1 row_shr:" #K " row_mask:0xf bank_mask:0xf\n\t" \
                    "v_mul_f32_dpp %2, %2, %2 row_shr:" #K " row_mask:0xf bank_mask:0xf\n\t" "v_mul_f32_dpp %3, %3, %3 row_shr:" #K " row_mask:0xf bank_mask:0xf\n\t"
                asm volatile("s_nop 1\n\t"
                    LRU_SCAN_STEP(1) LRU_SCAN_STEP(2) LRU_SCAN_STEP(4) LRU_SCAN_STEP(8)
                    "v_mov_b32_dpp %8, %0 row_newbcast:15 row_mask:0xf bank_mask:0xf\n\t" "v_mov_b32_dpp %9, %1 row_newbcast:15 row_mask:0xf bank_mask:0xf\n\t"
                    "v_mov_b32_dpp %10, %2 row_newbcast:15 row_mask:0xf bank_mask:0xf\n\t" "v_mov_b32_dpp %11, %3 row_newbcast:15 row_mask:0xf bank_mask:0xf\n\t"
                    "v_mov_b32_dpp %12, %4 row_newbcast:15 row_mask:0xf bank_mask:0xf\n\t" "v_mov_b32_dpp %13, %5 row_newbcast:15 row_mask:0xf bank_mask:0xf\n\t"
                    "v_mov_b32_dpp %14, %6 row_newbcast:15 row_mask:0xf bank_mask:0xf\n\t" "v_mov_b32_dpp %15, %7 row_newbcast:15 row_mask:0xf bank_mask:0xf\n\t"
                    "s_nop 0"
                    : "+v"(A[0]), "+v"(A[1]), "+v"(A[2]), "+v"(A[3]), "+v"(B[0]), "+v"(B[1]), "+v"(B[2]), "+v"(B[3]),
                      "=&v"(At[0]), "=&v"(At[1]), "=&v"(At[2]), "=&v"(At[3]), "=&v"(Bt[0]), "=&v"(Bt[1]), "=&v"(Bt[2]), "=&v"(Bt[3]));
#undef LRU_SCAN_STEP
#pragma unroll
                for (int hp = 0; hp < 2; ++hp) { const int r0 = 2 * hp, r1 = 2 * hp + 1;
                    const f32x2 Av = (f32x2){A[r0], A[r1]}, Bv = (f32x2){B[r0], B[r1]}, Pv = (f32x2){P[r0], P[r1]}, Qv = (f32x2){Q[r0], Q[r1]}, gv2 = (f32x2){gvv[r0], gvv[r1]}, Atv = (f32x2){At[r0], At[r1]}, Btv = (f32x2){Bt[r0], Bt[r1]};
                    const f32x2 acc_ = Av * Pv * gv2, bcc_ = (Av * Qv + Bv) * gv2;
                    pk[T][r0] = pk2(acc_.x, bcc_.x); pk[T][r1] = pk2(acc_.y, bcc_.y);
                    const f32x2 Qn = Atv * Qv + Btv, Pn = Atv * Pv; Q[r0] = Qn.x; Q[r1] = Qn.y; P[r0] = Pn.x; P[r1] = Pn.y; }
                if (T & 1) __builtin_amdgcn_sched_barrier(0);
            }
            if (fr == 0) {
#pragma unroll
                for (int r = 0; r < 4; ++r) __hip_atomic_store(AGG + (size_t)c * DL + 128 * h + chl + r, ((unsigned long long)__float_as_uint(Q[r]) << 32) | __float_as_uint(fmaxf(P[r], 1e-37f)), __ATOMIC_RELAXED, __HIP_MEMORY_SCOPE_AGENT); }
        }
        __syncthreads();
        pc = c; ph = h;
    }
    __syncthreads();
}

#define XB_TMO      128
#define XB_XCNT(j)  (256  + 64 * (j))
#define XB_XSUB(j)  (1280 + 64 * (j))
#define XB_XGEN(j)  (2304 + 64 * (j))
#define XB_TOP      3328
#define XB_TOPGEN   3392
#define XCD_BAR_WORDS 3456
#define XB_SPIN_CAP (1u << 18)
constexpr int LDS_BARST = MISC + 15 * 1024;
__device__ __forceinline__ unsigned xb_ld(unsigned* p)              { return __hip_atomic_load(p, __ATOMIC_RELAXED, __HIP_MEMORY_SCOPE_AGENT); }
__device__ __forceinline__ unsigned xb_add(unsigned* p, unsigned v) { return __hip_atomic_fetch_add(p, v, __ATOMIC_RELAXED, __HIP_MEMORY_SCOPE_AGENT); }
__device__ __forceinline__ unsigned xb_xcc_id() { return (unsigned)__builtin_amdgcn_s_getreg((3 << 11) | 20) & 0xFu; }
#define XB_SPIN(cond, bar) do { unsigned _sp = 0; while (cond) { __builtin_amdgcn_s_sleep(1); \
    if ((++_sp & 255u) == 0u) { if (xb_ld(&(bar)[XB_TMO])) break; if (_sp > XB_SPIN_CAP) { atomicAdd(&(bar)[XB_TMO], 1u); break; } } } } while (0)
__device__ __forceinline__ void xcd_barrier_complete(unsigned* bar, unsigned x, unsigned& nloc, unsigned& nx) {
    const unsigned G = gridDim.x;
    unsigned sum, cnt, mine, sp = 0u;
    for (;;) {
        sum = 0u; cnt = 0u; mine = 0u;
#pragma unroll
        for (unsigned j = 0; j < 16; ++j) { const unsigned c = xb_ld(&bar[XB_XCNT(j)]); sum += c; cnt += (c > 0u) ? 1u : 0u; mine = (j == x) ? c : mine; }
        if (sum == G) break;
        __builtin_amdgcn_s_sleep(1);
        if ((++sp & 255u) == 0u) { if (xb_ld(&bar[XB_TMO])) break; if (sp > XB_SPIN_CAP) { atomicAdd(&bar[XB_TMO], 1u); break; } }
    }
    nloc = mine > 0u ? mine : 1u; nx = cnt > 0u ? cnt : 1u;
}
__device__ __forceinline__ void xcd_barrier(unsigned* bar, volatile LAS unsigned* st, int tid) {
    asm volatile("s_waitcnt vmcnt(0)" ::: "memory");
    __syncthreads();
    if (tid == 0) {
        const unsigned x = xb_xcc_id();
        __builtin_amdgcn_s_waitcnt(0);
        unsigned nloc = st[0], nx = st[1];
        if (nloc == 0u) { xcd_barrier_complete(bar, x, nloc, nx); st[0] = nloc; st[1] = nx; }
        const unsigned old = xb_add(&bar[XB_XSUB(x)], 1u);
        const unsigned gen = old / nloc;
        if (old + 1u == (gen + 1u) * nloc) {
            __builtin_amdgcn_fence(__ATOMIC_RELEASE, "agent");
            asm volatile("s_waitcnt vmcnt(0)" ::: "memory");
            const unsigned og = xb_add(&bar[XB_TOP], 1u);
            const unsigned tg = og / nx;
            if (og + 1u == (tg + 1u) * nx) xb_add(&bar[XB_TOPGEN], 1u);
            else XB_SPIN(xb_ld(&bar[XB_TOPGEN]) == tg, bar);
            __builtin_amdgcn_fence(__ATOMIC_ACQUIRE, "agent");
            xb_add(&bar[XB_XGEN(x)], 1u);
            asm volatile("s_waitcnt vmcnt(0)" ::: "memory");
        } else {
            XB_SPIN(xb_ld(&bar[XB_XGEN(x)]) == gen, bar);
            __builtin_amdgcn_fence(__ATOMIC_ACQUIRE, "agent");
            asm volatile("s_waitcnt vmcnt(0)" ::: "memory");
        }
    }
    __syncthreads();
}

__global__ void __launch_bounds__(NTHR, 2) mk_fwd(Args args_unused) {
    extern __shared__ __attribute__((aligned(16))) unsigned char lds_raw[];
    Frame F;
    F.lds = (LAS uchar*)lds_raw; F.G = gridDim.x; F.bid = blockIdx.x; F.wv = __builtin_amdgcn_readfirstlane((int)threadIdx.x >> 6);
    PHASE_BEGIN(F);
    const int lo = F.ap->ph_lo, hi = F.ap->ph_hi;
#define IN(k) (lo <= (k) && (k) < hi)
#if MK_N_LAUNCHES == 1
#define SEAM(k) do { if (IN(k) && IN((k) + 1)) { PHASE_BEGIN(F); xcd_barrier((unsigned*)F.ap->ws, (volatile LAS unsigned*)(F.lds + LDS_BARST), F.tid); } } while (0)
#else
#define SEAM(k) do { } while (0)
#endif
#define WSB(off) ((bf16*)((uchar*)F.ap->ws + (off)))
#define WSF(off) ((float*)((uchar*)F.ap->ws + (off)))

    if (F.tid < 2) ((volatile LAS unsigned*)(F.lds + LDS_BARST))[F.tid] = 0u;
#if MK_N_LAUNCHES == 1 && !MK_CG_SYNC
    if (F.tid == 0) (void)xb_add((unsigned*)F.ap->ws + XB_XCNT(xb_xcc_id()), 1u);
#endif
    if (IN(0)) {
#if MK_N_LAUNCHES == 1 && MK_CG_SYNC
        if (F.bid == 0) { unsigned* bw = (unsigned*)F.ap->ws; for (int i = F.tid; i < CTL_WORDS; i += NTHR) __hip_atomic_store(bw + i, 0u, __ATOMIC_RELAXED, __HIP_MEMORY_SCOPE_AGENT); }
#endif
        REPS(0) { p0_prologue(F); __syncthreads(); } }
#if MK_N_LAUNCHES == 1 && MK_CG_SYNC
    cg::this_grid().sync();
    PHASE_BEGIN(F);
    if (F.tid == 0) (void)xb_add((unsigned*)F.ap->ws + XB_XCNT(xb_xcc_id()), 1u);
#else
    SEAM(0);
#endif
    if (IN(1)) REPS(1) {
        PHASE_BEGIN(F);
#if PROBE_KLOOP
        { pg8::Gemm g{WSB(WS_A1), WSB(WS_WIN), M, NZ, DM}; pg8::RepOrder S; S.init(M, NZ, F.G, F.bid);
          pg8::EpiZ E{WSB(WS_Z), NZO, (pg8::f32x2*)WSF(WS_VST), 0};
          pg8::gemm_phase<pg8::EpiZ, pg8::RepOrder, true, true>(F.lds, g, S, E, F.tid); }
#else
        { pg8::Gemm g{WSB(WS_A1), WSB(WS_WIN), M, NZ, DM}; pg8::StaticOrder S; S.init(M, NZ, F.G, F.bid);
          pg8::EpiZ E{WSB(WS_Z), NZO, (pg8::f32x2*)WSF(WS_VST), 0};
          pg8::gemm_phase<pg8::EpiZ, pg8::StaticOrder, true, true>(F.lds, g, S, E, F.tid); }
#endif
    }
    SEAM(1);
    if (IN(2)) {
        if ((F.bid & 7) < 4) { REPS(4) { PHASE_BEGIN(F); lru_phase(F); } REPS(2) { PHASE_BEGIN(F); gmlp_phase(F); } }
        else                 { REPS(2) { PHASE_BEGIN(F); gmlp_phase(F); } REPS(4) { PHASE_BEGIN(F); lru_phase(F); } }
    }
    SEAM(2);
    if (IN(5)) REPS(5) {
        PHASE_BEGIN(F);
        pg8::PanelOrder S; S.init(M, DM, F.G, F.bid);
        {
            const float* SSA = WSF(WS_SSA); const float* SSB = WSF(WS_SSB); LAS f32x2* rr = (LAS f32x2*)(F.lds + MISC);
            f32x4 a0[2], a1[2], b0[2], b1[2]; bool ok[2];
#pragma unroll
            for (int k = 0; k < 2; ++k) { pg8::Unit u; ok[k] = S.next((F.tid >> 8) + 2 * k, u); const size_t row = (size_t)(ok[k] ? u.pm : 0) * 256 + (F.tid & 255);
                a0[k] = *(const f32x4*)(SSA + row * 8); a1[k] = *(const f32x4*)(SSA + row * 8 + 4); b0[k] = *(const f32x4*)(SSB + row * 8); b1[k] = *(const f32x4*)(SSB + row * 8 + 4); }
#pragma unroll
            for (int k = 0; k < 2; ++k) {
                const float ra = 1.0f / sqrtf(((a0[k].x + a0[k].y) + (a0[k].z + a0[k].w) + (a1[k].x + a1[k].y) + (a1[k].z + a1[k].w)) * (1.0f / DG) + EPS);
                const float rb = 1.0f / sqrtf(((b0[k].x + b0[k].y) + (b0[k].z + b0[k].w) + (b1[k].x + b1[k].y) + (b1[k].z + b1[k].w)) * (1.0f / DL) + EPS);
                if (ok[k]) rr[((F.tid >> 8) + 2 * k) * 256 + (F.tid & 255)] = (f32x2){ra / rb, rb}; }
            __syncthreads();
        }
        pg8::Gemm g{WSB(WS_Y), WSB(WS_WOUT), M, DM, DM};
        pg8::EpiH E(WSB(WS_A3), K3, WSB(WS_A1), DM, WSF(WS_SX), F.ap->in[18], (const LAS pg8::f32x2*)(F.lds + MISC), (LAS float*)(F.lds + MISC + 8192), (LAS float*)(F.lds + MISC + 12288),
                    WSF(WS_SSO), (unsigned*)F.ap->ws + CW_PCNT, (unsigned*)F.ap->ws + CW_TMO2);
        pg8::gemm_phase<pg8::EpiH, pg8::PanelOrder, true, true>(F.lds, g, S, E, F.tid);
        __syncthreads();
    }
    SEAM(5);
    if (IN(7)) REPS(7) {
        PHASE_BEGIN(F);
#if SKEW7_TICKS > 0
        {
            const unsigned long long t0 = __builtin_amdgcn_s_memrealtime(); const unsigned long long dl = (unsigned long long)(F.bid & 7) * SKEW7_TICKS;
            while (__builtin_amdgcn_s_memrealtime() - t0 < dl) __builtin_amdgcn_s_sleep(8);
        }
#endif
        pg8::Gemm g{WSB(WS_A3), WSB(WS_B3), M, DM, K3}; pg8::StaticOrder S; S.init(M, DM, F.G, F.bid);
        pg8::EpiOut E((float*)F.ap->out, WSB(WS_A3), DM, K3);
        pg8::gemm_phase<pg8::EpiOut, pg8::StaticOrder, true, true>(F.lds, g, S, E, F.tid);
    }
#undef IN
#undef SEAM
}

extern "C" void kernel_launch(void* const* d_in, const int* in_sizes, int n_in, void* d_out, int out_size, void* d_ws, size_t ws_size, hipStream_t stream) {
    static int grid = 0;
    if (grid == 0) {
        if (n_in != 21 || in_sizes[0] != M * DM || out_size != M * DM || ws_size < WS_END) { fprintf(stderr, "kernel_launch: unexpected problem (n_in %d, in0 %d, out %d, ws %zu); nothing launched\n", n_in, n_in > 0 ? in_sizes[0] : -1, out_size, ws_size); grid = -1; return; }
        int dev = 0, cus = 0, per_cu = 0;
        if (hipGetDevice(&dev) != hipSuccess || hipDeviceGetAttribute(&cus, hipDeviceAttributeMultiprocessorCount, dev) != hipSuccess) { fprintf(stderr, "kernel_launch: device query failed\n"); grid = -1; return; }
        if (hipFuncSetAttribute((const void*)mk_fwd, hipFuncAttributeMaxDynamicSharedMemorySize, LDS_BYTES) != hipSuccess) { fprintf(stderr, "kernel_launch: hipFuncSetAttribute failed\n"); grid = -1; return; }
        if (hipOccupancyMaxActiveBlocksPerMultiprocessor(&per_cu, (const void*)mk_fwd, NTHR, LDS_BYTES) != hipSuccess || per_cu < 1) { fprintf(stderr, "kernel_launch: occupancy query says %d blocks per CU\n", per_cu); per_cu = 1; }
        (void)hipGetLastError();
        grid = cus * (per_cu < 1 ? 1 : per_cu);
    }
    if (grid < 0) return;
    Args a{};
    for (int i = 0; i < 21; ++i) a.in[i] = (const float*)d_in[i];
    a.out = (float*)d_out; a.ws = (unsigned char*)d_ws;
#if MK_N_LAUNCHES == 1
    a.ph_lo = 0; a.ph_hi = N_PHASES;
#if MK_CG_SYNC
    void* kargs[] = {&a};
    hipError_t e = hipLaunchCooperativeKernel((const void*)mk_fwd, dim3(grid), dim3(NTHR), kargs, LDS_BYTES, stream);
    if (e != hipSuccess) fprintf(stderr, "kernel_launch: cooperative launch failed: %s (grid %d)\n", hipGetErrorString(e), grid);
#else
    if (hipMemsetAsync(d_ws, 0, CTL_WORDS * 4, stream) != hipSuccess) { fprintf(stderr, "kernel_launch: hipMemsetAsync of the control words failed; nothing launched\n"); return; }
    hipLaunchKernelGGL(mk_fwd, dim3(grid), dim3(NTHR), LDS_BYTES, stream, a);
    { const hipError_t le = hipPeekAtLastError(); if (le != hipSuccess) fprintf(stderr, "kernel_launch: launch failed: %s (grid %d)\n", hipGetErrorName(le), grid); }
#endif
#else
    for (int li = 0; li < N_PHASES; ++li) { a.ph_lo = li; a.ph_hi = li + 1;
        hipLaunchKernelGGL(mk_fwd, dim3(grid), dim3(NTHR), LDS_BYTES, stream, a);
        const hipError_t le = hipPeekAtLastError(); if (le != hipSuccess) { fprintf(stderr, "kernel_launch: launch %d failed: %s\n", li, hipGetErrorName(le)); break; } }
#endif
}
```
